# Optimizing an MI355X kernel written in HIP

```python
import jax, jax.numpy as jnp
from jax import lax
import numpy as np

D_MODEL = 1024
BATCH = 32
SEQ = 2048
DEPTH = 1

CTX_LEN = 256
GRID_W = 64
NORM_EPS = 1e-6
SGU_WIDTH = 1024
SGU_GROUPS = 8
SGU_GROUP_DIM = SGU_WIDTH // SGU_GROUPS
CHUNK = 128
TINY_DIM = 64
ATTN_BLOCK = 128
ROPE_BASE = 10000.0
NA_HEADS = 16
NA_HEAD_DIM = 32
NA_WIDTH = NA_HEADS * NA_HEAD_DIM
NA_ROWS = 8
NA_COLS = 16
N_EXPERTS = 64
TOP_K = 8
EXPERT_FF = 256
SHARED_FF = 256
ROUTE_SCALE = 2.5
EXPERT_BLOCK = 128
COL_U = 0
COL_V = COL_U + SGU_WIDTH
COL_TQ = COL_V + SGU_WIDTH
COL_TK = COL_TQ + TINY_DIM
COL_TV = COL_TK + TINY_DIM
COL_NQ = COL_TV + TINY_DIM
COL_NK = COL_NQ + NA_WIDTH
COL_NV = COL_NK + NA_WIDTH
COL_GA = COL_NV + NA_WIDTH
COL_GB = COL_GA + D_MODEL
IN_WIDTH = COL_GB + D_MODEL

kernel_name = "hybrid_sgu_natten_moe_dit_block"


def rms_norm(x, g):
    xf = x.astype(jnp.float32)
    y = xf * lax.rsqrt(jnp.mean(xf * xf, -1, keepdims=True) + NORM_EPS)
    return (y * g.astype(jnp.float32)).astype(x.dtype)


def layer_norm(x, g, b):
    xf = x.astype(jnp.float32)
    mu = jnp.mean(xf, -1, keepdims=True)
    var = jnp.mean(jnp.square(xf - mu), -1, keepdims=True)
    y = (xf - mu) * lax.rsqrt(var + NORM_EPS) * g.astype(jnp.float32) + b.astype(jnp.float32)
    return y.astype(x.dtype)


def modulate(h, shift, scale):
    return h * (1 + scale) + shift


def swiglu(x, wg, wu, wd):
    return (jax.nn.silu(x @ wg) * (x @ wu)) @ wd


def axial_rope(x, n_tokens):
    dh = x.shape[-1]
    quarter = dh // 4
    t = jnp.arange(n_tokens)
    pos = jnp.stack([t // GRID_W, t % GRID_W], -1).astype(jnp.float32)
    inv_freq = ROPE_BASE ** (-jnp.arange(quarter, dtype=jnp.float32) / quarter)
    ang = pos[:, :, None] * inv_freq
    cos, sin = jnp.cos(ang), jnp.sin(ang)
    xf = x.astype(jnp.float32).reshape(x.shape[:-1] + (2, 2, quarter))
    x1, x2 = xf[..., 0, :], xf[..., 1, :]
    out = jnp.stack([x1 * cos - x2 * sin, x2 * cos + x1 * sin], -2)
    return out.reshape(x.shape).astype(x.dtype)


def tiny_attention(q, k_lat, v_lat, k_ctx, v_ctx):
    b, s, t = q.shape
    k_all = jnp.concatenate([k_lat, k_ctx], 1)
    v_all = jnp.concatenate([v_lat, v_ctx], 1)
    q_blocks = q.reshape(b, s // ATTN_BLOCK, ATTN_BLOCK, t).transpose(1, 0, 2, 3)
    scale = t ** -0.5

    def one_block(qb):
        sc = jnp.einsum("bqt,bkt->bqk", qb, k_all, preferred_element_type=jnp.float32) * scale
        p = jax.nn.softmax(sc, -1).astype(v_all.dtype)
        return jnp.einsum("bqk,bkt->bqt", p, v_all)

    out = lax.map(one_block, q_blocks)
    return out.transpose(1, 0, 2, 3).reshape(b, s, t)


def spatial_gating(u, v, tiny, ln_g, ln_b, w_s, b_s):
    b, s, _ = v.shape
    vn = layer_norm(v, ln_g, ln_b).reshape(b, s // CHUNK, CHUNK, SGU_GROUPS, SGU_GROUP_DIM)
    mixed = jnp.einsum("gpq,bnqgc->bnpgc", w_s, vn) + b_s.T[:, :, None]
    return u * (mixed.reshape(b, s, SGU_WIDTH) + tiny)


def neighbourhood_attention(q, k, v, k_ctx, v_ctx, rpb, rows):
    b, s, h, dh = q.shape
    kh = min(NA_ROWS, rows)
    qg = q.reshape(b, rows, GRID_W, h, dh)
    kg = k.reshape(b, rows, GRID_W, h, dh)
    vg = v.reshape(b, rows, GRID_W, h, dh)
    cq = np.arange(GRID_W)
    c_start = np.clip(cq - NA_COLS // 2, 0, GRID_W - NA_COLS)
    col_mask = (cq[None, :] >= c_start[:, None]) & (cq[None, :] < c_start[:, None] + NA_COLS)
    band_mask = np.broadcast_to(col_mask[:, None, :], (GRID_W, kh, GRID_W)).reshape(GRID_W, kh * GRID_W)
    dc_idx = np.clip(cq[None, :] - cq[:, None], -(NA_COLS - 1), NA_COLS - 1) + NA_COLS - 1
    col_bias = rpb[:, :, dc_idx]
    scale = dh ** -0.5

    def one_row(r):
        r_start = jnp.clip(r - kh // 2, 0, rows - kh)
        qb = lax.dynamic_index_in_dim(qg, r, axis=1, keepdims=False)
        kb = lax.dynamic_slice_in_dim(kg, r_start, kh, axis=1).reshape(b, kh * GRID_W, h, dh)
        vb = lax.dynamic_slice_in_dim(vg, r_start, kh, axis=1).reshape(b, kh * GRID_W, h, dh)
        dr = r_start + jnp.arange(kh) - r + NA_ROWS - 1
        bias = jnp.take(col_bias, dr, axis=1).transpose(0, 2, 1, 3).reshape(h, GRID_W, kh * GRID_W)
        s_lat = jnp.einsum("bqhd,bkhd->bhqk", qb, kb, preferred_element_type=jnp.float32) * scale + bias
        s_lat = jnp.where(band_mask, s_lat, -jnp.inf)
        s_ctx = jnp.einsum("bqhd,bkhd->bhqk", qb, k_ctx, preferred_element_type=jnp.float32) * scale
        p = jax.nn.softmax(jnp.concatenate([s_lat, s_ctx], -1), -1).astype(v.dtype)
        n_lat = kh * GRID_W
        return (jnp.einsum("bhqk,bkhd->bqhd", p[..., :n_lat], vb)
                + jnp.einsum("bhqk,bkhd->bqhd", p[..., n_lat:], v_ctx))

    out = lax.map(one_row, jnp.arange(rows))
    return out.transpose(1, 0, 2, 3, 4).reshape(b, s, h * dh)


def moe_ffn(h, w_router, b_router, w_e_gate, w_e_up, w_e_down, w_sh_gate, w_sh_up, w_sh_down):
    n, d = h.shape
    scores = jax.nn.sigmoid(jnp.matmul(h, w_router, preferred_element_type=jnp.float32))
    _, idx = lax.top_k(scores + b_router.astype(jnp.float32), TOP_K)
    wts = jnp.take_along_axis(scores, idx, axis=-1)
    wts = (wts / jnp.sum(wts, -1, keepdims=True) * ROUTE_SCALE).astype(h.dtype)
    n_assign = n * TOP_K
    flat_e = idx.reshape(-1)
    flat_tok = jnp.repeat(jnp.arange(n, dtype=jnp.int32), TOP_K)
    flat_w = wts.reshape(-1)
    order = jnp.argsort(flat_e)
    se, st, sw = flat_e[order], flat_tok[order], flat_w[order]
    counts = jnp.bincount(flat_e, length=N_EXPERTS)
    starts = jnp.cumsum(counts) - counts
    pad_counts = (counts + EXPERT_BLOCK - 1) // EXPERT_BLOCK * EXPERT_BLOCK
    pad_ends = jnp.cumsum(pad_counts)
    pad_starts = pad_ends - pad_counts
    dest = pad_starts[se] + jnp.arange(n_assign) - starts[se]
    n_blocks = -(-n_assign // EXPERT_BLOCK) + N_EXPERTS
    n_rows = n_blocks * EXPERT_BLOCK
    row_tok = jnp.full((n_rows,), n, jnp.int32).at[dest].set(st)
    row_w = jnp.zeros((n_rows,), h.dtype).at[dest].set(sw)
    block_e = jnp.minimum(jnp.searchsorted(pad_ends, jnp.arange(n_blocks) * EXPERT_BLOCK, side="right"),
                          N_EXPERTS - 1)
    h_pad = jnp.concatenate([h, jnp.zeros((1, d), h.dtype)], 0)

    def expert_block(acc, blk):
        tok, wt, e = blk
        yb = swiglu(h_pad[tok], w_e_gate[e], w_e_up[e], w_e_down[e]) * wt[:, None]
        return acc.at[tok].add(yb), None

    routed, _ = lax.scan(expert_block, jnp.zeros((n + 1, d), h.dtype),
                         (row_tok.reshape(n_blocks, EXPERT_BLOCK), row_w.reshape(n_blocks, EXPERT_BLOCK), block_e))
    return swiglu(h, w_sh_gate, w_sh_up, w_sh_down) + routed[:n]


def hybrid_layer(x, c, ctx, c_ctx, w_ada, b_ada, norm_mix_g, norm_ffn_g, w_in, b_in,
                 sgu_ln_g, sgu_ln_b, sgu_w_s, sgu_b_s, tiny_w_o, na_rpb, w_up_a, w_up_b, w_out,
                 w_router, b_router, w_e_gate, w_e_up, w_e_down, w_sh_gate, w_sh_up, w_sh_down):
    b, s, d = x.shape
    rows = s // GRID_W
    ctx_len = ctx.shape[1]
    mod = (jax.nn.silu(c) @ w_ada + b_ada)[:, None, :]
    sh_mix, sc_mix, g_mix, sh_ffn, sc_ffn, g_ffn = jnp.split(mod, 6, -1)
    mod_ctx = jax.nn.silu(c_ctx) @ w_ada[:, :2 * d] + b_ada[:2 * d]

    h = modulate(rms_norm(x, norm_mix_g), sh_mix, sc_mix)
    p_in = h @ w_in + b_in
    u = jax.nn.gelu(p_in[..., COL_U:COL_V], approximate=False)
    v = jax.nn.gelu(p_in[..., COL_V:COL_TQ], approximate=False)
    tq = axial_rope(p_in[..., COL_TQ:COL_TK], s)
    tk = axial_rope(p_in[..., COL_TK:COL_TV], s)
    tv = p_in[..., COL_TV:COL_NQ]
    nq = p_in[..., COL_NQ:COL_NK].reshape(b, s, NA_HEADS, NA_HEAD_DIM)
    nk = p_in[..., COL_NK:COL_NV].reshape(b, s, NA_HEADS, NA_HEAD_DIM)
    nv = p_in[..., COL_NV:COL_GA].reshape(b, s, NA_HEADS, NA_HEAD_DIM)
    gate_a = jax.nn.sigmoid(p_in[..., COL_GA:COL_GB])
    gate_b = jax.nn.sigmoid(p_in[..., COL_GB:IN_WIDTH])

    hc = modulate(rms_norm(ctx, norm_mix_g), mod_ctx[:d], mod_ctx[d:])
    c_tiny = hc @ w_in[:, COL_TK:COL_NQ] + b_in[COL_TK:COL_NQ]
    tk_c, tv_c = c_tiny[..., :TINY_DIM], c_tiny[..., TINY_DIM:]
    c_na = hc @ w_in[:, COL_NK:COL_GA] + b_in[COL_NK:COL_GA]
    nk_c = c_na[..., :NA_WIDTH].reshape(b, ctx_len, NA_HEADS, NA_HEAD_DIM)
    nv_c = c_na[..., NA_WIDTH:].reshape(b, ctx_len, NA_HEADS, NA_HEAD_DIM)

    tiny = tiny_attention(tq, tk, tv, tk_c, tv_c) @ tiny_w_o
    o_a = spatial_gating(u, v, tiny, sgu_ln_g, sgu_ln_b, sgu_w_s, sgu_b_s)
    o_b = neighbourhood_attention(nq, nk, nv, nk_c, nv_c, na_rpb, rows)

    merged = gate_a * (o_a @ w_up_a) + gate_b * (o_b @ w_up_b)
    x = x + g_mix * (merged @ w_out)

    h2 = modulate(rms_norm(x, norm_ffn_g), sh_ffn, sc_ffn).reshape(b * s, d)
    y = moe_ffn(h2, w_router, b_router, w_e_gate, w_e_up, w_e_down, w_sh_gate, w_sh_up, w_sh_down)
    return x + g_ffn * y.reshape(b, s, d)


def setup_inputs(seed: int = 0) -> dict:
    key = jax.random.key(seed)
    ks = jax.random.split(key, 32)
    f32 = jnp.float32
    L, D = DEPTH, D_MODEL

    def nrm(k, shape, scale):
        return jax.random.normal(k, shape, f32) * scale

    return {
        "x": nrm(ks[0], (BATCH, SEQ, D), 1.0),
        "c": nrm(ks[1], (BATCH, D), 1.0),
        "ctx": nrm(ks[2], (BATCH, CTX_LEN, D), 1.0),
        "c_ctx": nrm(ks[3], (D,), 1.0),
        "w_ada": nrm(ks[4], (L, D, 6 * D), 0.5 * D ** -0.5),
        "b_ada": nrm(ks[5], (L, 6 * D), 0.01),
        "norm_mix_g": 1.0 + nrm(ks[6], (L, D), 0.1),
        "norm_ffn_g": 1.0 + nrm(ks[7], (L, D), 0.1),
        "w_in": nrm(ks[8], (L, D, IN_WIDTH), D ** -0.5),
        "b_in": nrm(ks[9], (L, IN_WIDTH), 0.01),
        "sgu_ln_g": 1.0 + nrm(ks[10], (L, SGU_WIDTH), 0.1),
        "sgu_ln_b": nrm(ks[11], (L, SGU_WIDTH), 0.01),
        "sgu_w_s": nrm(ks[12], (L, SGU_GROUPS, CHUNK, CHUNK), CHUNK ** -0.5),
        "sgu_b_s": 1.0 + nrm(ks[13], (L, SGU_GROUPS, CHUNK), 0.1),
        "tiny_w_o": nrm(ks[14], (L, TINY_DIM, SGU_WIDTH), TINY_DIM ** -0.5),
        "na_rpb": nrm(ks[15], (L, NA_HEADS, 2 * NA_ROWS - 1, 2 * NA_COLS - 1), 0.1),
        "w_up_a": nrm(ks[16], (L, SGU_WIDTH, D), SGU_WIDTH ** -0.5),
        "w_up_b": nrm(ks[17], (L, NA_WIDTH, D), NA_WIDTH ** -0.5),
        "w_out": nrm(ks[18], (L, D, D), D ** -0.5),
        "w_router": nrm(ks[19], (L, D, N_EXPERTS), D ** -0.5),
        "b_router": nrm(ks[20], (L, N_EXPERTS), 0.01),
        "w_e_gate": nrm(ks[21], (L, N_EXPERTS, D, EXPERT_FF), D ** -0.5),
        "w_e_up": nrm(ks[22], (L, N_EXPERTS, D, EXPERT_FF), D ** -0.5),
        "w_e_down": nrm(ks[23], (L, N_EXPERTS, EXPERT_FF, D), EXPERT_FF ** -0.5),
        "w_sh_gate": nrm(ks[24], (L, D, SHARED_FF), D ** -0.5),
        "w_sh_up": nrm(ks[25], (L, D, SHARED_FF), D ** -0.5),
        "w_sh_down": nrm(ks[26], (L, SHARED_FF, D), SHARED_FF ** -0.5),
        "final_norm_g": 1.0 + nrm(ks[27], (D,), 0.1),
    }


def reference(x, c, ctx, c_ctx, w_ada, b_ada, norm_mix_g, norm_ffn_g, w_in, b_in,
              sgu_ln_g, sgu_ln_b, sgu_w_s, sgu_b_s, tiny_w_o, na_rpb, w_up_a, w_up_b, w_out,
              w_router, b_router, w_e_gate, w_e_up, w_e_down, w_sh_gate, w_sh_up, w_sh_down,
              final_norm_g):
    for i in range(DEPTH):
        x = hybrid_layer(x, c, ctx, c_ctx, w_ada[i], b_ada[i], norm_mix_g[i], norm_ffn_g[i], w_in[i], b_in[i],
                         sgu_ln_g[i], sgu_ln_b[i], sgu_w_s[i], sgu_b_s[i], tiny_w_o[i], na_rpb[i],
                         w_up_a[i], w_up_b[i], w_out[i], w_router[i], b_router[i],
                         w_e_gate[i], w_e_up[i], w_e_down[i], w_sh_gate[i], w_sh_up[i], w_sh_down[i])
    return rms_norm(x, final_norm_g)
```

```cpp
#define KSTAGE 3
#include <hip/hip_runtime.h>
#include <hip/hip_bf16.h>
#include <cstdio>
#include <cstdint>
#include <cmath>

#define GAS __attribute__((address_space(1)))
#define LAS __attribute__((address_space(3)))
typedef unsigned short bf16_t;
typedef float f32x4 __attribute__((ext_vector_type(4)));
typedef float f32x2 __attribute__((ext_vector_type(2)));
typedef unsigned u32x4 __attribute__((ext_vector_type(4)));
typedef unsigned u32x2 __attribute__((ext_vector_type(2)));
typedef short bf16x8 __attribute__((ext_vector_type(8)));

constexpr int DM = 1024, BATCH = 32, SEQ = 2048, MTOK = BATCH * SEQ, CTXL = 256, MCTX = BATCH * CTXL;
constexpr int IN_W = 5824;
constexpr int COL_U = 0, COL_V = 1024, COL_TQ = 2048, COL_TK = 2112, COL_TV = 2176, COL_NQ = 2240, COL_NK = 2752, COL_NV = 3264, COL_GA = 3776, COL_GB = 4800;
constexpr float NORM_EPS = 1e-6f;
constexpr int NWAVES = 8, NTHREADS = 512;

constexpr int SCR_BYTES = 147456;
constexpr int LDSCTL_OFF = SCR_BYTES, MISC_OFF = LDSCTL_OFF + 320;
constexpr int LDS_BYTES = SCR_BYTES + 2048;

constexpr size_t MiB = 1u << 20;
constexpr size_t WS_CTL = 0, CTL_ZERO_BYTES = 1 * MiB;
constexpr int CW_BAR = 4096, CW_GCOUNT = 8192;
constexpr size_t WS_MOD = 1 * MiB;
constexpr size_t WS_ROPE = 2 * MiB;
constexpr size_t WS_BIN = 2 * MiB + 64 * 1024;
constexpr size_t WS_BT = 2 * MiB + 128 * 1024;
constexpr size_t WS_WIN = 3 * MiB;
constexpr size_t WS_WT = 12 * MiB;
constexpr size_t WS_WUPA = 15 * MiB, WS_WUPB = 17 * MiB, WS_WOUT = 18 * MiB;
constexpr size_t WS_WO = 20 * MiB, WS_WS = 20 * MiB + 256 * 1024, WS_WRH = 20 * MiB + 512 * 1024, WS_WRL = 20 * MiB + 768 * 1024;
constexpr size_t WS_WGU = 24 * MiB;
constexpr size_t WS_WD = 89 * MiB;
constexpr size_t WS_U = 122 * MiB, WS_VT = 250 * MiB, WS_GA = 378 * MiB, WS_GB = 506 * MiB, WS_NQ = 634 * MiB;
constexpr size_t WS_C = 122 * MiB;
constexpr size_t WS_MERGED = WS_VT;
constexpr size_t WS_H = 698 * MiB;
constexpr size_t WS_NK = 827 * MiB, WS_NKC = 891 * MiB, WS_NVT = 899 * MiB, WS_NVCT = 963 * MiB, WS_TQ = 971 * MiB, WS_TKA = 979 * MiB, WS_TVA = 988 * MiB, WS_HC = 997 * MiB;
constexpr size_t WS_ACT = 827 * MiB;
constexpr size_t WS_LCROW = 979 * MiB, WS_LW = 995 * MiB;
constexpr size_t WS_END = 1013 * MiB;
constexpr int MOE_BLK_LDS = 131072;
constexpr int MOE_MAXBLK = 1216;

#ifndef KSTAGE
#define KSTAGE 3
#endif

#define RLX_AGENT __ATOMIC_RELAXED, __HIP_MEMORY_SCOPE_AGENT

#define XB_TMO      128
#define XB_XCNT(j)  (256  + 64 * (j))
#define XB_XSUB(j)  (1280 + 64 * (j))
#define XB_XGEN(j)  (2304 + 64 * (j))
#define XB_TOP      3328
#define XB_TOPGEN   3392
#define XCD_BAR_WORDS 3456
#define XB_SPIN_CAP (1u << 18)
__device__ __forceinline__ unsigned xb_ld(unsigned* p)              { return __hip_atomic_load(p, __ATOMIC_RELAXED, __HIP_MEMORY_SCOPE_AGENT); }
__device__ __forceinline__ unsigned xb_add(unsigned* p, unsigned v) { return __hip_atomic_fetch_add(p, v, __ATOMIC_RELAXED, __HIP_MEMORY_SCOPE_AGENT); }
__device__ __forceinline__ unsigned xb_xcc_id() { return (unsigned)__builtin_amdgcn_s_getreg((3 << 11) | 20) & 0xFu; }
#define XB_SPIN(cond, bar) do { unsigned _sp = 0; while (cond) { __builtin_amdgcn_s_sleep(1); \
    if ((++_sp & 255u) == 0u) { if (xb_ld(&(bar)[XB_TMO])) break; if (_sp > XB_SPIN_CAP) { atomicAdd(&(bar)[XB_TMO], 1u); break; } } } } while (0)
struct XcdBarrier { unsigned* bar; unsigned x; volatile LAS unsigned* st; };
__device__ __forceinline__ XcdBarrier xcd_barrier_post(unsigned* bar, volatile LAS unsigned* st) {
    XcdBarrier b; b.bar = bar; b.x = xb_xcc_id(); b.st = st;
    if (threadIdx.x == 0) (void)xb_add(&bar[XB_XCNT(b.x)], 1u);
    return b;
}
__device__ __forceinline__ void xcd_barrier_complete(unsigned* bar, unsigned x, unsigned& nloc, unsigned& nx) {
    const unsigned G = gridDim.x * gridDim.y * gridDim.z;
    unsigned sum, cnt, mine, sp = 0u;
    for (;;) {
        sum = 0u; cnt = 0u; mine = 0u;
#pragma unroll 1
        for (unsigned j = 0; j < 16; ++j) { const unsigned c = xb_ld(&bar[XB_XCNT(j)]); sum += c; cnt += (c > 0u) ? 1u : 0u; mine = (j == x) ? c : mine; }
        if (sum == G) break;
        __builtin_amdgcn_s_sleep(1);
        if ((++sp & 255u) == 0u) { if (xb_ld(&bar[XB_TMO])) break; if (sp > XB_SPIN_CAP) { atomicAdd(&bar[XB_TMO], 1u); break; } }
    }
    nloc = mine > 0u ? mine : 1u; nx = cnt > 0u ? cnt : 1u;
}
__device__ __forceinline__ void xcd_barrier(const XcdBarrier& b) {
    asm volatile("s_waitcnt vmcnt(0)" ::: "memory");
    __syncthreads();
    if (threadIdx.x == 0) {
        unsigned* bar = b.bar;
        __builtin_amdgcn_s_waitcnt(0);
        unsigned nloc = b.st[0], nx = b.st[1];
        if (nloc == 0u) { xcd_barrier_complete(bar, b.x, nloc, nx); b.st[0] = nloc; b.st[1] = nx; }
        const unsigned old = xb_add(&bar[XB_XSUB(b.x)], 1u);
        const unsigned gen = old / nloc;
        if (old + 1u == (gen + 1u) * nloc) {
            __builtin_amdgcn_fence(__ATOMIC_RELEASE, "agent");
            asm volatile("s_waitcnt vmcnt(0)" ::: "memory");
            const unsigned og = xb_add(&bar[XB_TOP], 1u);
            const unsigned tg = og / nx;
            if (og + 1u == (tg + 1u) * nx) xb_add(&bar[XB_TOPGEN], 1u);
            else XB_SPIN(xb_ld(&bar[XB_TOPGEN]) == tg, bar);
            __builtin_amdgcn_fence(__ATOMIC_ACQUIRE, "agent");
            xb_add(&bar[XB_XGEN(b.x)], 1u);
            asm volatile("s_waitcnt vmcnt(0)" ::: "memory");
        } else {
            XB_SPIN(xb_ld(&bar[XB_XGEN(b.x)]) == gen, bar);
            __builtin_amdgcn_fence(__ATOMIC_ACQUIRE, "agent");
            asm volatile("s_waitcnt vmcnt(0)" ::: "memory");
        }
    }
    __syncthreads();
}

__device__ __forceinline__ float wave_sum(float v) {
#pragma unroll
    for (int o = 1; o < 64; o <<= 1) v += __shfl_xor(v, o);
    return v;
}
__device__ __forceinline__ unsigned f2bf(float f) { unsigned u = __builtin_bit_cast(unsigned, f); return (u + 0x7fffu + ((u >> 16) & 1u)) >> 16; }
__device__ __forceinline__ unsigned pk2(float lo, float hi) { return f2bf(lo) | (f2bf(hi) << 16); }
__device__ __forceinline__ float bf2f(unsigned short b) { return __builtin_bit_cast(float, (unsigned)b << 16); }

namespace pg8 {
#define PG8_LAS __attribute__((address_space(3)))
constexpr int BM = 256, BK = 64, HALF = 128, HTB = HALF * BK * 2, STAGE_BYTES = 8 * HTB, NXCD = 8, WGM = 8;
__host__ __device__ __forceinline__ int lds_byte(int r, int c) { const int st = (r >> 4) * 2 + (c >> 5), rr = r & 15, cc = c & 31, ob = rr * 64 + cc * 2; return st * 1024 + (ob ^ (((ob >> 9) & 1) << 5)); }
__host__ __device__ __forceinline__ void stage_rc(int b, int& R, int& C) { const int st = b / 1024, sb = b % 1024, swz = sb ^ (((sb >> 9) & 1) << 5); R = (st >> 1) * 16 + swz / 64; C = (st & 1) * 32 + (swz % 64) / 2; }
__host__ __device__ __forceinline__ int perm32(int rho) { const int n = rho >> 4, i = rho & 15; return 8 * (i >> 2) + 4 * n + (i & 3); }

struct Unit { int pm, pn, e, r0; };
struct Gemm { const bf16_t* A; const bf16_t* Bt; int K; size_t b_estride; };

struct StaticOrder {
    int nM, nN, nwg, G, c;
    __host__ __device__ void init(int M, int N, int G_, int c_) { nM = M / BM; nN = N / BM; nwg = nM * nN; G = G_; c = c_; }
    __host__ __device__ bool next(int i, Unit& u) const {
        const long L = (long)i * G + c; if (L >= nwg) return false;
        int wgid = (int)L; { const int q = nwg / NXCD, r = nwg % NXCD, xcd = wgid % NXCD, off = wgid / NXCD; wgid = (xcd < r ? xcd * (q + 1) : r * (q + 1) + (xcd - r) * q) + off; }
        const int nig = WGM * nN, gid = wgid / nig, fm = gid * WGM, gsz = (nM - fm) < WGM ? (nM - fm) : WGM;
        u.pm = fm + ((wgid % nig) % gsz); u.pn = (wgid % nig) / gsz; u.e = 0; u.r0 = 0; return true;
    }
    __device__ __forceinline__ unsigned rowoff(const Unit&, int) const { return 0u; }
};

__device__ __forceinline__ unsigned cvt_pk_bf16(float lo, float hi) { unsigned r; asm volatile("v_cvt_pk_bf16_f32 %0, %1, %2" : "=v"(r) : "v"(lo), "v"(hi)); return r; }
__device__ __forceinline__ f32x2 gelu_pk(f32x2 v) {
    const f32x2 av = __builtin_elementwise_abs(v), d = av * 0.2316418882f + 1.0f;
    f32x2 t; t.x = __builtin_amdgcn_rcpf(d.x); t.y = __builtin_amdgcn_rcpf(d.y);
    f32x2 q = t * 0.5307027145f + (-0.7265760135f); q = q * t + 0.7107068705f; q = q * t + (-0.142248368f); q = q * t + 0.127414796f; q = q * t;
    const f32x2 s = (v * v) * (-0.72134752044f);
    f32x2 e; e.x = __builtin_amdgcn_exp2f(s.x); e.y = __builtin_amdgcn_exp2f(s.y);
    const f32x2 m = v * (q * e), r = v - m;
    f32x2 o; o.x = v.x < 0.f ? m.x : r.x; o.y = v.y < 0.f ? m.y : r.y; return o;
}

template <class Epi, class Sched, bool GATHER, bool ALIGN_EPI>
__device__ __forceinline__ void gemm_phase(PG8_LAS unsigned char* lds, const Gemm g, const Sched& S, const Epi& E) {
    int tid = threadIdx.x; asm volatile("" : "+v"(tid));
    const int wid = __builtin_amdgcn_readfirstlane(tid >> 6), lane = tid & 63, wr = wid >> 2, wc = wid & 3, fr = lane & 15, fq = lane >> 4;
    const int K = g.K, nt = K / BK;
    unsigned voffA[2], voffB[2]; int RA[2], CA[2];
#pragma unroll
    for (int i = 0; i < 2; ++i) { int R, C; stage_rc(tid * 16 + i * 8192, R, C); const int Rb = Epi::PERM ? ((R & ~31) + perm32(R & 31)) : R;
        RA[i] = R; CA[i] = C; voffA[i] = (unsigned)(R * K + C) * 2u; voffB[i] = (unsigned)(Rb * K + C) * 2u; }
    const size_t kstep = (size_t)(BK * 2);
    const size_t hstep = (size_t)HALF * K * 2;
    const size_t tstep = 2 * hstep;
    const size_t ahstep = GATHER ? 0 : hstep;
    const unsigned ldsw = (unsigned)wid * 1024u;
    const int aoff = lds_byte(wr * 64 + fr, fq * 8), boff = lds_byte(wc * 32 + fr, fq * 8);
#define PG8_SA(b, h) (((b) * 2 + (h)) * HTB)
#define PG8_SB(b, h) ((4 + (b) * 2 + (h)) * HTB)
#define PG8_STAGE(bufoff, gbase, voff) do { _Pragma("unroll") for (int _i = 0; _i < 2; ++_i) \
        __builtin_amdgcn_global_load_lds((const unsigned*)((const char*)(gbase) + (voff)[_i]), (PG8_LAS unsigned*)(lds + (bufoff) + ldsw + _i * 8192), 16, 0, 0); } while (0)
#define PG8_LDA(dst, b, h) do { _Pragma("unroll") for (int m = 0; m < 4; ++m) _Pragma("unroll") for (int k = 0; k < 2; ++k) dst[m][k] = *(const PG8_LAS bf16x8*)(lds + PG8_SA(b, h) + aoff + m * 2048 + k * 1024); } while (0)
#define PG8_LDB(dst, b, h) do { _Pragma("unroll") for (int n = 0; n < 2; ++n) _Pragma("unroll") for (int k = 0; k < 2; ++k) dst[n][k] = *(const PG8_LAS bf16x8*)(lds + PG8_SB(b, h) + boff + n * 2048 + k * 1024); } while (0)
#define PG8_MMA(ai, bj, At, Bt) do { __builtin_amdgcn_s_setprio(1); _Pragma("unroll") for (int m = 0; m < 4; ++m) _Pragma("unroll") for (int n = 0; n < 2; ++n) _Pragma("unroll") for (int k = 0; k < 2; ++k) \
        acc[ai][bj][m][n] = __builtin_amdgcn_mfma_f32_16x16x32_bf16(Bt[n][k], At[m][k], acc[ai][bj][m][n], 0, 0, 0); __builtin_amdgcn_s_setprio(0); } while (0)
#define PG8_WAIT_V(n) asm volatile("s_waitcnt vmcnt(" #n ")" ::: "memory")
#define PG8_WAIT_L(n) asm volatile("s_waitcnt lgkmcnt(" #n ")" ::: "memory")
#define PG8_BAR __builtin_amdgcn_s_barrier()
#define PG8_SCHED __builtin_amdgcn_sched_barrier(0)
#define PG8_AV0 (GATHER ? vA0 : voffA)
#define PG8_AV1 (GATHER ? vA1 : voffA)
    Unit cur, nxt; int ui = 0;
    if (!S.next(0, cur)) return;
    f32x4 acc[2][2][4][2];
#pragma unroll
    for (int a = 0; a < 2; ++a)
#pragma unroll
        for (int b = 0; b < 2; ++b)
#pragma unroll
            for (int m = 0; m < 4; ++m)
#pragma unroll
                for (int n = 0; n < 2; ++n) acc[a][b][m][n] = (f32x4){0.f, 0.f, 0.f, 0.f};
    bf16x8 At[4][2], B0[2][2], B1[2][2];
    unsigned vA0[2] = {0u, 0u}, vA1[2] = {0u, 0u};
    if constexpr (GATHER) {
#pragma unroll
        for (int i = 0; i < 2; ++i) { vA0[i] = S.rowoff(cur, RA[i]) + (unsigned)CA[i] * 2u; vA1[i] = S.rowoff(cur, HALF + RA[i]) + (unsigned)CA[i] * 2u; }
    }
    const char* cA = GATHER ? (const char*)g.A : (const char*)g.A + (size_t)cur.pm * tstep;
    const char* cB = (const char*)g.Bt + (size_t)cur.e * g.b_estride + (size_t)cur.pn * tstep;
    PG8_STAGE(PG8_SB(0, 0), cB, voffB); PG8_STAGE(PG8_SB(0, 1), cB + hstep, voffB); PG8_STAGE(PG8_SA(0, 0), cA, PG8_AV0); PG8_STAGE(PG8_SA(0, 1), cA + ahstep, PG8_AV1);
    if (wr == 1) PG8_BAR;
    PG8_WAIT_V(2); PG8_BAR;
    PG8_STAGE(PG8_SB(1, 0), cB + kstep, voffB); PG8_STAGE(PG8_SA(1, 0), cA + kstep, PG8_AV0); PG8_STAGE(PG8_SB(1, 1), cB + hstep + kstep, voffB);
    PG8_WAIT_V(6); PG8_BAR;
    for (;;) {
        const bool has_next = S.next(ui + 1, nxt);
        const char* nA = GATHER ? (const char*)g.A : (has_next ? (const char*)g.A + (size_t)nxt.pm * tstep : cA);
        const char* nB = has_next ? (const char*)g.Bt + (size_t)nxt.e * g.b_estride + (size_t)nxt.pn * tstep : cB;
#pragma unroll 1
        for (int t = 0; t < nt; t += 2) {
            const bool last = (t == nt - 2);
            const char* a1 = cA + (size_t)(t + 1) * kstep;
            const char* a2 = last ? nA : cA + (size_t)(t + 2) * kstep; const char* b2 = last ? nB : cB + (size_t)(t + 2) * kstep;
            const char* a3 = a2 + kstep; const char* b3 = b2 + kstep;
            unsigned nA0[2] = {0u, 0u}, nA1[2] = {0u, 0u};
            if constexpr (GATHER) { if (last && has_next) {
#pragma unroll
                for (int i = 0; i < 2; ++i) { nA0[i] = S.rowoff(nxt, RA[i]) + (unsigned)CA[i] * 2u; nA1[i] = S.rowoff(nxt, HALF + RA[i]) + (unsigned)CA[i] * 2u; } } }
            PG8_LDB(B0, 0, 0); PG8_LDB(B1, 0, 1); PG8_SCHED; PG8_LDA(At, 0, 0); PG8_STAGE(PG8_SA(1, 1), a1 + ahstep, PG8_AV1);
            PG8_WAIT_V(8); PG8_WAIT_L(0); PG8_BAR; PG8_MMA(0, 0, At, B0); PG8_MMA(0, 1, At, B1); PG8_BAR; PG8_SCHED;
            if constexpr (GATHER) { if (last && has_next) { vA0[0] = nA0[0]; vA0[1] = nA0[1]; vA1[0] = nA1[0]; vA1[1] = nA1[1]; } }
            PG8_LDA(At, 0, 1); PG8_STAGE(PG8_SB(0, 0), b2, voffB); PG8_STAGE(PG8_SB(0, 1), b2 + hstep, voffB); PG8_STAGE(PG8_SA(0, 0), a2, PG8_AV0);
            PG8_WAIT_V(8); PG8_WAIT_L(0); PG8_BAR; PG8_MMA(1, 0, At, B0); PG8_MMA(1, 1, At, B1); PG8_BAR; PG8_SCHED;
            PG8_LDB(B0, 1, 0); PG8_LDB(B1, 1, 1); PG8_SCHED; PG8_LDA(At, 1, 0); PG8_STAGE(PG8_SA(0, 1), a2 + ahstep, PG8_AV1);
            PG8_WAIT_V(8); PG8_WAIT_L(0); PG8_BAR; PG8_MMA(0, 0, At, B0); PG8_MMA(0, 1, At, B1); PG8_BAR; PG8_SCHED;
            PG8_LDA(At, 1, 1); PG8_STAGE(PG8_SB(1, 0), b3, voffB); PG8_STAGE(PG8_SB(1, 1), b3 + hstep, voffB); PG8_STAGE(PG8_SA(1, 0), a3, PG8_AV0);
            PG8_WAIT_V(8); PG8_WAIT_L(0); PG8_BAR; PG8_MMA(1, 0, At, B0); PG8_MMA(1, 1, At, B1); PG8_BAR; PG8_SCHED;
        }
        if constexpr (ALIGN_EPI) { if (wr == 0) PG8_BAR; }
        E(acc, cur, wr, wc, fr, fq);
        if (!has_next) break;
#pragma unroll
        for (int a = 0; a < 2; ++a)
#pragma unroll
            for (int b = 0; b < 2; ++b)
#pragma unroll
                for (int m = 0; m < 4; ++m)
#pragma unroll
                    for (int n = 0; n < 2; ++n) acc[a][b][m][n] = (f32x4){0.f, 0.f, 0.f, 0.f};
        cur = nxt; cA = nA; cB = nB; ++ui;
        if constexpr (ALIGN_EPI) { if (wr == 1) PG8_BAR; }
    }
    PG8_WAIT_V(0);
    if constexpr (!ALIGN_EPI) { if (wr == 0) PG8_BAR; }
    PG8_BAR;
#undef PG8_SA
#undef PG8_SB
#undef PG8_STAGE
#undef PG8_LDA
#undef PG8_LDB
#undef PG8_MMA
#undef PG8_WAIT_V
#undef PG8_WAIT_L
#undef PG8_BAR
#undef PG8_SCHED
#undef PG8_AV0
#undef PG8_AV1
}
}
#define EPI_ARGS f32x4 (&acc)[2][2][4][2], const pg8::Unit& u, int wr, int wc, int fr, int fq
constexpr float LOG2E = 1.4426950408889634f;
constexpr float TINY_C2 = 0.125f * LOG2E;
constexpr float NA_QS = 0.17677669529663687f * LOG2E;

__device__ __forceinline__ u32x4 pack8(f32x4 a, f32x4 b) { u32x4 w; w.x = pg8::cvt_pk_bf16(a[0], a[1]); w.y = pg8::cvt_pk_bf16(a[2], a[3]); w.z = pg8::cvt_pk_bf16(b[0], b[1]); w.w = pg8::cvt_pk_bf16(b[2], b[3]); return w; }
__device__ __forceinline__ f32x4 gelu4(f32x4 v) { const f32x2 a = pg8::gelu_pk((f32x2){v[0], v[1]}), b = pg8::gelu_pk((f32x2){v[2], v[3]}); return (f32x4){a.x, a.y, b.x, b.y}; }
__device__ __forceinline__ float sigmoidf_(float x) { return __builtin_amdgcn_rcpf(1.f + __builtin_amdgcn_exp2f(-x * LOG2E)); }
__device__ __forceinline__ f32x4 sigmoid4(f32x4 v) { return (f32x4){sigmoidf_(v[0]), sigmoidf_(v[1]), sigmoidf_(v[2]), sigmoidf_(v[3])}; }
__device__ __forceinline__ void unpack8(u32x4 w, f32x4& a, f32x4& b) {
    a = (f32x4){__builtin_bit_cast(float, w.x << 16), __builtin_bit_cast(float, w.x & 0xffff0000u), __builtin_bit_cast(float, w.y << 16), __builtin_bit_cast(float, w.y & 0xffff0000u)};
    b = (f32x4){__builtin_bit_cast(float, w.z << 16), __builtin_bit_cast(float, w.z & 0xffff0000u), __builtin_bit_cast(float, w.w << 16), __builtin_bit_cast(float, w.w & 0xffff0000u)};
}

struct EpiMain {
    static constexpr bool PERM = true;
    int mode; const float* bias; unsigned char* ws;
    __device__ __forceinline__ void operator()(EPI_ARGS) const {
        const int tile = mode == 0 ? u.pn : u.pn + 14;
        const int bcol0 = u.pn * 256 + wc * 32 + 8 * fq;
#pragma unroll
        for (int bj = 0; bj < 2; ++bj)
#pragma unroll
            for (int n = 0; n < 2; ++n) { const f32x4 bv = *(const f32x4*)(bias + bcol0 + bj * 128 + 4 * n);
#pragma unroll
                for (int ai = 0; ai < 2; ++ai)
#pragma unroll
                    for (int m = 0; m < 4; ++m) acc[ai][bj][m][n] += bv; }
        const int row0 = u.pm * 256 + wr * 64 + fr;
        if (tile < 12) {
            const size_t woff = tile < 4 ? WS_U : (tile < 8 ? WS_GA : WS_GB);
            bf16_t* O = (bf16_t*)(ws + woff); const int col0 = (tile & 3) * 256 + wc * 32 + 8 * fq;
#pragma unroll
            for (int ai = 0; ai < 2; ++ai)
#pragma unroll
                for (int m = 0; m < 4; ++m) { bf16_t* rowp = O + (size_t)(row0 + ai * 128 + m * 16) * 1024 + col0;
#pragma unroll
                    for (int bj = 0; bj < 2; ++bj) { f32x4 v0 = acc[ai][bj][m][0], v1 = acc[ai][bj][m][1];
                        if (tile < 4) { v0 = gelu4(v0); v1 = gelu4(v1); } else { v0 = sigmoid4(v0); v1 = sigmoid4(v1); }
                        *(u32x4*)(rowp + bj * 128) = pack8(v0, v1); } }
        } else {
            const size_t woff = tile < 14 ? WS_NQ : (mode == 0 ? WS_NK : WS_NKC);
            bf16_t* O = (bf16_t*)(ws + woff); const float sc = tile < 14 ? NA_QS : 1.f; const int col0 = (tile & 1) * 256 + wc * 32 + 8 * fq;
#pragma unroll
            for (int ai = 0; ai < 2; ++ai)
#pragma unroll
                for (int m = 0; m < 4; ++m) { bf16_t* rowp = O + (size_t)(row0 + ai * 128 + m * 16) * 512 + col0;
#pragma unroll
                    for (int bj = 0; bj < 2; ++bj) *(u32x4*)(rowp + bj * 128) = pack8(acc[ai][bj][m][0] * sc, acc[ai][bj][m][1] * sc); }
        }
    }
};
template <int MODE> struct EpiTT {
    static constexpr bool PERM = true;
    const float* bias; bf16_t *TQ, *TKA, *TVA; const float* rope;
    __device__ __forceinline__ void operator()(EPI_ARGS) const {
        const int bcol0 = wc * 32 + 8 * fq;
        const int row0 = u.pm * 256 + wr * 64 + fr;
        const int axis = wc & 1; const int c32 = (wc & 1) * 32 + 8 * fq;
        const f32x4 b00 = *(const f32x4*)(bias + bcol0), b01 = *(const f32x4*)(bias + bcol0 + 4), b10 = *(const f32x4*)(bias + bcol0 + 128), b11 = *(const f32x4*)(bias + bcol0 + 132);
#pragma unroll
        for (int ai = 0; ai < 2; ++ai)
#pragma unroll
            for (int m = 0; m < 4; ++m) {
                const int row = row0 + ai * 128 + m * 16;
                int b, s; size_t kvrow;
                if (MODE == 0) { b = row >> 11; s = row & 2047; kvrow = (size_t)b * 2304 + s; } else { b = row >> 8; s = row & 255; kvrow = (size_t)b * 2304 + 2048 + s; }
                f32x4 v0 = acc[ai][0][m][0] + b00, v1 = acc[ai][0][m][1] + b01;
                if (MODE == 0) {
                    const int pos = axis == 0 ? (s >> 6) : (s & 63);
                    const f32x4 cs0 = *(const f32x4*)(rope + ((axis * 64 + pos) * 16 + 4 * fq) * 2), cs1 = *(const f32x4*)(rope + ((axis * 64 + pos) * 16 + 4 * fq + 2) * 2);
                    v0 = (f32x4){v0[0] * cs0[0] - v0[1] * cs0[1], v0[1] * cs0[0] + v0[0] * cs0[1], v0[2] * cs0[2] - v0[3] * cs0[3], v0[3] * cs0[2] + v0[2] * cs0[3]};
                    v1 = (f32x4){v1[0] * cs1[0] - v1[1] * cs1[1], v1[1] * cs1[0] + v1[0] * cs1[1], v1[2] * cs1[2] - v1[3] * cs1[3], v1[3] * cs1[2] + v1[2] * cs1[3]};
                }
                if (wc < 2) { if (MODE == 0) *(u32x4*)(TQ + (size_t)row * 64 + c32) = pack8(v0 * TINY_C2, v1 * TINY_C2); }
                else *(u32x4*)(TKA + kvrow * 64 + c32) = pack8(v0, v1);
                if (wc < 2) *(u32x4*)(TVA + kvrow * 64 + c32) = pack8(acc[ai][1][m][0] + b10, acc[ai][1][m][1] + b11);
            }
    }
};

struct EpiT {
    static constexpr bool PERM = true;
    unsigned char* ws; const float* biasT; int ldc, pm_off, ctx;
    __device__ __forceinline__ void operator()(EPI_ARGS) const {
        const int rt = u.pm + pm_off;
        const int col0 = u.pn * 256 + wc * 32 + 8 * fq;
        const size_t woff = rt < 4 ? WS_VT : (ctx ? WS_NVCT : WS_NVT);
        bf16_t* O = (bf16_t*)(ws + woff);
#pragma unroll
        for (int ai = 0; ai < 2; ++ai)
#pragma unroll
            for (int m = 0; m < 4; ++m) {
                const int ch = rt * 256 + ai * 128 + wr * 64 + m * 16 + fr; const float bv = biasT[ch];
                bf16_t* rowp = O + (size_t)(rt < 4 ? ch : ch - 1024) * ldc + col0;
#pragma unroll
                for (int bj = 0; bj < 2; ++bj) { f32x4 v0 = acc[ai][bj][m][0] + bv, v1 = acc[ai][bj][m][1] + bv;
                    if (rt < 4) { v0 = gelu4(v0); v1 = gelu4(v1); }
                    *(u32x4*)(rowp + bj * 128) = pack8(v0, v1); } }
    }
};

struct EpiGate {
    static constexpr bool PERM = true;
    const bf16_t* gate; const bf16_t* addend; bf16_t* out;
    __device__ __forceinline__ void operator()(EPI_ARGS) const {
        const int row0 = u.pm * 256 + wr * 64 + fr, col0 = u.pn * 256 + wc * 32 + 8 * fq;
#pragma unroll
        for (int ai = 0; ai < 2; ++ai)
#pragma unroll
            for (int m = 0; m < 4; ++m) { const size_t off = (size_t)(row0 + ai * 128 + m * 16) * 1024 + col0;
#pragma unroll
                for (int bj = 0; bj < 2; ++bj) { f32x4 g0, g1; unpack8(*(const u32x4*)(gate + off + bj * 128), g0, g1);
                    f32x4 o0 = g0 * acc[ai][bj][m][0], o1 = g1 * acc[ai][bj][m][1];
                    if (addend) { f32x4 a0, a1; unpack8(*(const u32x4*)(addend + off + bj * 128), a0, a1); o0 += a0; o1 += a1; }
                    *(u32x4*)(out + off + bj * 128) = pack8(o0, o1); } }
    }
};

struct EpiXmid {
    static constexpr bool PERM = false;
    const float* x; const float* mod; float* xmid;
    __device__ __forceinline__ void operator()(EPI_ARGS) const {
        const int row0 = u.pm * 256 + wr * 64 + fr, col0 = u.pn * 256 + wc * 32 + 4 * fq;
        const float* gm = mod + (size_t)(u.pm >> 3) * 6144 + 2048;
        f32x4 gv[2][2];
#pragma unroll
        for (int bj = 0; bj < 2; ++bj)
#pragma unroll
            for (int n = 0; n < 2; ++n) gv[bj][n] = *(const f32x4*)(gm + col0 + bj * 128 + n * 16);
#pragma unroll
        for (int ai = 0; ai < 2; ++ai)
#pragma unroll
            for (int m = 0; m < 4; ++m) { const size_t off = (size_t)(row0 + ai * 128 + m * 16) * 1024 + col0;
#pragma unroll
                for (int bj = 0; bj < 2; ++bj)
#pragma unroll
                    for (int n = 0; n < 2; ++n) { const f32x4 xv = *(const f32x4*)(x + off + bj * 128 + n * 16); *(f32x4*)(xmid + off + bj * 128 + n * 16) = xv + gv[bj][n] * acc[ai][bj][m][n]; } }
    }
};

struct EpiMoeGU {
    static constexpr bool PERM = true;
    bf16_t* act;
    __device__ __forceinline__ void operator()(EPI_ARGS) const {
        const int row0 = u.pm * 256 + wr * 64 + fr, col0 = u.pn * 128 + wc * 32 + 8 * fq;
#pragma unroll
        for (int ai = 0; ai < 2; ++ai)
#pragma unroll
            for (int m = 0; m < 4; ++m) { f32x4 o[2];
#pragma unroll
                for (int n = 0; n < 2; ++n) { const f32x4 g = acc[ai][0][m][n], up = acc[ai][1][m][n]; o[n] = g * sigmoid4(g) * up; }
                *(u32x4*)(act + (size_t)(row0 + ai * 128 + m * 16) * 256 + col0) = pack8(o[0], o[1]); }
    }
};

struct MoeLists { const int* crow; const float* w; const unsigned* cnt; };
__device__ __forceinline__ bool moe_lookup(const MoeLists& L, int e, int idx, int& crow, float& w) {
    if (e == 64) { crow = idx * 9 + 8; w = 1.f; return true; }
    if (idx >= (int)L.cnt[e]) { crow = 0; w = 0.f; return false; }
    crow = L.crow[(size_t)e * 32768 + idx]; w = L.w[(size_t)e * 32768 + idx]; return true;
}
struct EpiMoeDown {
    static constexpr bool PERM = true;
    bf16_t* C; MoeLists L;
    __device__ __forceinline__ void operator()(EPI_ARGS) const {
        const int col0 = u.pn * 256 + wc * 32 + 8 * fq;
#pragma unroll
        for (int ai = 0; ai < 2; ++ai)
#pragma unroll
            for (int m = 0; m < 4; ++m) { int crow; float w; const bool ok = moe_lookup(L, u.e, u.r0 + ai * 128 + wr * 64 + m * 16 + fr, crow, w);
                if (ok) { bf16_t* rowp = C + (size_t)crow * 1024 + col0;
#pragma unroll
                    for (int bj = 0; bj < 2; ++bj) *(u32x4*)(rowp + bj * 128) = pack8(acc[ai][bj][m][0] * w, acc[ai][bj][m][1] * w); }
                if (m & 1) asm volatile("" ::: "memory"); }
    }
};

struct MoeOrder {
    const volatile LAS unsigned* blk; int nblk, NT, G, c; MoeLists L; int K2, hb;
    __device__ __forceinline__ bool next(int i, pg8::Unit& u) const {
        const int Lq = i * G + c; if (Lq >= nblk * NT) return false;
        const int j = Lq / NT; const unsigned v = (unsigned)__builtin_amdgcn_readfirstlane((int)blk[j]);
        u.pm = j; u.pn = Lq - j * NT; u.e = (int)(v >> 16); u.r0 = (int)(v & 0xffffu) * 256; return true;
    }
    __device__ __forceinline__ unsigned rowoff(const pg8::Unit& u, int r) const {
        int crow; float w; const bool ok = moe_lookup(L, u.e, u.r0 + r, crow, w);
        const int tok = ok ? hb + crow / 9 : MTOK;
        return (unsigned)tok * (unsigned)K2;
    }
};
struct Frame {
    LAS unsigned char* lds; volatile LAS unsigned* MISC; unsigned* ctl;
    int tid, lane, wave, vcu, G;
};
#define LDS_WAIT() asm volatile("s_waitcnt lgkmcnt(0)" ::: "memory")

__device__ __forceinline__ void p0_adaln(Frame& F, const float* c, const float* c_ctx, const float* w_ada, const float* b_ada, float* mod) {
    LAS float* s = (LAS float*)F.lds;
    for (int i = F.tid; i < 33 * 1024; i += NTHREADS) { const float v = (i < 32 * 1024) ? c[i] : c_ctx[i - 32 * 1024]; s[i] = v / (1.f + __expf(-v)); }
    __syncthreads();
    for (int cb = F.vcu; cb < 256; cb += F.G) {
        const int n0 = cb * 24 + F.wave * 3;
        float acc[3][33];
#pragma unroll
        for (int j = 0; j < 3; ++j)
#pragma unroll
            for (int b = 0; b < 33; ++b) acc[j][b] = 0.f;
        for (int i = 0; i < 16; ++i) {
            const int k = F.lane + 64 * i;
            const float w0 = w_ada[(size_t)k * 6144 + n0], w1 = w_ada[(size_t)k * 6144 + n0 + 1], w2 = w_ada[(size_t)k * 6144 + n0 + 2];
#pragma unroll
            for (int b = 0; b < 33; ++b) { const float sv = s[b * 1024 + k]; acc[0][b] += sv * w0; acc[1][b] += sv * w1; acc[2][b] += sv * w2; }
        }
#pragma unroll
        for (int j = 0; j < 3; ++j)
#pragma unroll
            for (int b = 0; b < 33; ++b) { const float t = wave_sum(acc[j][b]); if (F.lane == 0) mod[b * 6144 + n0 + j] = t + b_ada[n0 + j]; }
    }
    __syncthreads();
}

__device__ __forceinline__ void tr_block(const float* W, int ldw, int k0, int n0, bf16_t* WT, int ldk, int drow0, LAS float* scr, int lane) {
#pragma unroll 8
    for (int i = 0; i < 32; ++i) { const int kk = 2 * i + (lane >> 5); scr[kk * 33 + (lane & 31)] = W[(size_t)(k0 + kk) * ldw + n0 + (lane & 31)]; }
    LDS_WAIT(); asm volatile("" ::: "memory");
    const int c = lane & 7;
#pragma unroll
    for (int j = 0; j < 4; ++j) { const int n = (lane >> 3) + 8 * j; const LAS float* s = scr + (8 * c) * 33 + n;
        u32x4 o; o.x = pk2(s[0 * 33], s[1 * 33]); o.y = pk2(s[2 * 33], s[3 * 33]); o.z = pk2(s[4 * 33], s[5 * 33]); o.w = pk2(s[6 * 33], s[7 * 33]);
        *(u32x4*)(WT + (size_t)(drow0 + n) * ldk + k0 + 8 * c) = o; }
    LDS_WAIT(); asm volatile("" ::: "memory");
}
struct TrJob { const float* W; bf16_t* WT; int ldw, K, ncols, n0, drow0, nrep, mode; size_t wrs, wtrs; };
__device__ __forceinline__ int trjob_items(const TrJob& j) { return j.nrep * (j.K / 64) * (j.ncols / 32); }
__device__ __forceinline__ void trjob_run(const TrJob& j, int item, LAS float* scr, int lane) {
    const int per = (j.K / 64) * (j.ncols / 32); const int rep = item / per, r = item - rep * per; const int nblk = j.ncols / 32, kb = r / nblk, nb = r - kb * nblk;
    int drow = j.drow0 + 32 * nb;
    if (j.mode != 0) { const int c0 = 32 * nb; drow = j.drow0 + 256 * (c0 >> 7) + (c0 & 127) + (j.mode == 2 ? 128 : 0); }
    tr_block(j.W + (size_t)rep * j.wrs, j.ldw, 64 * kb, j.n0 + 32 * nb, j.WT + (size_t)rep * j.wtrs, j.K, drow, scr, lane);
}

__device__ __forceinline__ void norm_mod_row(const float* xrow, const float* g, const float* shift, const float* scale, bf16_t* orow, int lane) {
    const f32x4* xr = (const f32x4*)xrow + lane;
    f32x4 v[4]; float s = 0.f;
#pragma unroll
    for (int j = 0; j < 4; ++j) { v[j] = xr[64 * j]; s += (v[j].x * v[j].x + v[j].y * v[j].y) + (v[j].z * v[j].z + v[j].w * v[j].w); }
    const float r = 1.f / sqrtf(wave_sum(s) * (1.f / DM) + NORM_EPS);
    u32x2* o8 = (u32x2*)orow + lane;
#pragma unroll
    for (int j = 0; j < 4; ++j) { const f32x4 gv = ((const f32x4*)g)[lane + 64 * j], sh = ((const f32x4*)shift)[lane + 64 * j], sc = ((const f32x4*)scale)[lane + 64 * j];
        const f32x4 h = v[j] * r * gv * (sc + 1.f) + sh; u32x2 w; w.x = pk2(h.x, h.y); w.y = pk2(h.z, h.w); o8[64 * j] = w; }
}

namespace tattn {
using f32x16 = __attribute__((ext_vector_type(16))) float;
using s16x4 = __attribute__((ext_vector_type(4))) short;
constexpr int TP = 64;
constexpr int NW = 8, QBLK = 32, QB = QBLK * NW, KVBLK = 64;
__device__ __forceinline__ int crow(int r, int hi) { return (r & 3) + 8 * (r >> 2) + 4 * hi; }
#define SBAR() __builtin_amdgcn_sched_barrier(0)
constexpr int NSLOT = 3, SLOTB = 8192;
constexpr int LDS_K = 0, LDS_V = NSLOT * SLOTB, LDS_WS = 2 * NSLOT * SLOTB, LDS_OST = LDS_WS + NW * 64 * 4, LDS_BYTES_T = LDS_OST + NW * 4096;
__device__ __forceinline__ void glds16(const void* gsrc, unsigned lds_dst) { unsigned keep;
    asm volatile("s_mov_b32 %0, m0\n\ts_mov_b32 m0, %2\n\ts_nop 0\n\tglobal_load_lds_dwordx4 %1, off\n\ts_mov_b32 m0, %0" : "=&s"(keep) : "v"(gsrc), "s"(lds_dst) : "memory"); }
__device__ __forceinline__ float max3f(float a, float b, float c) { float r; asm("v_max3_f32 %0, %1, %2, %3" : "=v"(r) : "v"(a), "v"(b), "v"(c)); return r; }
__device__ __forceinline__ float max2f(float a, float b) { float r; asm("v_max_f32_e32 %0, %1, %2" : "=v"(r) : "v"(a), "v"(b)); return r; }
__device__ __forceinline__ float fadd_s(float a, float b) { float r; asm("v_add_f32_e32 %0, %1, %2" : "=v"(r) : "v"(a), "v"(b)); return r; }
__device__ __forceinline__ float fsub_s(float a, float b) { float r; asm("v_sub_f32_e32 %0, %1, %2" : "=v"(r) : "v"(a), "v"(b)); return r; }
typedef float f32x2_t __attribute__((ext_vector_type(2))); typedef __bf16 bf16x2_t __attribute__((ext_vector_type(2)));
__device__ __forceinline__ unsigned cvtpk_s(float lo, float hi) { f32x2_t v = {lo, hi}; bf16x2_t b = __builtin_convertvector(v, bf16x2_t); return __builtin_bit_cast(unsigned, b); }
#define WAIT_BAR(N) asm volatile("s_waitcnt vmcnt(" #N ") lgkmcnt(0)\n\ts_barrier" ::: "memory")
__device__ __forceinline__ void qkt(f32x16& p0, f32x16& p1, const char* Kslot, const bf16x8* qr, const f32x16& negm, int r32, int hi) {
    const char* kb = Kslot + hi * 1024 + r32 * 16;
#pragma unroll
    for (int d0 = 0; d0 < 4; ++d0) {
        const bf16x8 b0 = *reinterpret_cast<const bf16x8*>(kb + d0 * 2048);
        const bf16x8 b1 = *reinterpret_cast<const bf16x8*>(kb + d0 * 2048 + 512);
        if (d0 == 0) { p0 = __builtin_amdgcn_mfma_f32_32x32x16_bf16(b0, qr[0], negm, 0, 0, 0); p1 = __builtin_amdgcn_mfma_f32_32x32x16_bf16(b1, qr[0], negm, 0, 0, 0); }
        else { p0 = __builtin_amdgcn_mfma_f32_32x32x16_bf16(b0, qr[d0], p0, 0, 0, 0); p1 = __builtin_amdgcn_mfma_f32_32x32x16_bf16(b1, qr[d0], p1, 0, 0, 0); } }
}
typedef __attribute__((address_space(3))) const char* lds_cptr;
typedef short v4i16_t __attribute__((ext_vector_type(4)));
__device__ __forceinline__ void kload8(bf16x8* kf, lds_cptr kp) {
    kf[0] = *(const __attribute__((address_space(3))) bf16x8*)(kp);        kf[1] = *(const __attribute__((address_space(3))) bf16x8*)(kp + 512);
    kf[2] = *(const __attribute__((address_space(3))) bf16x8*)(kp + 2048); kf[3] = *(const __attribute__((address_space(3))) bf16x8*)(kp + 2560);
    kf[4] = *(const __attribute__((address_space(3))) bf16x8*)(kp + 4096); kf[5] = *(const __attribute__((address_space(3))) bf16x8*)(kp + 4608);
    kf[6] = *(const __attribute__((address_space(3))) bf16x8*)(kp + 6144); kf[7] = *(const __attribute__((address_space(3))) bf16x8*)(kp + 6656);
}
__device__ __forceinline__ void kload2(bf16x8* kf, lds_cptr kp, int j) { kf[2 * j] = *(const __attribute__((address_space(3))) bf16x8*)(kp + j * 2048); kf[2 * j + 1] = *(const __attribute__((address_space(3))) bf16x8*)(kp + j * 2048 + 512); }
__device__ __forceinline__ s16x4 vtr(lds_cptr p) { return __builtin_bit_cast(s16x4, __builtin_amdgcn_ds_read_tr16_b64_v4i16((__attribute__((address_space(3))) v4i16_t*)p)); }
__device__ __forceinline__ float rowmax(const f32x16& p0, const f32x16& p1) {
    float a = max3f(p0[0], p0[1], p1[0]), b = max3f(p0[2], p0[3], p1[1]); a = max3f(a, p1[2], p1[3]);
#pragma unroll
    for (int r = 4; r < 16; r += 4) { a = max3f(a, p0[r], p0[r + 1]); b = max3f(b, p0[r + 2], p0[r + 3]); a = max3f(a, p1[r], p1[r + 1]); b = max3f(b, p1[r + 2], p1[r + 3]); }
    const float m = max2f(a, b);
    auto rr = __builtin_amdgcn_permlane32_swap(__float_as_uint(m), __float_as_uint(m), false, false);
    return max2f(__uint_as_float(rr[0]), __uint_as_float(rr[1]));
}
__device__ __forceinline__ void pv(f32x16* o, int vb, bf16x8 pa0, bf16x8 pa1, bf16x8 pa2, bf16x8 pa3) {
#pragma unroll
    for (int d0 = 0; d0 < 2; ++d0) { s16x4 lo[4], hi[4];
#pragma unroll
        for (int ks = 0; ks < 4; ++ks) {
            asm volatile("ds_read_b64_tr_b16 %0,%1 offset:%c2" : "=&v"(lo[ks]) : "v"(vb), "i"(d0 * 4096 + ks * 1024) : "memory");
            asm volatile("ds_read_b64_tr_b16 %0,%1 offset:%c2" : "=&v"(hi[ks]) : "v"(vb), "i"(d0 * 4096 + ks * 1024 + 512) : "memory"); }
        asm volatile("s_waitcnt lgkmcnt(0)" ::: "memory"); SBAR();
#define PK(k) (bf16x8){lo[k][0], lo[k][1], lo[k][2], lo[k][3], hi[k][0], hi[k][1], hi[k][2], hi[k][3]}
        o[d0] = __builtin_amdgcn_mfma_f32_32x32x16_bf16(pa0, PK(0), o[d0], 0, 0, 0);
        o[d0] = __builtin_amdgcn_mfma_f32_32x32x16_bf16(pa1, PK(1), o[d0], 0, 0, 0);
        o[d0] = __builtin_amdgcn_mfma_f32_32x32x16_bf16(pa2, PK(2), o[d0], 0, 0, 0);
        o[d0] = __builtin_amdgcn_mfma_f32_32x32x16_bf16(pa3, PK(3), o[d0], 0, 0, 0);
#undef PK
    }
}
template <int THRL, int NKEYS> __device__ __forceinline__ void attn_unit(const bf16_t* Qu, const bf16_t* __restrict__ Kb, const bf16_t* __restrict__ Vb, bf16_t* Ou, char* shm) {
    const int tid = threadIdx.x, lane = tid & 63, r32 = lane & 31, hi = lane >> 5; const int wid = __builtin_amdgcn_readfirstlane(tid >> 6);
    const bf16_t* Qw = Qu + (long)(wid * QBLK) * TP;
    const bf16_t *Kh = Kb, *Vh = Vb;
    const unsigned lds0 = (unsigned)(uintptr_t)shm;
    float* wsf = (float*)(shm + LDS_WS) + wid * 64;
    const bf16_t* ksrc = Kh + (long)lane * TP + wid * 8;
    const bf16_t* vsrc = Vh + (long)(16 * (wid & 3) + (lane >> 2)) * TP + (wid >> 2) * 32 + (lane & 3) * 8;
    const unsigned kdst = lds0 + LDS_K + wid * 1024, vdst = lds0 + LDS_V + wid * 1024;
#define DMA_K(t, slot) glds16(ksrc + (long)(t) * KVBLK * TP, (unsigned)__builtin_amdgcn_readfirstlane(kdst + (slot)))
#define DMA_V(t, slot) glds16(vsrc + (long)(t) * KVBLK * TP, (unsigned)__builtin_amdgcn_readfirstlane(vdst + (slot)))
    const int vb0 = (int)(lds0 + LDS_V) + ((lane >> 4) & 1) * 32 + (lane & 3) * 8 + (4 * hi + ((lane & 15) >> 2)) * 64;
    const char* Kbase = shm + LDS_K; bf16x8 kf[8];
    const lds_cptr shm3 = (lds_cptr)shm; const lds_cptr kp0 = shm3 + LDS_K + hi * 1024 + r32 * 16; const lds_cptr vp0 = shm3 + LDS_V + ((lane >> 4) & 1) * 32 + (lane & 3) * 8 + (4 * hi + ((lane & 15) >> 2)) * 64;
    constexpr int NT = NKEYS / KVBLK;
    static_assert(NT % 2 == 0 && NT >= 8, "NT even");
    DMA_K(0, 0); DMA_V(0, 0); DMA_K(1, SLOTB);
    bf16x8 qr[4];
#pragma unroll
    for (int d0 = 0; d0 < 4; ++d0) qr[d0] = *reinterpret_cast<const bf16x8*>(&Qw[(long)r32 * TP + d0 * 16 + hi * 8]);
    float mhat = 0.f, l_reg = 0.f; f32x16 o[2]; o[0] = f32x16{}; o[1] = f32x16{}; f32x16 negm = f32x16{}; asm volatile("" : "+v"(negm));
    bool resc = false;
#define START(P0, P1) do { const float rm = rowmax(P0, P1); resc = false; \
    { const float dl = rm; mhat = fadd_s(mhat, dl); \
      _Pragma("unroll") for (int r = 0; r < 16; ++r) { P0[r] = fsub_s(P0[r], dl); P1[r] = fsub_s(P1[r], dl); } \
      _Pragma("unroll") for (int r = 0; r < 16; ++r) negm[r] = -mhat; asm volatile("" : "+v"(negm)); } \
    _Pragma("unroll") for (int r = 0; r < 16; ++r) P0[r] = __builtin_amdgcn_exp2f(P0[r]); } while (0)
#define RESC() do { if (resc) { asm volatile("s_waitcnt lgkmcnt(0)" ::: "memory"); \
      _Pragma("unroll") for (int d_ = 0; d_ < 2; ++d_) _Pragma("unroll") for (int r = 0; r < 16; ++r) o[d_][r] *= wsf[crow(r, hi)]; } } while (0)
    f32x16 pA0, pA1, pB0, pB1;
    int sl_prev = 0, sl_cur = 0, sl_next = SLOTB;
#define ROT() do { sl_prev = sl_cur; sl_cur = sl_next; sl_next = (sl_next == (NSLOT - 1) * SLOTB) ? 0 : sl_next + SLOTB; } while (0)
    DMA_K(2, 2 * SLOTB);
    WAIT_BAR(3);
    qkt(pA0, pA1, Kbase, qr, negm, r32, hi); asm volatile("s_nop 15\n\ts_nop 7" : "+v"(pA0), "+v"(pA1));
    START(pA0, pA1);
    _Pragma("unroll") for (int r = 0; r < 16; ++r) pA1[r] = __builtin_amdgcn_exp2f(pA1[r]);
    WAIT_BAR(0);
    DMA_K(3, 0); DMA_V(1, SLOTB);
    ROT();
    kload8(kf, kp0 + sl_cur);
    WAIT_BAR(2);
    s16x4 vlo[8], vhi[8]; u32x4 pw0, pw1, pw2, pw3;
#define PKW(P, B) cvtpk_s(P[B], P[B + 1])
#define PAF(k) __builtin_bit_cast(bf16x8, pw##k)
#define VFR(i) (bf16x8){vlo[i][0], vlo[i][1], vlo[i][2], vlo[i][3], vhi[i][0], vhi[i][1], vhi[i][2], vhi[i][3]}
#define PIN(x) asm volatile("" : "+v"(x))
#define MX3(a, b, c) __builtin_fmaxf(__builtin_fmaxf((a), (b)), (c))
#define GAPA(MF, A0, A1, A2, A3, W0, W1, PW) do { MF; sacc += A0; sacc += A1; sacc += A2; sacc += A3; PIN(sacc); W0; W1; PIN(PW); SBAR(); } while (0)
#define EX(v) __builtin_amdgcn_exp2f(v)
#define GAPB(MF, X, B) do { MF; X[B] = EX(X[B]); X[B + 1] = EX(X[B + 1]); X[B + 2] = EX(X[B + 2]); X[B + 3] = EX(X[B + 3]); PIN(X); SBAR(); } while (0)
#define VRD(i) do { vlo[i] = vtr(vp_ + (((i) >> 2) * 4096 + ((i) & 3) * 1024)); vhi[i] = vtr(vp_ + (((i) >> 2) * 4096 + ((i) & 3) * 1024 + 512)); } while (0)
#define KRD(G, j) do { if (G) { kload2(kf, kp0 + sl_next, j); SBAR(); } } while (0)
#define STEP(C0, C1, P0, P1, t, GK, GV, GL) do { SBAR(); \
    const lds_cptr vp_ = vp0 + sl_prev; \
    VRD(0); SBAR(); float sacc = (P0[0] + P0[1]); \
    GAPA(C0 = __builtin_amdgcn_mfma_f32_32x32x16_bf16(kf[0], qr[0], negm, 0, 0, 0), P0[2], P0[3], P0[4], P0[5],     pw0[0] = PKW(P0, 0), pw0[1] = PKW(P0, 2), pw0); \
    VRD(4); SBAR(); GAPA(C1 = __builtin_amdgcn_mfma_f32_32x32x16_bf16(kf[1], qr[0], negm, 0, 0, 0), P0[6], P0[7], P0[8], P0[9],     pw0[2] = PKW(P0, 4), pw0[3] = PKW(P0, 6), pw0); \
    VRD(1); SBAR(); GAPA(C0 = __builtin_amdgcn_mfma_f32_32x32x16_bf16(kf[2], qr[1], C0, 0, 0, 0),   P0[10], P0[11], P0[12], P0[13], pw1[0] = PKW(P0, 8), pw1[1] = PKW(P0, 10), pw1); \
    VRD(5); SBAR(); GAPA(C1 = __builtin_amdgcn_mfma_f32_32x32x16_bf16(kf[3], qr[1], C1, 0, 0, 0),   P0[14], P0[15], P1[0], P1[1],   pw1[2] = PKW(P0, 12), pw1[3] = PKW(P0, 14), pw1); \
    VRD(2); SBAR(); GAPA(C0 = __builtin_amdgcn_mfma_f32_32x32x16_bf16(kf[4], qr[2], C0, 0, 0, 0),   P1[2], P1[3], P1[4], P1[5],     pw2[0] = PKW(P1, 0), pw2[1] = PKW(P1, 2), pw2); \
    VRD(6); SBAR(); GAPA(C1 = __builtin_amdgcn_mfma_f32_32x32x16_bf16(kf[5], qr[2], C1, 0, 0, 0),   P1[6], P1[7], P1[8], P1[9],     pw2[2] = PKW(P1, 4), pw2[3] = PKW(P1, 6), pw2); \
    VRD(3); SBAR(); GAPA(C0 = __builtin_amdgcn_mfma_f32_32x32x16_bf16(kf[6], qr[3], C0, 0, 0, 0),   P1[10], P1[11], P1[12], P1[13], pw3[0] = PKW(P1, 8), pw3[1] = PKW(P1, 10), pw3); \
    VRD(7); SBAR(); GAPA(C1 = __builtin_amdgcn_mfma_f32_32x32x16_bf16(kf[7], qr[3], C1, 0, 0, 0),   P1[14], P1[15], 0.f, 0.f,       pw3[2] = PKW(P1, 12), pw3[3] = PKW(P1, 14), pw3); \
    l_reg += sacc; \
    if (GK) { DMA_K((t) + 3, sl_cur); } if (GV) { DMA_V((t) + 1, sl_next); } \
    { float a = MX3(C0[0], C0[1], C1[0]), b = MX3(C0[2], C0[3], C1[1]); a = MX3(a, C1[2], C1[3]); \
      _Pragma("unroll") for (int r = 4; r < 16; r += 4) { a = MX3(a, C0[r], C0[r + 1]); b = MX3(b, C0[r + 2], C0[r + 3]); a = MX3(a, C1[r], C1[r + 1]); b = MX3(b, C1[r + 2], C1[r + 3]); } \
      float rm = __builtin_fmaxf(a, b); { auto rr = __builtin_amdgcn_permlane32_swap(__float_as_uint(rm), __float_as_uint(rm), false, false); rm = __builtin_fmaxf(__uint_as_float(rr[0]), __uint_as_float(rr[1])); } \
      resc = false; \
      if (__builtin_expect(__any(rm > (float)THRL), 0)) { const float dl = __builtin_fmaxf(rm, 0.f); mhat += dl; \
        _Pragma("unroll") for (int r = 0; r < 16; ++r) { C0[r] -= dl; C1[r] -= dl; } \
        _Pragma("unroll") for (int r = 0; r < 16; ++r) negm[r] = -mhat; asm volatile("" : "+v"(negm)); \
        const float f = __builtin_amdgcn_exp2f(-dl); l_reg *= f; if (hi == 0) wsf[r32] = f; resc = true; } } \
    SBAR(); \
    GAPB(o[0] = __builtin_amdgcn_mfma_f32_32x32x16_bf16(PAF(0), VFR(0), o[0], 0, 0, 0), C0, 0); \
    GAPB(o[1] = __builtin_amdgcn_mfma_f32_32x32x16_bf16(PAF(0), VFR(4), o[1], 0, 0, 0), C0, 4); \
    KRD(GL, 0); GAPB(o[0] = __builtin_amdgcn_mfma_f32_32x32x16_bf16(PAF(1), VFR(1), o[0], 0, 0, 0), C0, 8); \
    KRD(GL, 1); GAPB(o[1] = __builtin_amdgcn_mfma_f32_32x32x16_bf16(PAF(1), VFR(5), o[1], 0, 0, 0), C0, 12); \
    KRD(GL, 2); GAPB(o[0] = __builtin_amdgcn_mfma_f32_32x32x16_bf16(PAF(2), VFR(2), o[0], 0, 0, 0), C1, 0); \
    KRD(GL, 3); GAPB(o[1] = __builtin_amdgcn_mfma_f32_32x32x16_bf16(PAF(2), VFR(6), o[1], 0, 0, 0), C1, 4); \
    GAPB(o[0] = __builtin_amdgcn_mfma_f32_32x32x16_bf16(PAF(3), VFR(3), o[0], 0, 0, 0), C1, 8); \
    GAPB(o[1] = __builtin_amdgcn_mfma_f32_32x32x16_bf16(PAF(3), VFR(7), o[1], 0, 0, 0), C1, 12); \
    } while (0)
    int t = 1;
    for (; t + 5 < NT; t += 2) {
        STEP(pB0, pB1, pA0, pA1, t, true, true, true);     WAIT_BAR(2); RESC(); ROT();
        STEP(pA0, pA1, pB0, pB1, t + 1, true, true, true); WAIT_BAR(2); RESC(); ROT();
    }
#define ENDW(tt) do { if ((tt) + 3 < NT) { WAIT_BAR(2); } else if ((tt) + 2 < NT) { WAIT_BAR(1); } else { WAIT_BAR(0); } } while (0)
    for (; t + 1 < NT; t += 2) {
        STEP(pB0, pB1, pA0, pA1, t, (t + 3 < NT), (t + 1 < NT), (t + 1 < NT));         ENDW(t);     RESC(); ROT();
        STEP(pA0, pA1, pB0, pB1, t + 1, (t + 4 < NT), (t + 2 < NT), (t + 2 < NT));     ENDW(t + 1); RESC(); ROT();
    }
    STEP(pB0, pB1, pA0, pA1, NT - 1, false, false, false); RESC();
    { float sacc = pB0[0] + pB0[1]; _Pragma("unroll") for (int r = 2; r < 16; ++r) sacc += pB0[r]; _Pragma("unroll") for (int r = 0; r < 16; ++r) sacc += pB1[r]; l_reg += sacc;
      pw0 = (u32x4){PKW(pB0, 0), PKW(pB0, 2), PKW(pB0, 4), PKW(pB0, 6)}; pw1 = (u32x4){PKW(pB0, 8), PKW(pB0, 10), PKW(pB0, 12), PKW(pB0, 14)}; pw2 = (u32x4){PKW(pB1, 0), PKW(pB1, 2), PKW(pB1, 4), PKW(pB1, 6)}; pw3 = (u32x4){PKW(pB1, 8), PKW(pB1, 10), PKW(pB1, 12), PKW(pB1, 14)};
      SBAR(); pv(o, vb0 + sl_cur, PAF(0), PAF(1), PAF(2), PAF(3)); }
#undef PKW
#undef PAF
#undef VFR
#undef PIN
#undef MX3
#undef GAPA
#undef GAPB
#undef EX
#undef VRD
#undef KRD
#undef STEP
#undef ENDW
    { auto rr = __builtin_amdgcn_permlane32_swap(__float_as_uint(l_reg), __float_as_uint(l_reg), false, false); l_reg = __uint_as_float(rr[0]) + __uint_as_float(rr[1]); }
    if (hi == 0) wsf[32 + r32] = l_reg; asm volatile("s_waitcnt lgkmcnt(0)" ::: "memory");
    float rli[16];
#pragma unroll
    for (int r = 0; r < 16; ++r) rli[r] = __builtin_amdgcn_rcpf(wsf[32 + crow(r, hi)]);
    bf16_t* Ow = Ou + (long)(wid * QBLK) * TP;
    { bf16_t* stg = (bf16_t*)(shm + LDS_OST) + wid * 2048;
#pragma unroll
      for (int r = 0; r < 16; ++r) { const int orow = crow(r, hi);
#pragma unroll
        for (int d0 = 0; d0 < 2; ++d0) stg[orow * 64 + d0 * 32 + r32] = (bf16_t)f2bf(o[d0][r] * rli[r]); }
      asm volatile("s_waitcnt lgkmcnt(0)" ::: "memory");
#pragma unroll
      for (int i = 0; i < 4; ++i) { const int row = i * 8 + (lane >> 3), ch = lane & 7; const u32x4 v = *(const u32x4*)(stg + row * 64 + ch * 8); *(u32x4*)(Ow + (long)row * TP + ch * 8) = v; } }
    asm volatile("s_waitcnt lgkmcnt(0)\n\ts_barrier" ::: "memory");
#undef DMA_K
#undef DMA_V
#undef START
#undef RESC
#undef ROT
}
#undef SBAR
#undef WAIT_BAR
}
__device__ __forceinline__ void na_wave(int b, int r, int ct, int h, bf16_t* NQ, const bf16_t* NK, const bf16_t* NKC, const bf16_t* NVT, const bf16_t* NVCT, const LAS float* rpb_l, int lane) {
    const int qi = lane & 15, g = lane >> 4;
    const int c0 = ct * 16; const int kc0 = min(max(c0 - 8, 0), 32);
    const int r_start = min(max(r - 4, 0), 24);
    const size_t qrow = (size_t)b * 2048 + r * 64 + c0 + qi;
    const bf16x8 qf = *(const bf16x8*)(NQ + qrow * 512 + h * 32 + 8 * g);
    f32x4 s[32];
    const f32x4 z4 = {0.f, 0.f, 0.f, 0.f};
#pragma unroll
    for (int kr = 0; kr < 8; ++kr)
#pragma unroll
        for (int cg = 0; cg < 2; ++cg) {
            const size_t tok = (size_t)b * 2048 + (r_start + kr) * 64 + kc0 + 16 * cg + qi;
            const bf16x8 kf = *(const bf16x8*)(NK + tok * 512 + h * 32 + 8 * g);
            s[kr * 2 + cg] = __builtin_amdgcn_mfma_f32_16x16x32_bf16(kf, qf, z4, 0, 0, 0);
        }
#pragma unroll
    for (int tc = 0; tc < 16; ++tc) {
        const size_t tok = (size_t)b * 256 + 16 * tc + qi;
        const bf16x8 kf = *(const bf16x8*)(NKC + tok * 512 + h * 32 + 8 * g);
        s[16 + tc] = __builtin_amdgcn_mfma_f32_16x16x32_bf16(kf, qf, z4, 0, 0, 0);
    }
    const int qc = c0 + qi; const int cs = min(max(qc - 8, 0), 48);
    const LAS float* rp = rpb_l + h * (15 * 31);
    float mx = -INFINITY;
#pragma unroll
    for (int kr = 0; kr < 8; ++kr) {
        const int dr = r_start + kr - r + 7;
#pragma unroll
        for (int cg = 0; cg < 2; ++cg)
#pragma unroll
            for (int e = 0; e < 4; ++e) {
                const int kc = kc0 + 16 * cg + 4 * g + e; const bool valid = (kc >= cs) && (kc < cs + 16);
                const int dc = min(max(kc - qc + 15, 0), 30);
                const float bias = rp[dr * 31 + dc];
                const float v = valid ? s[kr * 2 + cg][e] + bias : -INFINITY;
                s[kr * 2 + cg][e] = v; mx = fmaxf(mx, v);
            }
    }
#pragma unroll
    for (int tc = 0; tc < 16; ++tc)
#pragma unroll
        for (int e = 0; e < 4; ++e) mx = fmaxf(mx, s[16 + tc][e]);
    mx = fmaxf(mx, __shfl_xor(mx, 16)); mx = fmaxf(mx, __shfl_xor(mx, 32));
    float l = 0.f;
    u32x4 pf[16];
#pragma unroll
    for (int ks = 0; ks < 16; ++ks) {
        f32x4 a = s[2 * ks], c = s[2 * ks + 1];
#pragma unroll
        for (int e = 0; e < 4; ++e) { a[e] = __builtin_amdgcn_exp2f(a[e] - mx); c[e] = __builtin_amdgcn_exp2f(c[e] - mx); }
        l += (a[0] + a[1]) + (a[2] + a[3]) + (c[0] + c[1]) + (c[2] + c[3]);
        pf[ks] = pack8(a, c);
    }
    l += __shfl_xor(l, 16); l += __shfl_xor(l, 32);
    f32x4 o0 = z4, o1 = z4;
    const bf16_t* vt0 = NVT + (size_t)(h * 32 + qi) * MTOK + (size_t)b * 2048 + kc0 + 4 * g;
    const bf16_t* vt1 = vt0 + (size_t)16 * MTOK;
#pragma unroll
    for (int ks = 0; ks < 8; ++ks) {
        const int off = (r_start + ks) * 64;
        const u32x2 a0 = *(const u32x2*)(vt0 + off), a1 = *(const u32x2*)(vt0 + off + 16);
        const u32x2 b0 = *(const u32x2*)(vt1 + off), b1 = *(const u32x2*)(vt1 + off + 16);
        const bf16x8 pfr = __builtin_bit_cast(bf16x8, pf[ks]);
        o0 = __builtin_amdgcn_mfma_f32_16x16x32_bf16(__builtin_bit_cast(bf16x8, (u32x4){a0.x, a0.y, a1.x, a1.y}), pfr, o0, 0, 0, 0);
        o1 = __builtin_amdgcn_mfma_f32_16x16x32_bf16(__builtin_bit_cast(bf16x8, (u32x4){b0.x, b0.y, b1.x, b1.y}), pfr, o1, 0, 0, 0);
    }
    const bf16_t* vc0 = NVCT + (size_t)(h * 32 + qi) * MCTX + (size_t)b * 256 + 4 * g;
    const bf16_t* vc1 = vc0 + (size_t)16 * MCTX;
#pragma unroll
    for (int ks = 0; ks < 8; ++ks) {
        const int off = ks * 32;
        const u32x2 a0 = *(const u32x2*)(vc0 + off), a1 = *(const u32x2*)(vc0 + off + 16);
        const u32x2 b0 = *(const u32x2*)(vc1 + off), b1 = *(const u32x2*)(vc1 + off + 16);
        const bf16x8 pfr = __builtin_bit_cast(bf16x8, pf[8 + ks]);
        o0 = __builtin_amdgcn_mfma_f32_16x16x32_bf16(__builtin_bit_cast(bf16x8, (u32x4){a0.x, a0.y, a1.x, a1.y}), pfr, o0, 0, 0, 0);
        o1 = __builtin_amdgcn_mfma_f32_16x16x32_bf16(__builtin_bit_cast(bf16x8, (u32x4){b0.x, b0.y, b1.x, b1.y}), pfr, o1, 0, 0, 0);
    }
    const float rl = 1.f / l;
    bf16_t* op = NQ + qrow * 512 + h * 32 + 4 * g;
    u32x2 w0, w1; w0.x = pk2(o0[0] * rl, o0[1] * rl); w0.y = pk2(o0[2] * rl, o0[3] * rl); w1.x = pk2(o1[0] * rl, o1[1] * rl); w1.y = pk2(o1[2] * rl, o1[3] * rl);
    *(u32x2*)op = w0; *(u32x2*)(op + 16) = w1;
}

__device__ __forceinline__ void na_phase(Frame& F, const float* na_rpb, bf16_t* NQ, const bf16_t* NK, const bf16_t* NKC, const bf16_t* NVT, const bf16_t* NVCT) {
    LAS float* rpb_l = (LAS float*)F.lds;
    for (int i = F.tid; i < 16 * 15 * 31; i += NTHREADS) rpb_l[i] = na_rpb[i] * LOG2E;
    __syncthreads();
    const int per = (BATCH * 32 * 8 + F.G - 1) / F.G;
    for (int i = 0; i < per; ++i) {
        const int bu = F.vcu * per + i; if (bu >= BATCH * 32 * 8) break; const int b = bu >> 8, rem = bu & 255, r = rem >> 3, hq = rem & 7;
        na_wave(b, r, F.wave & 3, 2 * hq + (F.wave >> 2), NQ, NK, NKC, NVT, NVCT, rpb_l, F.lane);
    }
    __syncthreads();
}

constexpr int SG_P = 200;
__device__ __forceinline__ void sgu_phase(Frame& F, const bf16_t* VT, bf16_t* U, const bf16_t* TA, const bf16_t* WS, const bf16_t* WO_T,
                                          const float* ln_g, const float* ln_b, const float* b_s) {
    LAS bf16_t* XS = (LAS bf16_t*)F.lds;
    LAS bf16_t* WM = XS + 128 * SG_P;
    LAS float* red = (LAS float*)(F.lds + 2 * 128 * SG_P * 2);
    LAS float* stat = red + 32 * 128 * 2;
    const int tid = F.tid, lane = F.lane, w = F.wave;
    const int nchunk = MTOK / 128;
    for (int ck = F.vcu; ck < nchunk; ck += F.G) {
        const size_t tok0 = (size_t)ck * 128;
        { const int q8 = tid & 15, cg = tid >> 4; float sm[8], sq[8];
#pragma unroll
          for (int i = 0; i < 8; ++i) { sm[i] = 0.f; sq[i] = 0.f; }
          for (int j = 0; j < 32; ++j) { const int ch = cg + 32 * j; f32x4 a, c; unpack8(*(const u32x4*)(VT + (size_t)ch * MTOK + tok0 + 8 * q8), a, c);
#pragma unroll
              for (int i = 0; i < 4; ++i) { sm[i] += a[i]; sq[i] += a[i] * a[i]; sm[4 + i] += c[i]; sq[4 + i] += c[i] * c[i]; } }
#pragma unroll
          for (int i = 0; i < 8; ++i) { red[(cg * 128 + q8 * 8 + i) * 2] = sm[i]; red[(cg * 128 + q8 * 8 + i) * 2 + 1] = sq[i]; }
          __syncthreads();
          if (tid < 128) { float s = 0.f, q = 0.f; for (int j = 0; j < 32; ++j) { s += red[(j * 128 + tid) * 2]; q += red[(j * 128 + tid) * 2 + 1]; }
              const float mean = s * (1.f / 1024.f), var = fmaxf(q * (1.f / 1024.f) - mean * mean, 0.f); stat[tid * 2] = mean; stat[tid * 2 + 1] = 1.f / sqrtf(var + NORM_EPS); }
#pragma unroll
          for (int j = 0; j < 2; ++j) { const int pid = tid + 512 * j, p = pid >> 3, c8 = pid & 7; *(LAS u32x4*)(XS + p * SG_P + 128 + 8 * c8) = *(const u32x4*)(TA + (tok0 + p) * 64 + 8 * c8); }
          __syncthreads(); }
        for (int g = 0; g < 8; ++g) {
#pragma unroll
            for (int j = 0; j < 4; ++j) { const int pid = tid + 512 * j, p = pid >> 4, q8 = pid & 15; *(LAS u32x4*)(XS + p * SG_P + 8 * q8) = *(const u32x4*)(WS + ((size_t)g * 128 + p) * 128 + 8 * q8); }
#pragma unroll
            for (int j = 0; j < 4; ++j) { const int pid = tid + 512 * j, c = pid >> 4, q8 = pid & 15; const int ch = g * 128 + c;
                f32x4 a, d; unpack8(*(const u32x4*)(VT + (size_t)ch * MTOK + tok0 + 8 * q8), a, d);
                const float lg = ln_g[ch], lb = ln_b[ch];
#pragma unroll
                for (int i = 0; i < 4; ++i) { a[i] = (a[i] - stat[(8 * q8 + i) * 2]) * stat[(8 * q8 + i) * 2 + 1] * lg + lb; d[i] = (d[i] - stat[(8 * q8 + 4 + i) * 2]) * stat[(8 * q8 + 4 + i) * 2 + 1] * lg + lb; }
                *(LAS u32x4*)(WM + c * SG_P + 8 * q8) = pack8(a, d); }
#pragma unroll
            for (int j = 0; j < 2; ++j) { const int pid = tid + 512 * j, c = pid >> 3, c8 = pid & 7; *(LAS u32x4*)(WM + c * SG_P + 128 + 8 * c8) = *(const u32x4*)(WO_T + ((size_t)g * 128 + c) * 64 + 8 * c8); }
            __syncthreads();
            f32x4 acc[2][4];
#pragma unroll
            for (int mi = 0; mi < 2; ++mi)
#pragma unroll
                for (int ni = 0; ni < 4; ++ni) acc[mi][ni] = (f32x4){0.f, 0.f, 0.f, 0.f};
            const int fr = lane & 15, fq = lane >> 4;
#pragma unroll
            for (int kk = 0; kk < 6; ++kk) {
                bf16x8 xf[2], wf[4];
#pragma unroll
                for (int mi = 0; mi < 2; ++mi) xf[mi] = *(const LAS bf16x8*)(XS + (32 * (w >> 1) + 16 * mi + fr) * SG_P + 32 * kk + 8 * fq);
#pragma unroll
                for (int ni = 0; ni < 4; ++ni) wf[ni] = *(const LAS bf16x8*)(WM + (64 * (w & 1) + 16 * ni + fr) * SG_P + 32 * kk + 8 * fq);
#pragma unroll
                for (int mi = 0; mi < 2; ++mi)
#pragma unroll
                    for (int ni = 0; ni < 4; ++ni) acc[mi][ni] = __builtin_amdgcn_mfma_f32_16x16x32_bf16(wf[ni], xf[mi], acc[mi][ni], 0, 0, 0);
            }
#pragma unroll
            for (int mi = 0; mi < 2; ++mi) { const int p = 32 * (w >> 1) + 16 * mi + fr; const float bs = b_s[g * 128 + p];
#pragma unroll
                for (int ni = 0; ni < 4; ++ni) { bf16_t* up = U + (tok0 + p) * 1024 + g * 128 + 64 * (w & 1) + 16 * ni + 4 * fq;
                    const u32x2 uw = *(const u32x2*)up;
                    const float u0 = __builtin_bit_cast(float, uw.x << 16), u1 = __builtin_bit_cast(float, uw.x & 0xffff0000u), u2 = __builtin_bit_cast(float, uw.y << 16), u3 = __builtin_bit_cast(float, uw.y & 0xffff0000u);
                    u32x2 ow; ow.x = pk2(u0 * (acc[mi][ni][0] + bs), u1 * (acc[mi][ni][1] + bs)); ow.y = pk2(u2 * (acc[mi][ni][2] + bs), u3 * (acc[mi][ni][3] + bs));
                    *(u32x2*)up = ow; } }
            __syncthreads();
        }
    }
}

__device__ __forceinline__ void router_phase(Frame& F, const float* xmid, const float* mod, const float* gn, const float* b_router, const bf16_t* WRH, const bf16_t* WRL,
                                             bf16_t* H2, int* list_crow, float* list_w, unsigned* gcount) {
    LAS float* t_g = (LAS float*)F.lds;
    LAS float* t_s = t_g + 1024;
    LAS float* br = t_s + 1024;
    LAS unsigned* lcnt = (LAS unsigned*)(br + 64);
    LAS unsigned* lbase = lcnt + 64;
    LAS float* sc = (LAS float*)(lbase + 64) + F.wave * (16 * 65);
    const int tid = F.tid, lane = F.lane;
    const int fr = lane & 15, fq = lane >> 4;
    for (int blk = F.vcu; blk < MTOK / 256; blk += F.G) {
        const int b = blk >> 3, half = blk >> 7;
        const float* mb = mod + (size_t)b * 6144;
        for (int i = tid; i < 1024; i += NTHREADS) { t_g[i] = gn[i] * (1.f + mb[4 * 1024 + i]); t_s[i] = mb[3 * 1024 + i]; }
        if (tid < 64) { br[tid] = b_router[tid]; lcnt[tid] = 0u; }
        __syncthreads();
        int sel_e[2][8]; float sel_w[2][8]; unsigned sel_p[2][8];
#pragma unroll
        for (int it = 0; it < 2; ++it) {
            const int tok0 = blk * 256 + F.wave * 32 + it * 16;
            float r_mine = 0.f;
            for (int rr = 0; rr < 16; ++rr) {
                const f32x4* xr = (const f32x4*)(xmid + (size_t)(tok0 + rr) * DM) + lane; float s = 0.f;
#pragma unroll
                for (int j = 0; j < 4; ++j) { const f32x4 v = xr[64 * j]; s += (v.x * v.x + v.y * v.y) + (v.z * v.z + v.w * v.w); }
                const float rinv = 1.f / sqrtf(wave_sum(s) * (1.f / DM) + NORM_EPS);
                r_mine = (rr == fr) ? rinv : r_mine;
            }
            f32x4 acc[4];
#pragma unroll
            for (int j = 0; j < 4; ++j) acc[j] = (f32x4){0.f, 0.f, 0.f, 0.f};
            const float* xrow = xmid + (size_t)(tok0 + fr) * DM;
            bf16_t* hrow = H2 + (size_t)(tok0 + fr) * DM;
            for (int s = 0; s < 32; ++s) {
                const int k = 32 * s + 8 * fq;
                const f32x4 x0 = *(const f32x4*)(xrow + k), x1 = *(const f32x4*)(xrow + k + 4);
                const f32x4 g0 = *(const LAS f32x4*)(t_g + k), g1 = *(const LAS f32x4*)(t_g + k + 4), s0 = *(const LAS f32x4*)(t_s + k), s1 = *(const LAS f32x4*)(t_s + k + 4);
                const f32x4 h0 = x0 * r_mine * g0 + s0, h1 = x1 * r_mine * g1 + s1;
                const u32x4 hi = pack8(h0, h1);
                f32x4 f0, f1; unpack8(hi, f0, f1);
                const u32x4 lo = pack8(h0 - f0, h1 - f1);
                *(u32x4*)(hrow + k) = hi;
                const bf16x8 xh = __builtin_bit_cast(bf16x8, hi), xl = __builtin_bit_cast(bf16x8, lo);
#pragma unroll
                for (int j = 0; j < 4; ++j) {
                    const bf16x8 wh = *(const bf16x8*)(WRH + (size_t)(16 * j + fr) * DM + k), wl = *(const bf16x8*)(WRL + (size_t)(16 * j + fr) * DM + k);
                    acc[j] = __builtin_amdgcn_mfma_f32_16x16x32_bf16(wh, xh, acc[j], 0, 0, 0);
                    acc[j] = __builtin_amdgcn_mfma_f32_16x16x32_bf16(wh, xl, acc[j], 0, 0, 0);
                    acc[j] = __builtin_amdgcn_mfma_f32_16x16x32_bf16(wl, xh, acc[j], 0, 0, 0);
                }
            }
#pragma unroll
            for (int j = 0; j < 4; ++j)
#pragma unroll
                for (int e = 0; e < 4; ++e) sc[fr * 65 + 16 * j + 4 * fq + e] = 1.f / (1.f + __expf(-acc[j][e]));
            LDS_WAIT(); asm volatile("" ::: "memory");
            if (lane < 16) {
                unsigned long long taken = 0ull; float ssum = 0.f;
#pragma unroll
                for (int kk = 0; kk < 8; ++kk) {
                    float best = -INFINITY; int be = 0;
                    for (int e = 0; e < 64; ++e) { const float v = sc[lane * 65 + e] + br[e]; const bool free_ = !((taken >> e) & 1ull); if (free_ && v > best) { best = v; be = e; } }
                    taken |= 1ull << be; sel_e[it][kk] = be; sel_w[it][kk] = sc[lane * 65 + be]; ssum += sel_w[it][kk];
                }
                const float inv = 2.5f / ssum;
#pragma unroll
                for (int kk = 0; kk < 8; ++kk) { sel_w[it][kk] *= inv; sel_p[it][kk] = atomicAdd((unsigned*)&lcnt[sel_e[it][kk]], 1u); }
            }
            LDS_WAIT(); asm volatile("" ::: "memory");
        }
        __syncthreads();
        if (tid < 64) lbase[tid] = atomicAdd(&gcount[half * 64 + tid], lcnt[tid]);
        __syncthreads();
        if (lane < 16) {
#pragma unroll
            for (int it = 0; it < 2; ++it) {
                const int tok = blk * 256 + F.wave * 32 + it * 16 + lane; const int tl = tok - half * 32768;
#pragma unroll
                for (int kk = 0; kk < 8; ++kk) { const int e = sel_e[it][kk]; const size_t pos = (size_t)(half * 64 + e) * 32768 + lbase[e] + sel_p[it][kk];
                    list_crow[pos] = tl * 9 + kk; list_w[pos] = sel_w[it][kk]; }
            }
        }
        __syncthreads();
    }
}

__device__ __forceinline__ void final_phase(Frame& F, int half, const bf16_t* C, const float* mod, const float* fg, float* out  ) {
    const int gw = F.vcu * NWAVES + F.wave, NGW = F.G * NWAVES, lane = F.lane;
    for (int tl = gw; tl < 32768; tl += NGW) {
        const int tok = half * 32768 + tl, b = tok >> 11;
        const float* gf = mod + (size_t)b * 6144 + 5 * 1024;
        f32x4* xr = (f32x4*)(out + (size_t)tok * DM) + lane;
        f32x4 y[4];
#pragma unroll
        for (int j = 0; j < 4; ++j) y[j] = (f32x4){0.f, 0.f, 0.f, 0.f};
#pragma unroll
        for (int k = 0; k < 9; ++k) { const u32x2* cr = (const u32x2*)(C + ((size_t)tl * 9 + k) * 1024) + lane;
#pragma unroll
            for (int j = 0; j < 4; ++j) { const u32x2 w = cr[64 * j];
                y[j] += (f32x4){__builtin_bit_cast(float, w.x << 16), __builtin_bit_cast(float, w.x & 0xffff0000u), __builtin_bit_cast(float, w.y << 16), __builtin_bit_cast(float, w.y & 0xffff0000u)}; } }
        f32x4 v[4]; float s = 0.f;
#pragma unroll
        for (int j = 0; j < 4; ++j) { v[j] = xr[64 * j] + ((const f32x4*)gf)[lane + 64 * j] * y[j]; s += (v[j].x * v[j].x + v[j].y * v[j].y) + (v[j].z * v[j].z + v[j].w * v[j].w); }
        const float r = 1.f / sqrtf(wave_sum(s) * (1.f / DM) + NORM_EPS);
#pragma unroll
        for (int j = 0; j < 4; ++j) xr[64 * j] = v[j] * r * ((const f32x4*)fg)[lane + 64 * j];
    }
}
struct Args { const float* in[28]; float* out; unsigned char* ws; int stage, pad1; };

__device__ __forceinline__ int tq_src_col(int j) { const int axis = j >> 5, p = j & 31; return axis * 32 + (p & 1) * 16 + (p >> 1); }
__device__ __forceinline__ int main_src_col(int c) {
    if (c < 1024) return COL_U + c;
    if (c < 2048) return COL_GA + (c - 1024);
    if (c < 3072) return COL_GB + (c - 2048);
    if (c < 3584) return COL_NQ + (c - 3072);
    if (c < 4096) return COL_NK + (c - 3584);
    const int j = c - 4096;
    if (j < 64) return COL_TQ + tq_src_col(j);
    if (j < 128) return COL_TK + tq_src_col(j - 64);
    if (j < 192) return COL_TV + (j - 128);
    return -1;
}
typedef const __attribute__((address_space(4))) Args* KArgs0;
__device__ __forceinline__ void p0_elementwise(Frame& F, KArgs0 ap) {
    unsigned char* ws = ap->ws;
    const size_t gt = (size_t)F.vcu * NTHREADS + F.tid, NT_ = (size_t)F.G * NTHREADS;
    const float* w_in = ap->in[8]; const float* b_in = ap->in[9];
    float* rope = (float*)(ws + WS_ROPE);
    for (size_t i = gt; i < 2 * 64 * 16; i += NT_) { const int f = (int)(i & 15), pos = (int)((i >> 4) & 63); const float inv = powf(10000.f, -(float)f / 16.f); const float ang = (float)pos * inv; rope[2 * i] = cosf(ang); rope[2 * i + 1] = sinf(ang); }
    float* bin = (float*)(ws + WS_BIN); float* bt = (float*)(ws + WS_BT);
    for (size_t i = gt; i < 4352; i += NT_) { const int sc = main_src_col((int)i); bin[i] = sc >= 0 ? b_in[sc] : 0.f; }
    for (size_t i = gt; i < 1536; i += NT_) bt[i] = i < 1024 ? b_in[COL_V + i] : b_in[COL_NV + (i - 1024)];
    bf16_t* win = (bf16_t*)(ws + WS_WIN);
    for (size_t i = gt; i < (size_t)128 * 1024; i += NT_) { const int j = (int)(i >> 10), k = (int)(i & 1023); const int sc = main_src_col(4096 + j); win[(size_t)(4096 + j) * 1024 + k] = (bf16_t)f2bf(w_in[(size_t)k * IN_W + sc]); }
    for (size_t i = gt; i < (size_t)64 * 1024; i += NT_) win[(size_t)(4096 + 192) * 1024 + i] = 0;
    bf16_t* wrh = (bf16_t*)(ws + WS_WRH); bf16_t* wrl = (bf16_t*)(ws + WS_WRL); const float* w_router = ap->in[19];
    for (size_t i = gt; i < (size_t)64 * 1024; i += NT_) { const int e = (int)(i >> 10), k = (int)(i & 1023); const float v = w_router[(size_t)k * 64 + e]; const unsigned h = f2bf(v); wrh[i] = (bf16_t)h; wrl[i] = (bf16_t)f2bf(v - bf2f((unsigned short)h)); }
    bf16_t* wsb = (bf16_t*)(ws + WS_WS); const float* w_s = ap->in[12];
    for (size_t i = gt; i < (size_t)8 * 128 * 128; i += NT_) wsb[i] = (bf16_t)f2bf(w_s[i]);
}

__device__ __forceinline__ void p0_weights(Frame& F, KArgs0 ap) {
    unsigned char* ws = ap->ws;
    LAS float* scr = (LAS float*)(F.lds + F.wave * 16384);
    const int gw = F.vcu * NWAVES + F.wave, NGW = F.G * NWAVES;
    const float* w_in = ap->in[8];
    bf16_t* win = (bf16_t*)(ws + WS_WIN); bf16_t* wt = (bf16_t*)(ws + WS_WT);
    const TrJob jobs[18] = {
        {w_in, win, IN_W, 1024, 1024, COL_U, 0, 1, 0, 0, 0},
        {w_in, win, IN_W, 1024, 1024, COL_GA, 1024, 1, 0, 0, 0},
        {w_in, win, IN_W, 1024, 1024, COL_GB, 2048, 1, 0, 0, 0},
        {w_in, win, IN_W, 1024, 512, COL_NQ, 3072, 1, 0, 0, 0},
        {w_in, win, IN_W, 1024, 512, COL_NK, 3584, 1, 0, 0, 0},
        {w_in, win, IN_W, 1024, 64, COL_TV, 4096 + 128, 1, 0, 0, 0},
        {w_in, wt, IN_W, 1024, 1024, COL_V, 0, 1, 0, 0, 0},
        {w_in, wt, IN_W, 1024, 512, COL_NV, 1024, 1, 0, 0, 0},
        {ap->in[16], (bf16_t*)(ws + WS_WUPA), 1024, 1024, 1024, 0, 0, 1, 0, 0, 0},
        {ap->in[17], (bf16_t*)(ws + WS_WUPB), 1024, 512, 1024, 0, 0, 1, 0, 0, 0},
        {ap->in[18], (bf16_t*)(ws + WS_WOUT), 1024, 1024, 1024, 0, 0, 1, 0, 0, 0},
        {ap->in[14], (bf16_t*)(ws + WS_WO), 1024, 64, 1024, 0, 0, 1, 0, 0, 0},
        {ap->in[21], (bf16_t*)(ws + WS_WGU), 256, 1024, 256, 0, 0, 64, 1, (size_t)1024 * 256, (size_t)512 * 1024},
        {ap->in[22], (bf16_t*)(ws + WS_WGU), 256, 1024, 256, 0, 0, 64, 2, (size_t)1024 * 256, (size_t)512 * 1024},
        {ap->in[23], (bf16_t*)(ws + WS_WD), 1024, 256, 1024, 0, 0, 64, 0, (size_t)256 * 1024, (size_t)1024 * 256},
        {ap->in[24], (bf16_t*)(ws + WS_WGU) + (size_t)64 * 512 * 1024, 256, 1024, 256, 0, 0, 1, 1, 0, 0},
        {ap->in[25], (bf16_t*)(ws + WS_WGU) + (size_t)64 * 512 * 1024, 256, 1024, 256, 0, 0, 1, 2, 0, 0},
        {ap->in[26], (bf16_t*)(ws + WS_WD) + (size_t)64 * 1024 * 256, 1024, 256, 1024, 0, 0, 1, 0, 0, 0},
    };
    int base = 0;
#pragma unroll
    for (int j = 0; j < 18; ++j) {
        const TrJob job = jobs[j]; const int n = trjob_items(job);
        int it = (gw - base % NGW + NGW) % NGW;
        for (; it < n; it += NGW) trjob_run(job, it, scr, F.lane);
        base += n;
    }
}

typedef const __attribute__((address_space(4))) Args* KArgs;
__device__ __forceinline__ KArgs get_args() { KArgs p = (KArgs)__builtin_amdgcn_kernarg_segment_ptr(); asm volatile("" : "+s"(p)); return p; }
#define WSP(T, off) ((T*)(ws + (off)))

__device__ __forceinline__ void moe_gu_phase(Frame& F, int half) {
    volatile LAS unsigned* blk = (volatile LAS unsigned*)(F.lds + MOE_BLK_LDS);
    volatile LAS unsigned* pre = blk + MOE_MAXBLK;
    { const unsigned* cnt = F.ctl + CW_GCOUNT + half * 64;
      if (F.tid == 0) { unsigned p = 0;
#pragma unroll 1
        for (int e = 0; e < 65; ++e) { pre[e] = p; const unsigned c = e < 64 ? __hip_atomic_load(cnt + e, RLX_AGENT) : 32768u; p += (c + 255u) >> 8; } pre[65] = p; }
      __syncthreads(); }
    const int nblk = (int)pre[65];
    for (int j = F.tid; j < nblk; j += NTHREADS) { int e = 0; while (pre[e + 1] <= (unsigned)j) ++e; blk[j] = ((unsigned)e << 16) | ((unsigned)j - pre[e]); }
    __syncthreads();
    unsigned char* ws = get_args()->ws;
    MoeLists L{WSP(int, WS_LCROW) + (size_t)half * 64 * 32768, WSP(float, WS_LW) + (size_t)half * 64 * 32768, F.ctl + CW_GCOUNT + half * 64};
    pg8::Gemm g{WSP(bf16_t, WS_H), WSP(bf16_t, WS_WGU), 1024, (size_t)512 * 1024 * 2};
    MoeOrder S{blk, nblk, 2, F.G, (int)blockIdx.x, L, 2048, half * 32768};
    EpiMoeGU E{WSP(bf16_t, WS_ACT)};
    pg8::gemm_phase<EpiMoeGU, MoeOrder, true, true>(F.lds, g, S, E);
}
__device__ __forceinline__ void moe_down_phase(Frame& F, int half) {
    volatile LAS unsigned* blk = (volatile LAS unsigned*)(F.lds + MOE_BLK_LDS);
    const int nblk = (int)blk[MOE_MAXBLK + 65];
    unsigned char* ws = get_args()->ws;
    MoeLists L{WSP(int, WS_LCROW) + (size_t)half * 64 * 32768, WSP(float, WS_LW) + (size_t)half * 64 * 32768, F.ctl + CW_GCOUNT + half * 64};
    pg8::Gemm g{WSP(bf16_t, WS_ACT), WSP(bf16_t, WS_WD), 256, (size_t)1024 * 256 * 2};
    MoeOrder S{blk, nblk, 4, F.G, (int)blockIdx.x, L, 2048, half * 32768};
    EpiMoeDown E{WSP(bf16_t, WS_C), L};
    pg8::gemm_phase<EpiMoeDown, MoeOrder, false, true>(F.lds, g, S, E);
}

__global__ void __launch_bounds__(NTHREADS, 2) mega_fwd(Args args_unused) {
    extern __shared__ __attribute__((aligned(16))) unsigned char lds[];
    Frame F;
    F.lds = (LAS unsigned char*)lds;
    F.MISC = (volatile LAS unsigned*)(F.lds + MISC_OFF);
    F.tid = threadIdx.x; F.lane = F.tid & 63; F.wave = __builtin_amdgcn_readfirstlane(F.tid >> 6);
    F.G = gridDim.x; { const int bx = blockIdx.x; F.vcu = (F.G % 8 == 0) ? (bx % 8) * (F.G / 8) + bx / 8 : bx; }
    { KArgs A = get_args(); F.ctl = (unsigned*)(A->ws + WS_CTL); }
    for (int u = F.tid; u < (LDS_BYTES - LDSCTL_OFF) / 4; u += NTHREADS) ((LAS unsigned*)(F.lds + LDSCTL_OFF))[u] = 0u;
    __syncthreads();
    XcdBarrier bar = xcd_barrier_post(F.ctl + CW_BAR, F.MISC + 8);
#define GRID_BAR() xcd_barrier(bar)
    const int stage = get_args()->stage;
#define PHASE_BEGIN() do { F.tid = threadIdx.x; asm volatile("" : "+v"(F.tid)); F.lane = F.tid & 63; } while (0)
      { PHASE_BEGIN(); {
        { KArgs A = get_args(); p0_adaln(F, A->in[1], A->in[3], A->in[4], A->in[5], (float*)(A->ws + WS_MOD)); }
        { KArgs A = get_args(); p0_elementwise(F, A); }
        { KArgs A = get_args(); p0_weights(F, A); }
      } } GRID_BAR();
      { PHASE_BEGIN(); {
        KArgs A = get_args(); unsigned char* ws = A->ws; const float* x = A->in[0]; const float* mod = WSP(const float, WS_MOD); const float* gmix = A->in[6];
        bf16_t* H = WSP(bf16_t, WS_H); bf16_t* HC = WSP(bf16_t, WS_HC);
        const int gw = F.vcu * NWAVES + F.wave, NGW = F.G * NWAVES;
        for (int m = gw; m < MTOK; m += NGW) { const float* mb = mod + (size_t)(m >> 11) * 6144; norm_mod_row(x + (size_t)m * DM, gmix, mb, mb + 1024, H + (size_t)m * DM, F.lane); }
        const float* mc = mod + (size_t)32 * 6144; const float* cx = A->in[2];
        for (int m = gw; m < MCTX; m += NGW) norm_mod_row(cx + (size_t)m * DM, gmix, mc, mc + 1024, HC + (size_t)m * DM, F.lane);
      } } GRID_BAR();
      { PHASE_BEGIN(); {
        { unsigned char* ws = get_args()->ws;
          pg8::Gemm g{WSP(bf16_t, WS_H), WSP(bf16_t, WS_WIN), 1024, 0}; pg8::StaticOrder S; S.init(MTOK, 4096, F.G, (int)blockIdx.x);
          EpiMain E{0, WSP(const float, WS_BIN), ws};
          pg8::gemm_phase<EpiMain, pg8::StaticOrder, false, true>(F.lds, g, S, E); }
        { unsigned char* ws = get_args()->ws;
          pg8::Gemm g{WSP(bf16_t, WS_WT), WSP(bf16_t, WS_H), 1024, 0}; pg8::StaticOrder S; S.init(1536, MTOK, F.G, (int)blockIdx.x);
          EpiT E{ws, WSP(const float, WS_BT), MTOK, 0, 0};
          pg8::gemm_phase<EpiT, pg8::StaticOrder, false, true>(F.lds, g, S, E); }
        { unsigned char* ws = get_args()->ws;
          pg8::Gemm g{WSP(bf16_t, WS_H), WSP(bf16_t, WS_WIN) + (size_t)4096 * 1024, 1024, 0}; pg8::StaticOrder S; S.init(MTOK, 256, F.G, (int)blockIdx.x);
          EpiTT<0> E{WSP(const float, WS_BIN) + 4096, WSP(bf16_t, WS_TQ), WSP(bf16_t, WS_TKA), WSP(bf16_t, WS_TVA), WSP(const float, WS_ROPE)};
          pg8::gemm_phase<EpiTT<0>, pg8::StaticOrder, false, true>(F.lds, g, S, E); }
        { unsigned char* ws = get_args()->ws;
          pg8::Gemm g{WSP(bf16_t, WS_HC), WSP(bf16_t, WS_WIN) + (size_t)3584 * 1024, 1024, 0}; pg8::StaticOrder S; S.init(MCTX, 512, F.G, (int)blockIdx.x);
          EpiMain E{1, WSP(const float, WS_BIN) + 3584, ws};
          pg8::gemm_phase<EpiMain, pg8::StaticOrder, false, true>(F.lds, g, S, E); }
        { unsigned char* ws = get_args()->ws;
          pg8::Gemm g{WSP(bf16_t, WS_HC), WSP(bf16_t, WS_WIN) + (size_t)4096 * 1024, 1024, 0}; pg8::StaticOrder S; S.init(MCTX, 256, F.G, (int)((blockIdx.x + 64) % F.G));
          EpiTT<1> E{WSP(const float, WS_BIN) + 4096, WSP(bf16_t, WS_TQ), WSP(bf16_t, WS_TKA), WSP(bf16_t, WS_TVA), WSP(const float, WS_ROPE)};
          pg8::gemm_phase<EpiTT<1>, pg8::StaticOrder, false, true>(F.lds, g, S, E); }
        { unsigned char* ws = get_args()->ws;
          pg8::Gemm g{WSP(bf16_t, WS_WT) + (size_t)1024 * 1024, WSP(bf16_t, WS_HC), 1024, 0}; pg8::StaticOrder S; S.init(512, MCTX, F.G, (int)((blockIdx.x + 96) % F.G));
          EpiT E{ws, WSP(const float, WS_BT), MCTX, 4, 1};
          pg8::gemm_phase<EpiT, pg8::StaticOrder, false, true>(F.lds, g, S, E); }
      } } GRID_BAR();
      { PHASE_BEGIN(); if (stage >= 2) {
        { unsigned char* ws = get_args()->ws;
          for (int u = F.vcu; u < BATCH * 8; u += F.G) { const int b = u >> 3, qb = u & 7;
            bf16_t* qp = WSP(bf16_t, WS_TQ) + ((size_t)b * 2048 + qb * 256) * 64;
            tattn::attn_unit<8, 2304>(qp, WSP(bf16_t, WS_TKA) + (size_t)b * 2304 * 64, WSP(bf16_t, WS_TVA) + (size_t)b * 2304 * 64, qp, (char*)lds); }
          __syncthreads(); }
        { KArgs A = get_args(); unsigned char* ws = A->ws;
          na_phase(F, A->in[15], WSP(bf16_t, WS_NQ), WSP(bf16_t, WS_NK), WSP(bf16_t, WS_NKC), WSP(bf16_t, WS_NVT), WSP(bf16_t, WS_NVCT)); }
      } } GRID_BAR();
      { PHASE_BEGIN(); if (stage >= 2) {
        { KArgs A = get_args(); unsigned char* ws = A->ws;
          sgu_phase(F, WSP(bf16_t, WS_VT), WSP(bf16_t, WS_U), WSP(bf16_t, WS_TQ), WSP(const bf16_t, WS_WS), WSP(const bf16_t, WS_WO), A->in[10], A->in[11], A->in[13]);
          __syncthreads(); }
        { unsigned char* ws = get_args()->ws;
          pg8::Gemm g{WSP(bf16_t, WS_NQ), WSP(bf16_t, WS_WUPB), 512, 0}; pg8::StaticOrder S; S.init(MTOK, 1024, F.G, (int)blockIdx.x);
          EpiGate E{WSP(bf16_t, WS_GB), nullptr, WSP(bf16_t, WS_H)};
          pg8::gemm_phase<EpiGate, pg8::StaticOrder, false, true>(F.lds, g, S, E); }
      } } GRID_BAR();
      { PHASE_BEGIN(); if (stage >= 2) {
        unsigned char* ws = get_args()->ws;
        pg8::Gemm g{WSP(bf16_t, WS_U), WSP(bf16_t, WS_WUPA), 1024, 0}; pg8::StaticOrder S; S.init(MTOK, 1024, F.G, (int)blockIdx.x);
        EpiGate E{WSP(bf16_t, WS_GA), WSP(bf16_t, WS_H), WSP(bf16_t, WS_MERGED)};
        pg8::gemm_phase<EpiGate, pg8::StaticOrder, false, true>(F.lds, g, S, E);
      } } GRID_BAR();
      { PHASE_BEGIN(); if (stage >= 2) {
        KArgs A = get_args(); unsigned char* ws = A->ws;
        pg8::Gemm g{WSP(bf16_t, WS_MERGED), WSP(bf16_t, WS_WOUT), 1024, 0}; pg8::StaticOrder S; S.init(MTOK, 1024, F.G, (int)blockIdx.x);
        EpiXmid E{A->in[0], WSP(const float, WS_MOD), A->out};
        pg8::gemm_phase<EpiXmid, pg8::StaticOrder, false, true>(F.lds, g, S, E);
      } else {
        KArgs A = get_args(); const float* x = A->in[0]; float* xmid = A->out;
        const size_t gt = (size_t)F.vcu * NTHREADS + F.tid, NT_ = (size_t)F.G * NTHREADS;
        for (size_t i = gt; i < (size_t)MTOK * DM / 4; i += NT_) ((f32x4*)xmid)[i] = ((const f32x4*)x)[i];
      } } GRID_BAR();
      { PHASE_BEGIN(); if (stage >= 3) {
        KArgs A = get_args(); unsigned char* ws = A->ws; bf16_t* H2 = WSP(bf16_t, WS_H);
        if (blockIdx.x == 0) for (int i = F.tid; i < DM / 2; i += NTHREADS) ((unsigned*)(H2 + (size_t)MTOK * DM))[i] = 0u;
        router_phase(F, A->out, WSP(const float, WS_MOD), A->in[7], A->in[20], WSP(const bf16_t, WS_WRH), WSP(const bf16_t, WS_WRL), H2, WSP(int, WS_LCROW), WSP(float, WS_LW), F.ctl + CW_GCOUNT);
      } } GRID_BAR();
      { PHASE_BEGIN(); if (stage >= 3) moe_gu_phase(F, 0); } GRID_BAR();
      { PHASE_BEGIN(); if (stage >= 3) moe_down_phase(F, 0); } GRID_BAR();
      { PHASE_BEGIN(); if (stage >= 3) { { KArgs A = get_args(); unsigned char* ws = A->ws; final_phase(F, 0, WSP(bf16_t, WS_C), WSP(const float, WS_MOD), A->in[27], A->out); } moe_gu_phase(F, 1); } } GRID_BAR();
      { PHASE_BEGIN(); if (stage >= 3) moe_down_phase(F, 1); } GRID_BAR();
      { PHASE_BEGIN();
        KArgs A = get_args(); unsigned char* ws = A->ws;
        if (stage >= 3) final_phase(F, 1, WSP(bf16_t, WS_C), WSP(const float, WS_MOD), A->in[27], A->out);
        else {
          float* out = A->out; const float* fg = A->in[27];
          const int gw = F.vcu * NWAVES + F.wave, NGW = F.G * NWAVES;
          for (int tl = gw; tl < MTOK; tl += NGW) {
            f32x4* xr = (f32x4*)(out + (size_t)tl * DM) + F.lane; f32x4 v[4]; float s = 0.f;
#pragma unroll
            for (int j = 0; j < 4; ++j) { v[j] = xr[64 * j]; s += (v[j].x * v[j].x + v[j].y * v[j].y) + (v[j].z * v[j].z + v[j].w * v[j].w); }
            const float r = 1.f / sqrtf(wave_sum(s) * (1.f / DM) + NORM_EPS);
#pragma unroll
            for (int j = 0; j < 4; ++j) xr[64 * j] = v[j] * r * ((const f32x4*)fg)[F.lane + 64 * j];
          }
        }
      }
}

extern "C" void kernel_launch(void* const* d_in, const int* in_sizes, int n_in, void* d_out, int out_size, void* d_ws, size_t ws_size, hipStream_t stream) {
    static int grid = 0;
    if (grid == 0) {
        int dev = 0, cus = 0, per_cu = 0;
        if (n_in != 28 || ws_size < WS_END) { fprintf(stderr, "kernel_launch: n_in %d ws %zu (need %zu)\n", n_in, ws_size, (size_t)WS_END); grid = -1; return; }
        if (hipGetDevice(&dev) != hipSuccess || hipDeviceGetAttribute(&cus, hipDeviceAttributeMultiprocessorCount, dev) != hipSuccess) { fprintf(stderr, "kernel_launch: device query failed\n"); grid = -1; return; }
        if (hipFuncSetAttribute((const void*)mega_fwd, hipFuncAttributeMaxDynamicSharedMemorySize, LDS_BYTES) != hipSuccess) { fprintf(stderr, "kernel_launch: hipFuncSetAttribute failed\n"); grid = -1; return; }
        if (hipOccupancyMaxActiveBlocksPerMultiprocessor(&per_cu, (const void*)mega_fwd, NTHREADS, LDS_BYTES) != hipSuccess || per_cu < 1) { fprintf(stderr, "kernel_launch: occupancy query says %d\n", per_cu); }
        (void)hipGetLastError();
        grid = cus;
    }
    if (grid < 0) return;
    (void)hipMemsetAsync((char*)d_ws + WS_CTL, 0, CTL_ZERO_BYTES, stream);
    Args a{};
    for (int i = 0; i < 28; ++i) a.in[i] = (const float*)d_in[i];
    a.out = (float*)d_out; a.ws = (unsigned char*)d_ws; a.stage = KSTAGE;
    void* kargs[] = {&a};
    hipError_t e = hipLaunchCooperativeKernel((const void*)mega_fwd, dim3(grid), dim3(NTHREADS), kargs, LDS_BYTES, stream);
    if (e != hipSuccess) fprintf(stderr, "kernel_launch: cooperative launch failed: %s\n", hipGetErrorString(e));
}
```

```cpp
#define KSTAGE 3
#define PROBE_MASK 0
#include <hip/hip_runtime.h>
#include <hip/hip_bf16.h>
#include <cstdio>
#include <cstdint>
#include <cmath>

#define GAS __attribute__((address_space(1)))
#define LAS __attribute__((address_space(3)))
typedef unsigned short bf16_t;
typedef float f32x4 __attribute__((ext_vector_type(4)));
typedef float f32x2 __attribute__((ext_vector_type(2)));
typedef unsigned u32x4 __attribute__((ext_vector_type(4)));
typedef unsigned u32x2 __attribute__((ext_vector_type(2)));
typedef short bf16x8 __attribute__((ext_vector_type(8)));

constexpr int DM = 1024, BATCH = 32, SEQ = 2048, MTOK = BATCH * SEQ, CTXL = 256, MCTX = BATCH * CTXL;
constexpr int IN_W = 5824;
constexpr int COL_U = 0, COL_V = 1024, COL_TQ = 2048, COL_TK = 2112, COL_TV = 2176, COL_NQ = 2240, COL_NK = 2752, COL_NV = 3264, COL_GA = 3776, COL_GB = 4800;
constexpr float NORM_EPS = 1e-6f;
constexpr int NWAVES = 8, NTHREADS = 512;

constexpr int SCR_BYTES = 147456;
constexpr int LDSCTL_OFF = SCR_BYTES, MISC_OFF = LDSCTL_OFF + 320;
constexpr int LDS_BYTES = SCR_BYTES + 2048;

constexpr size_t MiB = 1u << 20;
constexpr size_t WS_CTL = 0, CTL_ZERO_BYTES = 1 * MiB;
constexpr int CW_BAR = 4096, CW_GCOUNT = 8192;
constexpr size_t WS_MOD = 1 * MiB;
constexpr size_t WS_ROPE = 2 * MiB;
constexpr size_t WS_BIN = 2 * MiB + 64 * 1024;
constexpr size_t WS_BT = 2 * MiB + 128 * 1024;
constexpr size_t WS_WIN = 3 * MiB;
constexpr size_t WS_WT = 12 * MiB;
constexpr size_t WS_WUPA = 15 * MiB, WS_WUPB = 17 * MiB, WS_WOUT = 18 * MiB;
constexpr size_t WS_WO = 20 * MiB, WS_WS = 20 * MiB + 256 * 1024, WS_WRH = 20 * MiB + 512 * 1024, WS_WRL = 20 * MiB + 768 * 1024;
constexpr size_t WS_WGU = 24 * MiB;
constexpr size_t WS_WD = 89 * MiB;
constexpr size_t WS_U = 122 * MiB, WS_VT = 250 * MiB, WS_GA = 378 * MiB, WS_GB = 506 * MiB, WS_NQ = 634 * MiB;
constexpr size_t WS_C = 122 * MiB;
constexpr int CROW_BYTES = 8 * 1024 + 2048;
constexpr size_t WS_XMID = 506 * MiB;
constexpr size_t C_BYTES = 0;
constexpr size_t WS_MERGED = WS_VT;
constexpr size_t WS_H = 698 * MiB;
constexpr size_t WS_NK = 827 * MiB, WS_NKC = 891 * MiB, WS_NVT = 899 * MiB, WS_NVCT = 963 * MiB, WS_TQ = 971 * MiB, WS_TKA = 979 * MiB, WS_TVA = 988 * MiB, WS_HC = 997 * MiB;
constexpr size_t WS_ACT = 827 * MiB;
constexpr size_t ACT_BYTES = 0;
constexpr size_t WS_LCROW = 987 * MiB, WS_LW = 1003 * MiB;
constexpr int NGRP = 2, GTOK = MTOK / NGRP;
constexpr size_t WS_DUMMY = 1019 * MiB;
constexpr size_t WS_END = 1020 * MiB;
constexpr int MOE_BLK_LDS = 131072;
constexpr int MOE_MAXBLK = 1216;

#ifndef PROBE_MASK
#define PROBE_MASK 0
#endif
#ifndef KSTAGE
#define KSTAGE 3
#endif

#define RLX_AGENT __ATOMIC_RELAXED, __HIP_MEMORY_SCOPE_AGENT

#define XB_TMO      128
#define XB_XCNT(j)  (256  + 64 * (j))
#define XB_XSUB(j)  (1280 + 64 * (j))
#define XB_XGEN(j)  (2304 + 64 * (j))
#define XB_TOP      3328
#define XB_TOPGEN   3392
#define XCD_BAR_WORDS 3456
#define XB_SPIN_CAP (1u << 18)
__device__ __forceinline__ unsigned xb_ld(unsigned* p)              { return __hip_atomic_load(p, __ATOMIC_RELAXED, __HIP_MEMORY_SCOPE_AGENT); }
__device__ __forceinline__ unsigned xb_add(unsigned* p, unsigned v) { return __hip_atomic_fetch_add(p, v, __ATOMIC_RELAXED, __HIP_MEMORY_SCOPE_AGENT); }
__device__ __forceinline__ unsigned xb_xcc_id() { return (unsigned)__builtin_amdgcn_s_getreg((3 << 11) | 20) & 0xFu; }
#define XB_SPIN(cond, bar) do { unsigned _sp = 0; while (cond) { __builtin_amdgcn_s_sleep(1); \
    if ((++_sp & 255u) == 0u) { if (xb_ld(&(bar)[XB_TMO])) break; if (_sp > XB_SPIN_CAP) { atomicAdd(&(bar)[XB_TMO], 1u); break; } } } } while (0)
struct XcdBarrier { unsigned* bar; unsigned x; volatile LAS unsigned* st; };
__device__ __forceinline__ XcdBarrier xcd_barrier_post(unsigned* bar, volatile LAS unsigned* st) {
    XcdBarrier b; b.bar = bar; b.x = xb_xcc_id(); b.st = st;
    if (threadIdx.x == 0) (void)xb_add(&bar[XB_XCNT(b.x)], 1u);
    return b;
}
__device__ __forceinline__ void xcd_barrier_complete(unsigned* bar, unsigned x, unsigned& nloc, unsigned& nx) {
    const unsigned G = gridDim.x * gridDim.y * gridDim.z;
    unsigned sum, cnt, mine, sp = 0u;
    for (;;) {
        sum = 0u; cnt = 0u; mine = 0u;
#pragma unroll 1
        for (unsigned j = 0; j < 16; ++j) { const unsigned c = xb_ld(&bar[XB_XCNT(j)]); sum += c; cnt += (c > 0u) ? 1u : 0u; mine = (j == x) ? c : mine; }
        if (sum == G) break;
        __builtin_amdgcn_s_sleep(1);
        if ((++sp & 255u) == 0u) { if (xb_ld(&bar[XB_TMO])) break; if (sp > XB_SPIN_CAP) { atomicAdd(&bar[XB_TMO], 1u); break; } }
    }
    nloc = mine > 0u ? mine : 1u; nx = cnt > 0u ? cnt : 1u;
}
__device__ __forceinline__ void xcd_barrier(const XcdBarrier& b) {
    asm volatile("s_waitcnt vmcnt(0)" ::: "memory");
    __syncthreads();
    if (threadIdx.x == 0) {
        unsigned* bar = b.bar;
        __builtin_amdgcn_s_waitcnt(0);
        unsigned nloc = b.st[0], nx = b.st[1];
        if (nloc == 0u) { xcd_barrier_complete(bar, b.x, nloc, nx); b.st[0] = nloc; b.st[1] = nx; }
        const unsigned old = xb_add(&bar[XB_XSUB(b.x)], 1u);
        const unsigned gen = old / nloc;
        if (old + 1u == (gen + 1u) * nloc) {
            __builtin_amdgcn_fence(__ATOMIC_RELEASE, "agent");
            asm volatile("s_waitcnt vmcnt(0)" ::: "memory");
            const unsigned og = xb_add(&bar[XB_TOP], 1u);
            const unsigned tg = og / nx;
            if (og + 1u == (tg + 1u) * nx) xb_add(&bar[XB_TOPGEN], 1u);
            else XB_SPIN(xb_ld(&bar[XB_TOPGEN]) == tg, bar);
            __builtin_amdgcn_fence(__ATOMIC_ACQUIRE, "agent");
            xb_add(&bar[XB_XGEN(b.x)], 1u);
            asm volatile("s_waitcnt vmcnt(0)" ::: "memory");
        } else {
            XB_SPIN(xb_ld(&bar[XB_XGEN(b.x)]) == gen, bar);
            __builtin_amdgcn_fence(__ATOMIC_ACQUIRE, "agent");
            asm volatile("s_waitcnt vmcnt(0)" ::: "memory");
        }
    }
    __syncthreads();
}

__device__ __forceinline__ float wave_sum(float v) {
#pragma unroll
    for (int o = 1; o < 64; o <<= 1) v += __shfl_xor(v, o);
    return v;
}
__device__ __forceinline__ unsigned f2bf(float f) { unsigned u = __builtin_bit_cast(unsigned, f); return (u + 0x7fffu + ((u >> 16) & 1u)) >> 16; }
__device__ __forceinline__ unsigned pk2(float lo, float hi) { return f2bf(lo) | (f2bf(hi) << 16); }
__device__ __forceinline__ float bf2f(unsigned short b) { return __builtin_bit_cast(float, (unsigned)b << 16); }

namespace pg8 {
#define PG8_LAS __attribute__((address_space(3)))
constexpr int BM = 256, BK = 64, HALF = 128, HTB = HALF * BK * 2, STAGE_BYTES = 8 * HTB, NXCD = 8, WGM = 8;
__host__ __device__ __forceinline__ int lds_byte(int r, int c) { const int st = (r >> 4) * 2 + (c >> 5), rr = r & 15, cc = c & 31, ob = rr * 64 + cc * 2; return st * 1024 + (ob ^ (((ob >> 9) & 1) << 5)); }
__host__ __device__ __forceinline__ void stage_rc(int b, int& R, int& C) { const int st = b / 1024, sb = b % 1024, swz = sb ^ (((sb >> 9) & 1) << 5); R = (st >> 1) * 16 + swz / 64; C = (st & 1) * 32 + (swz % 64) / 2; }
__host__ __device__ __forceinline__ int perm32(int rho) { const int n = rho >> 4, i = rho & 15; return 8 * (i >> 2) + 4 * n + (i & 3); }

struct Unit { int pm, pn, e, r0, skip; };
struct Gemm { const bf16_t* A; const bf16_t* Bt; int K; size_t b_estride; };

struct StaticOrder {
    int nM, nN, nwg, G, c;
    __host__ __device__ void init(int M, int N, int G_, int c_) { nM = M / BM; nN = N / BM; nwg = nM * nN; G = G_; c = c_; }
    __host__ __device__ bool next(int i, Unit& u) const {
        const long L = (long)i * G + c; if (L >= nwg) return false;
        int wgid = (int)L; { const int q = nwg / NXCD, r = nwg % NXCD, xcd = wgid % NXCD, off = wgid / NXCD; wgid = (xcd < r ? xcd * (q + 1) : r * (q + 1) + (xcd - r) * q) + off; }
        const int nig = WGM * nN, gid = wgid / nig, fm = gid * WGM, gsz = (nM - fm) < WGM ? (nM - fm) : WGM;
        u.pm = fm + ((wgid % nig) % gsz); u.pn = (wgid % nig) / gsz; u.e = 0; u.r0 = 0; u.skip = 0; return true;
    }
    __device__ __forceinline__ unsigned rowoff(const Unit&, int) const { return 0u; }
};

template <class Base> struct DupOrder { Base b;
    __device__ __forceinline__ bool next(int i, Unit& u) const { const bool ok = b.next(i >> 1, u); u.skip = (i & 1) == 0; return ok; }
    __device__ __forceinline__ unsigned rowoff(const Unit& u, int r) const { return b.rowoff(u, r); } };

__device__ __forceinline__ unsigned cvt_pk_bf16(float lo, float hi) { unsigned r; asm volatile("v_cvt_pk_bf16_f32 %0, %1, %2" : "=v"(r) : "v"(lo), "v"(hi)); return r; }
__device__ __forceinline__ f32x2 gelu_pk(f32x2 v) {
    const f32x2 av = __builtin_elementwise_abs(v), d = av * 0.2316418882f + 1.0f;
    f32x2 t; t.x = __builtin_amdgcn_rcpf(d.x); t.y = __builtin_amdgcn_rcpf(d.y);
    f32x2 q = t * 0.5307027145f + (-0.7265760135f); q = q * t + 0.7107068705f; q = q * t + (-0.142248368f); q = q * t + 0.127414796f; q = q * t;
    const f32x2 s = (v * v) * (-0.72134752044f);
    f32x2 e; e.x = __builtin_amdgcn_exp2f(s.x); e.y = __builtin_amdgcn_exp2f(s.y);
    const f32x2 m = v * (q * e), r = v - m;
    f32x2 o; o.x = v.x < 0.f ? m.x : r.x; o.y = v.y < 0.f ? m.y : r.y; return o;
}

template <class Epi, class Sched, bool GATHER, bool ALIGN_EPI>
__device__ __forceinline__ void gemm_phase(PG8_LAS unsigned char* lds, const Gemm g, const Sched& S, const Epi& E) {
    int tid = threadIdx.x; asm volatile("" : "+v"(tid));
    const int wid = __builtin_amdgcn_readfirstlane(tid >> 6), lane = tid & 63, wr = wid >> 2, wc = wid & 3, fr = lane & 15, fq = lane >> 4;
    const int K = g.K, nt = K / BK;
    unsigned voffA[2], voffB[2];
#pragma unroll
    for (int i = 0; i < 2; ++i) { int R, C; stage_rc(tid * 16 + i * 8192, R, C); const int Rb = Epi::PERM ? ((R & ~31) + perm32(R & 31)) : R;
        voffA[i] = (unsigned)(R * K + C) * 2u; voffB[i] = (unsigned)(Rb * K + C) * 2u; }
#define PG8_ROWOFFS(U, d0, d1) do { _Pragma("unroll") for (int i_ = 0; i_ < 2; ++i_) { int R_, C_; stage_rc(tid * 16 + i_ * 8192, R_, C_); d0[i_] = S.rowoff(U, R_) + (unsigned)C_ * 2u; d1[i_] = S.rowoff(U, HALF + R_) + (unsigned)C_ * 2u; } } while (0)
    const size_t kstep = (size_t)(BK * 2);
    const size_t hstep = (size_t)HALF * K * 2;
    const size_t tstep = 2 * hstep;
    const size_t ahstep = GATHER ? 0 : hstep;
    const unsigned ldsw = (unsigned)wid * 1024u;
    const int aoff = lds_byte(wr * 64 + fr, fq * 8), boff = lds_byte(wc * 32 + fr, fq * 8);
#define PG8_SA(b, h) (((b) * 2 + (h)) * HTB)
#define PG8_SB(b, h) ((4 + (b) * 2 + (h)) * HTB)
#define PG8_STAGE(bufoff, gbase, voff) do { _Pragma("unroll") for (int _i = 0; _i < 2; ++_i) \
        __builtin_amdgcn_global_load_lds((const unsigned*)((const char*)(gbase) + (voff)[_i]), (PG8_LAS unsigned*)(lds + (bufoff) + ldsw + _i * 8192), 16, 0, 0); } while (0)
#define PG8_LDA(dst, b, h) do { _Pragma("unroll") for (int m = 0; m < 4; ++m) _Pragma("unroll") for (int k = 0; k < 2; ++k) dst[m][k] = *(const PG8_LAS bf16x8*)(lds + PG8_SA(b, h) + aoff + m * 2048 + k * 1024); } while (0)
#define PG8_LDB(dst, b, h) do { _Pragma("unroll") for (int n = 0; n < 2; ++n) _Pragma("unroll") for (int k = 0; k < 2; ++k) dst[n][k] = *(const PG8_LAS bf16x8*)(lds + PG8_SB(b, h) + boff + n * 2048 + k * 1024); } while (0)
#define PG8_MMA(ai, bj, At, Bt) do { __builtin_amdgcn_s_setprio(1); _Pragma("unroll") for (int m = 0; m < 4; ++m) _Pragma("unroll") for (int n = 0; n < 2; ++n) _Pragma("unroll") for (int k = 0; k < 2; ++k) \
        acc[ai][bj][m][n] = __builtin_amdgcn_mfma_f32_16x16x32_bf16(Bt[n][k], At[m][k], acc[ai][bj][m][n], 0, 0, 0); __builtin_amdgcn_s_setprio(0); } while (0)
#define PG8_WAIT_V(n) asm volatile("s_waitcnt vmcnt(" #n ")" ::: "memory")
#define PG8_WAIT_L(n) asm volatile("s_waitcnt lgkmcnt(" #n ")" ::: "memory")
#define PG8_BAR __builtin_amdgcn_s_barrier()
#define PG8_SCHED __builtin_amdgcn_sched_barrier(0)
#define PG8_AV0 (GATHER ? vA0 : voffA)
#define PG8_AV1 (GATHER ? vA1 : voffA)
    Unit cur, nxt; int ui = 0;
    if (!S.next(0, cur)) return;
    f32x4 acc[2][2][4][2];
#pragma unroll
    for (int a = 0; a < 2; ++a)
#pragma unroll
        for (int b = 0; b < 2; ++b)
#pragma unroll
            for (int m = 0; m < 4; ++m)
#pragma unroll
                for (int n = 0; n < 2; ++n) acc[a][b][m][n] = (f32x4){0.f, 0.f, 0.f, 0.f};
    bf16x8 At[4][2], B0[2][2], B1[2][2];
    unsigned vA0[2] = {0u, 0u}, vA1[2] = {0u, 0u};
    if constexpr (GATHER) { PG8_ROWOFFS(cur, vA0, vA1); }
    const char* cA = GATHER ? (const char*)g.A : (const char*)g.A + (size_t)cur.pm * tstep;
    const char* cB = (const char*)g.Bt + (size_t)cur.e * g.b_estride + (size_t)cur.pn * tstep;
    PG8_STAGE(PG8_SB(0, 0), cB, voffB); PG8_STAGE(PG8_SB(0, 1), cB + hstep, voffB); PG8_STAGE(PG8_SA(0, 0), cA, PG8_AV0); PG8_STAGE(PG8_SA(0, 1), cA + ahstep, PG8_AV1);
    if (wr == 1) PG8_BAR;
    PG8_WAIT_V(2); PG8_BAR;
    PG8_STAGE(PG8_SB(1, 0), cB + kstep, voffB); PG8_STAGE(PG8_SA(1, 0), cA + kstep, PG8_AV0); PG8_STAGE(PG8_SB(1, 1), cB + hstep + kstep, voffB);
    PG8_WAIT_V(6); PG8_BAR;
    for (;;) {
        const bool has_next = S.next(ui + 1, nxt);
        const char* nA = GATHER ? (const char*)g.A : (has_next ? (const char*)g.A + (size_t)nxt.pm * tstep : cA);
        const char* nB = has_next ? (const char*)g.Bt + (size_t)nxt.e * g.b_estride + (size_t)nxt.pn * tstep : cB;
#pragma unroll 1
        for (int t = 0; t < nt; t += 2) {
            const bool last = (t == nt - 2);
            const char* a1 = cA + (size_t)(t + 1) * kstep;
            const char* a2 = last ? nA : cA + (size_t)(t + 2) * kstep; const char* b2 = last ? nB : cB + (size_t)(t + 2) * kstep;
            const char* a3 = a2 + kstep; const char* b3 = b2 + kstep;
            unsigned nA0[2] = {0u, 0u}, nA1[2] = {0u, 0u};
            if constexpr (GATHER) { if (last && has_next) { PG8_ROWOFFS(nxt, nA0, nA1); } }
            PG8_LDB(B0, 0, 0); PG8_LDB(B1, 0, 1); PG8_SCHED; PG8_LDA(At, 0, 0); PG8_STAGE(PG8_SA(1, 1), a1 + ahstep, PG8_AV1);
            PG8_WAIT_V(8); PG8_WAIT_L(0); PG8_BAR; PG8_MMA(0, 0, At, B0); PG8_MMA(0, 1, At, B1); PG8_BAR; PG8_SCHED;
            if constexpr (GATHER) { if (last && has_next) { vA0[0] = nA0[0]; vA0[1] = nA0[1]; vA1[0] = nA1[0]; vA1[1] = nA1[1]; } }
            PG8_LDA(At, 0, 1); PG8_STAGE(PG8_SB(0, 0), b2, voffB); PG8_STAGE(PG8_SB(0, 1), b2 + hstep, voffB); PG8_STAGE(PG8_SA(0, 0), a2, PG8_AV0);
            PG8_WAIT_V(8); PG8_WAIT_L(0); PG8_BAR; PG8_MMA(1, 0, At, B0); PG8_MMA(1, 1, At, B1); PG8_BAR; PG8_SCHED;
            PG8_LDB(B0, 1, 0); PG8_LDB(B1, 1, 1); PG8_SCHED; PG8_LDA(At, 1, 0); PG8_STAGE(PG8_SA(0, 1), a2 + ahstep, PG8_AV1);
            PG8_WAIT_V(8); PG8_WAIT_L(0); PG8_BAR; PG8_MMA(0, 0, At, B0); PG8_MMA(0, 1, At, B1); PG8_BAR; PG8_SCHED;
            PG8_LDA(At, 1, 1); PG8_STAGE(PG8_SB(1, 0), b3, voffB); PG8_STAGE(PG8_SB(1, 1), b3 + hstep, voffB); PG8_STAGE(PG8_SA(1, 0), a3, PG8_AV0);
            PG8_WAIT_V(8); PG8_WAIT_L(0); PG8_BAR; PG8_MMA(1, 0, At, B0); PG8_MMA(1, 1, At, B1); PG8_BAR; PG8_SCHED;
        }
        if constexpr (ALIGN_EPI) { if (wr == 0) PG8_BAR; }
        if (!cur.skip) E(acc, cur, wr, wc, fr, fq);
        if (!has_next) break;
#pragma unroll
        for (int a = 0; a < 2; ++a)
#pragma unroll
            for (int b = 0; b < 2; ++b)
#pragma unroll
                for (int m = 0; m < 4; ++m)
#pragma unroll
                    for (int n = 0; n < 2; ++n) acc[a][b][m][n] = (f32x4){0.f, 0.f, 0.f, 0.f};
        cur = nxt; cA = nA; cB = nB; ++ui;
        if constexpr (ALIGN_EPI) { if (wr == 1) PG8_BAR; }
    }
    PG8_WAIT_V(0);
    if constexpr (!ALIGN_EPI) { if (wr == 0) PG8_BAR; }
    PG8_BAR;
#undef PG8_SA
#undef PG8_SB
#undef PG8_STAGE
#undef PG8_LDA
#undef PG8_LDB
#undef PG8_MMA
#undef PG8_WAIT_V
#undef PG8_WAIT_L
#undef PG8_BAR
#undef PG8_SCHED
#undef PG8_ROWOFFS
#undef PG8_AV0
#undef PG8_AV1
}
}
#define EPI_ARGS f32x4 (&acc)[2][2][4][2], const pg8::Unit& u, int wr, int wc, int fr, int fq
constexpr float LOG2E = 1.4426950408889634f;
constexpr float TINY_C2 = 0.125f * LOG2E;
constexpr float NA_QS = 0.17677669529663687f * LOG2E;

__device__ __forceinline__ u32x4 pack8(f32x4 a, f32x4 b) { u32x4 w; w.x = pg8::cvt_pk_bf16(a[0], a[1]); w.y = pg8::cvt_pk_bf16(a[2], a[3]); w.z = pg8::cvt_pk_bf16(b[0], b[1]); w.w = pg8::cvt_pk_bf16(b[2], b[3]); return w; }
__device__ __forceinline__ f32x4 gelu4(f32x4 v) { const f32x2 a = pg8::gelu_pk((f32x2){v[0], v[1]}), b = pg8::gelu_pk((f32x2){v[2], v[3]}); return (f32x4){a.x, a.y, b.x, b.y}; }
__device__ __forceinline__ float sigmoidf_(float x) { return __builtin_amdgcn_rcpf(1.f + __builtin_amdgcn_exp2f(-x * LOG2E)); }
__device__ __forceinline__ f32x4 sigmoid4(f32x4 v) { return (f32x4){sigmoidf_(v[0]), sigmoidf_(v[1]), sigmoidf_(v[2]), sigmoidf_(v[3])}; }
__device__ __forceinline__ void unpack8(u32x4 w, f32x4& a, f32x4& b) {
    a = (f32x4){__builtin_bit_cast(float, w.x << 16), __builtin_bit_cast(float, w.x & 0xffff0000u), __builtin_bit_cast(float, w.y << 16), __builtin_bit_cast(float, w.y & 0xffff0000u)};
    b = (f32x4){__builtin_bit_cast(float, w.z << 16), __builtin_bit_cast(float, w.z & 0xffff0000u), __builtin_bit_cast(float, w.w << 16), __builtin_bit_cast(float, w.w & 0xffff0000u)};
}

struct EpiMain {
    static constexpr bool PERM = true;
    int mode; const float* bias; unsigned char* ws;
    __device__ __forceinline__ void operator()(EPI_ARGS) const {
        const int tile = mode == 0 ? u.pn : u.pn + 14;
        const int bcol0 = u.pn * 256 + wc * 32 + 8 * fq;
#pragma unroll
        for (int bj = 0; bj < 2; ++bj)
#pragma unroll
            for (int n = 0; n < 2; ++n) { const f32x4 bv = *(const f32x4*)(bias + bcol0 + bj * 128 + 4 * n);
#pragma unroll
                for (int ai = 0; ai < 2; ++ai)
#pragma unroll
                    for (int m = 0; m < 4; ++m) acc[ai][bj][m][n] += bv; }
        const int row0 = u.pm * 256 + wr * 64 + fr;
        if (tile < 12) {
            const size_t woff = tile < 4 ? WS_U : (tile < 8 ? WS_GA : WS_GB);
            bf16_t* O = (bf16_t*)(ws + woff); const int col0 = (tile & 3) * 256 + wc * 32 + 8 * fq;
#pragma unroll
            for (int ai = 0; ai < 2; ++ai)
#pragma unroll
                for (int m = 0; m < 4; ++m) { bf16_t* rowp = O + (size_t)(row0 + ai * 128 + m * 16) * 1024 + col0;
#pragma unroll
                    for (int bj = 0; bj < 2; ++bj) { f32x4 v0 = acc[ai][bj][m][0], v1 = acc[ai][bj][m][1];
                        if (tile < 4) { v0 = gelu4(v0); v1 = gelu4(v1); } else { v0 = sigmoid4(v0); v1 = sigmoid4(v1); }
                        *(u32x4*)(rowp + bj * 128) = pack8(v0, v1); } }
        } else {
            const size_t woff = tile < 14 ? WS_NQ : (mode == 0 ? WS_NK : WS_NKC);
            bf16_t* O = (bf16_t*)(ws + woff); const float sc = tile < 14 ? NA_QS : 1.f; const int col0 = (tile & 1) * 256 + wc * 32 + 8 * fq;
#pragma unroll
            for (int ai = 0; ai < 2; ++ai)
#pragma unroll
                for (int m = 0; m < 4; ++m) { bf16_t* rowp = O + (size_t)(row0 + ai * 128 + m * 16) * 512 + col0;
#pragma unroll
                    for (int bj = 0; bj < 2; ++bj) *(u32x4*)(rowp + bj * 128) = pack8(acc[ai][bj][m][0] * sc, acc[ai][bj][m][1] * sc); }
        }
    }
};
template <int MODE> struct EpiTT {
    static constexpr bool PERM = true;
    const float* bias; bf16_t *TQ, *TKA, *TVA; const float* rope;
    __device__ __forceinline__ void operator()(EPI_ARGS) const {
        const int bcol0 = wc * 32 + 8 * fq;
        const int row0 = u.pm * 256 + wr * 64 + fr;
        const int axis = wc & 1; const int c32 = (wc & 1) * 32 + 8 * fq;
        const f32x4 b00 = *(const f32x4*)(bias + bcol0), b01 = *(const f32x4*)(bias + bcol0 + 4), b10 = *(const f32x4*)(bias + bcol0 + 128), b11 = *(const f32x4*)(bias + bcol0 + 132);
#pragma unroll
        for (int ai = 0; ai < 2; ++ai)
#pragma unroll
            for (int m = 0; m < 4; ++m) {
                const int row = row0 + ai * 128 + m * 16;
                int b, s; size_t kvrow;
                if (MODE == 0) { b = row >> 11; s = row & 2047; kvrow = (size_t)b * 2304 + s; } else { b = row >> 8; s = row & 255; kvrow = (size_t)b * 2304 + 2048 + s; }
                f32x4 v0 = acc[ai][0][m][0] + b00, v1 = acc[ai][0][m][1] + b01;
                if (MODE == 0) {
                    const int pos = axis == 0 ? (s >> 6) : (s & 63);
                    const f32x4 cs0 = *(const f32x4*)(rope + ((axis * 64 + pos) * 16 + 4 * fq) * 2), cs1 = *(const f32x4*)(rope + ((axis * 64 + pos) * 16 + 4 * fq + 2) * 2);
                    v0 = (f32x4){v0[0] * cs0[0] - v0[1] * cs0[1], v0[1] * cs0[0] + v0[0] * cs0[1], v0[2] * cs0[2] - v0[3] * cs0[3], v0[3] * cs0[2] + v0[2] * cs0[3]};
                    v1 = (f32x4){v1[0] * cs1[0] - v1[1] * cs1[1], v1[1] * cs1[0] + v1[0] * cs1[1], v1[2] * cs1[2] - v1[3] * cs1[3], v1[3] * cs1[2] + v1[2] * cs1[3]};
                }
                if (wc < 2) { if (MODE == 0) *(u32x4*)(TQ + (size_t)row * 64 + c32) = pack8(v0 * TINY_C2, v1 * TINY_C2); }
                else *(u32x4*)(TKA + kvrow * 64 + c32) = pack8(v0, v1);
                if (wc < 2) *(u32x4*)(TVA + kvrow * 64 + c32) = pack8(acc[ai][1][m][0] + b10, acc[ai][1][m][1] + b11);
            }
    }
};

struct EpiT {
    static constexpr bool PERM = true;
    unsigned char* ws; const float* biasT; int ldc, pm_off, ctx;
    __device__ __forceinline__ void operator()(EPI_ARGS) const {
        const int rt = u.pm + pm_off;
        const int col0 = u.pn * 256 + wc * 32 + 8 * fq;
        const size_t woff = rt < 4 ? WS_VT : (ctx ? WS_NVCT : WS_NVT);
        bf16_t* O = (bf16_t*)(ws + woff);
#pragma unroll
        for (int ai = 0; ai < 2; ++ai)
#pragma unroll
            for (int m = 0; m < 4; ++m) {
                const int ch = rt * 256 + ai * 128 + wr * 64 + m * 16 + fr; const float bv = biasT[ch];
                bf16_t* rowp = O + (size_t)(rt < 4 ? ch : ch - 1024) * ldc + col0;
#pragma unroll
                for (int bj = 0; bj < 2; ++bj) { f32x4 v0 = acc[ai][bj][m][0] + bv, v1 = acc[ai][bj][m][1] + bv;
                    if (rt < 4) { v0 = gelu4(v0); v1 = gelu4(v1); }
                    *(u32x4*)(rowp + bj * 128) = pack8(v0, v1); } }
    }
};

struct EpiGate {
    static constexpr bool PERM = true;
    const bf16_t* gate; const bf16_t* addend; bf16_t* out;
    __device__ __forceinline__ void operator()(EPI_ARGS) const {
        const int row0 = u.pm * 256 + wr * 64 + fr, col0 = u.pn * 256 + wc * 32 + 8 * fq;
#pragma unroll
        for (int ai = 0; ai < 2; ++ai)
#pragma unroll
            for (int m = 0; m < 4; ++m) { const size_t off = (size_t)(row0 + ai * 128 + m * 16) * 1024 + col0;
#pragma unroll
                for (int bj = 0; bj < 2; ++bj) { f32x4 g0, g1; unpack8(*(const u32x4*)(gate + off + bj * 128), g0, g1);
                    f32x4 o0 = g0 * acc[ai][bj][m][0], o1 = g1 * acc[ai][bj][m][1];
                    if (addend) { f32x4 a0, a1; unpack8(*(const u32x4*)(addend + off + bj * 128), a0, a1); o0 += a0; o1 += a1; }
                    *(u32x4*)(out + off + bj * 128) = pack8(o0, o1); } }
    }
};

struct EpiXmid {
    static constexpr bool PERM = true;
    const float* x; const float* mod; bf16_t* xmid;
    __device__ __forceinline__ void operator()(EPI_ARGS) const {
        const int row0 = u.pm * 256 + wr * 64 + fr, col0 = u.pn * 256 + wc * 32 + 8 * fq;
        const float* gm = mod + (size_t)(u.pm >> 3) * 6144 + 2048;
        f32x4 gv[2][2];
#pragma unroll
        for (int bj = 0; bj < 2; ++bj)
#pragma unroll
            for (int n = 0; n < 2; ++n) gv[bj][n] = *(const f32x4*)(gm + col0 + bj * 128 + n * 4);
#pragma unroll
        for (int ai = 0; ai < 2; ++ai)
#pragma unroll
            for (int m = 0; m < 4; ++m) { const size_t off = (size_t)(row0 + ai * 128 + m * 16) * 1024 + col0;
#pragma unroll
                for (int bj = 0; bj < 2; ++bj) { const f32x4 x0 = *(const f32x4*)(x + off + bj * 128), x1 = *(const f32x4*)(x + off + bj * 128 + 4);
                    *(u32x4*)(xmid + off + bj * 128) = pack8(x0 + gv[bj][0] * acc[ai][bj][m][0], x1 + gv[bj][1] * acc[ai][bj][m][1]); } }
    }
};

struct EpiMoeGU {
    static constexpr bool PERM = true;
    bf16_t* act;
    __device__ __forceinline__ void operator()(EPI_ARGS) const {
        const int row0 = u.pm * 256 + wr * 64 + fr, col0 = u.pn * 128 + wc * 32 + 8 * fq;
#pragma unroll
        for (int ai = 0; ai < 2; ++ai)
#pragma unroll
            for (int m = 0; m < 4; ++m) { f32x4 o[2];
#pragma unroll
                for (int n = 0; n < 2; ++n) { const f32x4 g = acc[ai][0][m][n], up = acc[ai][1][m][n]; o[n] = g * sigmoid4(g) * up; }
                *(u32x4*)(act + (size_t)(row0 + ai * 128 + m * 16) * 256 + col0) = pack8(o[0], o[1]); }
    }
};

struct MoeLists { const int* crow; const float* w; const unsigned* cnt; };
__device__ __forceinline__ bool moe_lookup(const MoeLists& L, int e, int idx, int& crow, float& w) {
    if (e == 64) { crow = idx * 9 + 8; w = 1.f; return true; }
    if (idx >= (int)L.cnt[e]) { crow = 0; w = 0.f; return false; }
    crow = L.crow[(size_t)e * GTOK + idx]; w = L.w[(size_t)e * GTOK + idx]; return true;
}
__device__ __forceinline__ unsigned pk4_fp8(f32x4 v) {
    const float L = 448.f;
    int d = __builtin_amdgcn_cvt_pk_fp8_f32(__builtin_amdgcn_fmed3f(v[0], -L, L), __builtin_amdgcn_fmed3f(v[1], -L, L), 0, false);
    d = __builtin_amdgcn_cvt_pk_fp8_f32(__builtin_amdgcn_fmed3f(v[2], -L, L), __builtin_amdgcn_fmed3f(v[3], -L, L), d, true);
    return (unsigned)d;
}
struct EpiMoeDown {
    static constexpr bool PERM = true;
    unsigned char* C; MoeLists L;
    __device__ __forceinline__ void operator()(EPI_ARGS) const {
        const int col0 = u.pn * 256 + wc * 32 + 8 * fq;
#pragma unroll
        for (int ai = 0; ai < 2; ++ai)
#pragma unroll
            for (int m = 0; m < 4; ++m) { int crow; float w; const bool ok = moe_lookup(L, u.e, u.r0 + ai * 128 + wr * 64 + m * 16 + fr, crow, w);
                if (ok) { const int tl = crow / 9, k = crow - tl * 9; unsigned char* tp = C + (size_t)tl * CROW_BYTES;
                    if (u.e == 64) {
#pragma unroll
                        for (int bj = 0; bj < 2; ++bj) *(u32x4*)(tp + 8192 + (col0 + bj * 128) * 2) = pack8(acc[ai][bj][m][0] * w, acc[ai][bj][m][1] * w);
                    } else {
#pragma unroll
                        for (int bj = 0; bj < 2; ++bj) { u32x2 o; o.x = pk4_fp8(acc[ai][bj][m][0] * w); o.y = pk4_fp8(acc[ai][bj][m][1] * w); *(u32x2*)(tp + k * 1024 + col0 + bj * 128) = o; } } }
                if (m & 1) asm volatile("" ::: "memory"); }
    }
};

struct MoeOrder {
    const volatile LAS unsigned* blk; int nblk, NT, G, c; MoeLists L; int K2, hb;
    __device__ __forceinline__ bool next(int i, pg8::Unit& u) const {
        const int Lq = i * G + c; if (Lq >= nblk * NT) return false;
        const int j = Lq / NT; const unsigned v = (unsigned)__builtin_amdgcn_readfirstlane((int)blk[j]);
        u.pm = j; u.pn = Lq - j * NT; u.e = (int)(v >> 16); u.r0 = (int)(v & 0xffffu) * 256; u.skip = 0; return true;
    }
    __device__ __forceinline__ unsigned rowoff(const pg8::Unit& u, int r) const {
        int crow; float w; const bool ok = moe_lookup(L, u.e, u.r0 + r, crow, w);
        const int tok = ok ? hb + crow / 9 : MTOK;
        return (unsigned)tok * (unsigned)K2;
    }
};
struct Frame {
    LAS unsigned char* lds; volatile LAS unsigned* MISC; unsigned* ctl;
    int tid, lane, wave, vcu, G;
};
#define LDS_WAIT() asm volatile("s_waitcnt lgkmcnt(0)" ::: "memory")

__device__ __forceinline__ void p0_adaln(Frame& F, const float* c, const float* c_ctx, const float* w_ada, const float* b_ada, float* mod) {
    LAS float* s = (LAS float*)F.lds;
    for (int i = F.tid; i < 33 * 1024; i += NTHREADS) { const float v = (i < 32 * 1024) ? c[i] : c_ctx[i - 32 * 1024]; s[i] = v / (1.f + __expf(-v)); }
    __syncthreads();
    for (int cb = F.vcu; cb < 256; cb += F.G) {
        const int n0 = cb * 24 + F.wave * 3;
        float acc[3][33];
#pragma unroll
        for (int j = 0; j < 3; ++j)
#pragma unroll
            for (int b = 0; b < 33; ++b) acc[j][b] = 0.f;
        for (int i = 0; i < 16; ++i) {
            const int k = F.lane + 64 * i;
            const float w0 = w_ada[(size_t)k * 6144 + n0], w1 = w_ada[(size_t)k * 6144 + n0 + 1], w2 = w_ada[(size_t)k * 6144 + n0 + 2];
#pragma unroll
            for (int b = 0; b < 33; ++b) { const float sv = s[b * 1024 + k]; acc[0][b] += sv * w0; acc[1][b] += sv * w1; acc[2][b] += sv * w2; }
        }
#pragma unroll
        for (int j = 0; j < 3; ++j)
#pragma unroll
            for (int b = 0; b < 33; ++b) { const float t = wave_sum(acc[j][b]); if (F.lane == 0) mod[b * 6144 + n0 + j] = t + b_ada[n0 + j]; }
    }
    __syncthreads();
}

__device__ __forceinline__ void tr_block(const float* W, int ldw, int k0, int n0, bf16_t* WT, int ldk, int drow0, LAS float* scr, int lane) {
#pragma unroll 8
    for (int i = 0; i < 32; ++i) { const int kk = 2 * i + (lane >> 5); scr[kk * 33 + (lane & 31)] = W[(size_t)(k0 + kk) * ldw + n0 + (lane & 31)]; }
    LDS_WAIT(); asm volatile("" ::: "memory");
    const int c = lane & 7;
#pragma unroll
    for (int j = 0; j < 4; ++j) { const int n = (lane >> 3) + 8 * j; const LAS float* s = scr + (8 * c) * 33 + n;
        u32x4 o; o.x = pk2(s[0 * 33], s[1 * 33]); o.y = pk2(s[2 * 33], s[3 * 33]); o.z = pk2(s[4 * 33], s[5 * 33]); o.w = pk2(s[6 * 33], s[7 * 33]);
        *(u32x4*)(WT + (size_t)(drow0 + n) * ldk + k0 + 8 * c) = o; }
    LDS_WAIT(); asm volatile("" ::: "memory");
}
struct TrJob { const float* W; bf16_t* WT; int ldw, K, ncols, n0, drow0, nrep, mode; size_t wrs, wtrs; };
__device__ __forceinline__ int trjob_items(const TrJob& j) { return j.nrep * (j.K / 64) * (j.ncols / 32); }
__device__ __forceinline__ void trjob_run(const TrJob& j, int item, LAS float* scr, int lane) {
    const int per = (j.K / 64) * (j.ncols / 32); const int rep = item / per, r = item - rep * per; const int nblk = j.ncols / 32, kb = r / nblk, nb = r - kb * nblk;
    int drow = j.drow0 + 32 * nb;
    if (j.mode != 0) { const int c0 = 32 * nb; drow = j.drow0 + 256 * (c0 >> 7) + (c0 & 127) + (j.mode == 2 ? 128 : 0); }
    tr_block(j.W + (size_t)rep * j.wrs, j.ldw, 64 * kb, j.n0 + 32 * nb, j.WT + (size_t)rep * j.wtrs, j.K, drow, scr, lane);
}

__device__ __forceinline__ void norm_mod_row(const float* xrow, const float* g, const float* shift, const float* scale, bf16_t* orow, int lane) {
    const f32x4* xr = (const f32x4*)xrow + lane;
    f32x4 v[4]; float s = 0.f;
#pragma unroll
    for (int j = 0; j < 4; ++j) { v[j] = xr[64 * j]; s += (v[j].x * v[j].x + v[j].y * v[j].y) + (v[j].z * v[j].z + v[j].w * v[j].w); }
    const float r = 1.f / sqrtf(wave_sum(s) * (1.f / DM) + NORM_EPS);
    u32x2* o8 = (u32x2*)orow + lane;
#pragma unroll
    for (int j = 0; j < 4; ++j) { const f32x4 gv = ((const f32x4*)g)[lane + 64 * j], sh = ((const f32x4*)shift)[lane + 64 * j], sc = ((const f32x4*)scale)[lane + 64 * j];
        const f32x4 h = v[j] * r * gv * (sc + 1.f) + sh; u32x2 w; w.x = pk2(h.x, h.y); w.y = pk2(h.z, h.w); o8[64 * j] = w; }
}

namespace tattn {
using f32x16 = __attribute__((ext_vector_type(16))) float;
using s16x4 = __attribute__((ext_vector_type(4))) short;
constexpr int TP = 64;
constexpr int NW = 8, QBLK = 32, QB = QBLK * NW, KVBLK = 64;
__device__ __forceinline__ int crow(int r, int hi) { return (r & 3) + 8 * (r >> 2) + 4 * hi; }
#define SBAR() __builtin_amdgcn_sched_barrier(0)
constexpr int NSLOT = 3, SLOTB = 8192;
constexpr int LDS_K = 0, LDS_V = NSLOT * SLOTB, LDS_WS = 2 * NSLOT * SLOTB, LDS_OST = LDS_WS + NW * 64 * 4, LDS_BYTES_T = LDS_OST + NW * 4096;
__device__ __forceinline__ void glds16(const void* gsrc, unsigned lds_dst) { unsigned keep;
    asm volatile("s_mov_b32 %0, m0\n\ts_mov_b32 m0, %2\n\ts_nop 0\n\tglobal_load_lds_dwordx4 %1, off\n\ts_mov_b32 m0, %0" : "=&s"(keep) : "v"(gsrc), "s"(lds_dst) : "memory"); }
__device__ __forceinline__ float max3f(float a, float b, float c) { float r; asm("v_max3_f32 %0, %1, %2, %3" : "=v"(r) : "v"(a), "v"(b), "v"(c)); return r; }
__device__ __forceinline__ float max2f(float a, float b) { float r; asm("v_max_f32_e32 %0, %1, %2" : "=v"(r) : "v"(a), "v"(b)); return r; }
__device__ __forceinline__ float fadd_s(float a, float b) { float r; asm("v_add_f32_e32 %0, %1, %2" : "=v"(r) : "v"(a), "v"(b)); return r; }
__device__ __forceinline__ float fsub_s(float a, float b) { float r; asm("v_sub_f32_e32 %0, %1, %2" : "=v"(r) : "v"(a), "v"(b)); return r; }
typedef float f32x2_t __attribute__((ext_vector_type(2))); typedef __bf16 bf16x2_t __attribute__((ext_vector_type(2)));
__device__ __forceinline__ unsigned cvtpk_s(float lo, float hi) { f32x2_t v = {lo, hi}; bf16x2_t b = __builtin_convertvector(v, bf16x2_t); return __builtin_bit_cast(unsigned, b); }
#define WAIT_BAR(N) asm volatile("s_waitcnt vmcnt(" #N ") lgkmcnt(0)\n\ts_barrier" ::: "memory")
__device__ __forceinline__ void qkt(f32x16& p0, f32x16& p1, const char* Kslot, const bf16x8* qr, const f32x16& negm, int r32, int hi) {
    const char* kb = Kslot + hi * 1024 + r32 * 16;
#pragma unroll
    for (int d0 = 0; d0 < 4; ++d0) {
        const bf16x8 b0 = *reinterpret_cast<const bf16x8*>(kb + d0 * 2048);
        const bf16x8 b1 = *reinterpret_cast<const bf16x8*>(kb + d0 * 2048 + 512);
        if (d0 == 0) { p0 = __builtin_amdgcn_mfma_f32_32x32x16_bf16(b0, qr[0], negm, 0, 0, 0); p1 = __builtin_amdgcn_mfma_f32_32x32x16_bf16(b1, qr[0], negm, 0, 0, 0); }
        else { p0 = __builtin_amdgcn_mfma_f32_32x32x16_bf16(b0, qr[d0], p0, 0, 0, 0); p1 = __builtin_amdgcn_mfma_f32_32x32x16_bf16(b1, qr[d0], p1, 0, 0, 0); } }
}
typedef __attribute__((address_space(3))) const char* lds_cptr;
typedef short v4i16_t __attribute__((ext_vector_type(4)));
__device__ __forceinline__ void kload8(bf16x8* kf, lds_cptr kp) {
    kf[0] = *(const __attribute__((address_space(3))) bf16x8*)(kp);        kf[1] = *(const __attribute__((address_space(3))) bf16x8*)(kp + 512);
    kf[2] = *(const __attribute__((address_space(3))) bf16x8*)(kp + 2048); kf[3] = *(const __attribute__((address_space(3))) bf16x8*)(kp + 2560);
    kf[4] = *(const __attribute__((address_space(3))) bf16x8*)(kp + 4096); kf[5] = *(const __attribute__((address_space(3))) bf16x8*)(kp + 4608);
    kf[6] = *(const __attribute__((address_space(3))) bf16x8*)(kp + 6144); kf[7] = *(const __attribute__((address_space(3))) bf16x8*)(kp + 6656);
}
__device__ __forceinline__ void kload2(bf16x8* kf, lds_cptr kp, int j) { kf[2 * j] = *(const __attribute__((address_space(3))) bf16x8*)(kp + j * 2048); kf[2 * j + 1] = *(const __attribute__((address_space(3))) bf16x8*)(kp + j * 2048 + 512); }
__device__ __forceinline__ s16x4 vtr(lds_cptr p) { return __builtin_bit_cast(s16x4, __builtin_amdgcn_ds_read_tr16_b64_v4i16((__attribute__((address_space(3))) v4i16_t*)p)); }
__device__ __forceinline__ float rowmax(const f32x16& p0, const f32x16& p1) {
    float a = max3f(p0[0], p0[1], p1[0]), b = max3f(p0[2], p0[3], p1[1]); a = max3f(a, p1[2], p1[3]);
#pragma unroll
    for (int r = 4; r < 16; r += 4) { a = max3f(a, p0[r], p0[r + 1]); b = max3f(b, p0[r + 2], p0[r + 3]); a = max3f(a, p1[r], p1[r + 1]); b = max3f(b, p1[r + 2], p1[r + 3]); }
    const float m = max2f(a, b);
    auto rr = __builtin_amdgcn_permlane32_swap(__float_as_uint(m), __float_as_uint(m), false, false);
    return max2f(__uint_as_float(rr[0]), __uint_as_float(rr[1]));
}
__device__ __forceinline__ void pv(f32x16* o, int vb, bf16x8 pa0, bf16x8 pa1, bf16x8 pa2, bf16x8 pa3) {
#pragma unroll
    for (int d0 = 0; d0 < 2; ++d0) { s16x4 lo[4], hi[4];
#pragma unroll
        for (int ks = 0; ks < 4; ++ks) {
            asm volatile("ds_read_b64_tr_b16 %0,%1 offset:%c2" : "=&v"(lo[ks]) : "v"(vb), "i"(d0 * 4096 + ks * 1024) : "memory");
            asm volatile("ds_read_b64_tr_b16 %0,%1 offset:%c2" : "=&v"(hi[ks]) : "v"(vb), "i"(d0 * 4096 + ks * 1024 + 512) : "memory"); }
        asm volatile("s_waitcnt lgkmcnt(0)" ::: "memory"); SBAR();
#define PK(k) (bf16x8){lo[k][0], lo[k][1], lo[k][2], lo[k][3], hi[k][0], hi[k][1], hi[k][2], hi[k][3]}
        o[d0] = __builtin_amdgcn_mfma_f32_32x32x16_bf16(pa0, PK(0), o[d0], 0, 0, 0);
        o[d0] = __builtin_amdgcn_mfma_f32_32x32x16_bf16(pa1, PK(1), o[d0], 0, 0, 0);
        o[d0] = __builtin_amdgcn_mfma_f32_32x32x16_bf16(pa2, PK(2), o[d0], 0, 0, 0);
        o[d0] = __builtin_amdgcn_mfma_f32_32x32x16_bf16(pa3, PK(3), o[d0], 0, 0, 0);
#undef PK
    }
}
template <int THRL, int NKEYS> __device__ __forceinline__ void attn_unit(const bf16_t* Qu, const bf16_t* __restrict__ Kb, const bf16_t* __restrict__ Vb, bf16_t* Ou, char* shm) {
    const int tid = threadIdx.x, lane = tid & 63, r32 = lane & 31, hi = lane >> 5; const int wid = __builtin_amdgcn_readfirstlane(tid >> 6);
    const bf16_t* Qw = Qu + (long)(wid * QBLK) * TP;
    const bf16_t *Kh = Kb, *Vh = Vb;
    const unsigned lds0 = (unsigned)(uintptr_t)shm;
    float* wsf = (float*)(shm + LDS_WS) + wid * 64;
    const bf16_t* ksrc = Kh + (long)lane * TP + wid * 8;
    const bf16_t* vsrc = Vh + (long)(16 * (wid & 3) + (lane >> 2)) * TP + (wid >> 2) * 32 + (lane & 3) * 8;
    const unsigned kdst = lds0 + LDS_K + wid * 1024, vdst = lds0 + LDS_V + wid * 1024;
#define DMA_K(t, slot) glds16(ksrc + (long)(t) * KVBLK * TP, (unsigned)__builtin_amdgcn_readfirstlane(kdst + (slot)))
#define DMA_V(t, slot) glds16(vsrc + (long)(t) * KVBLK * TP, (unsigned)__builtin_amdgcn_readfirstlane(vdst + (slot)))
    const int vb0 = (int)(lds0 + LDS_V) + ((lane >> 4) & 1) * 32 + (lane & 3) * 8 + (4 * hi + ((lane & 15) >> 2)) * 64;
    const char* Kbase = shm + LDS_K; bf16x8 kf[8];
    const lds_cptr shm3 = (lds_cptr)shm; const lds_cptr kp0 = shm3 + LDS_K + hi * 1024 + r32 * 16; const lds_cptr vp0 = shm3 + LDS_V + ((lane >> 4) & 1) * 32 + (lane & 3) * 8 + (4 * hi + ((lane & 15) >> 2)) * 64;
    constexpr int NT = NKEYS / KVBLK;
    static_assert(NT % 2 == 0 && NT >= 8, "NT even");
    DMA_K(0, 0); DMA_V(0, 0); DMA_K(1, SLOTB);
    bf16x8 qr[4];
#pragma unroll
    for (int d0 = 0; d0 < 4; ++d0) qr[d0] = *reinterpret_cast<const bf16x8*>(&Qw[(long)r32 * TP + d0 * 16 + hi * 8]);
    float mhat = 0.f, l_reg = 0.f; f32x16 o[2]; o[0] = f32x16{}; o[1] = f32x16{}; f32x16 negm = f32x16{}; asm volatile("" : "+v"(negm));
    bool resc = false;
#define START(P0, P1) do { const float rm = rowmax(P0, P1); resc = false; \
    { const float dl = rm; mhat = fadd_s(mhat, dl); \
      _Pragma("unroll") for (int r = 0; r < 16; ++r) { P0[r] = fsub_s(P0[r], dl); P1[r] = fsub_s(P1[r], dl); } \
      _Pragma("unroll") for (int r = 0; r < 16; ++r) negm[r] = -mhat; asm volatile("" : "+v"(negm)); } \
    _Pragma("unroll") for (int r = 0; r < 16; ++r) P0[r] = __builtin_amdgcn_exp2f(P0[r]); } while (0)
#define RESC() do { if (resc) { asm volatile("s_waitcnt lgkmcnt(0)" ::: "memory"); \
      _Pragma("unroll") for (int d_ = 0; d_ < 2; ++d_) _Pragma("unroll") for (int r = 0; r < 16; ++r) o[d_][r] *= wsf[crow(r, hi)]; } } while (0)
    f32x16 pA0, pA1, pB0, pB1;
    int sl_prev = 0, sl_cur = 0, sl_next = SLOTB;
#define ROT() do { sl_prev = sl_cur; sl_cur = sl_next; sl_next = (sl_next == (NSLOT - 1) * SLOTB) ? 0 : sl_next + SLOTB; } while (0)
    DMA_K(2, 2 * SLOTB);
    WAIT_BAR(3);
    qkt(pA0, pA1, Kbase, qr, negm, r32, hi); asm volatile("s_nop 15\n\ts_nop 7" : "+v"(pA0), "+v"(pA1));
    START(pA0, pA1);
    _Pragma("unroll") for (int r = 0; r < 16; ++r) pA1[r] = __builtin_amdgcn_exp2f(pA1[r]);
    WAIT_BAR(0);
    DMA_K(3, 0); DMA_V(1, SLOTB);
    ROT();
    kload8(kf, kp0 + sl_cur);
    WAIT_BAR(2);
    s16x4 vlo[8], vhi[8]; u32x4 pw0, pw1, pw2, pw3;
#define PKW(P, B) cvtpk_s(P[B], P[B + 1])
#define PAF(k) __builtin_bit_cast(bf16x8, pw##k)
#define VFR(i) (bf16x8){vlo[i][0], vlo[i][1], vlo[i][2], vlo[i][3], vhi[i][0], vhi[i][1], vhi[i][2], vhi[i][3]}
#define PIN(x) asm volatile("" : "+v"(x))
#define MX3(a, b, c) __builtin_fmaxf(__builtin_fmaxf((a), (b)), (c))
#define GAPA(MF, A0, A1, A2, A3, W0, W1, PW) do { MF; sacc += A0; sacc += A1; sacc += A2; sacc += A3; PIN(sacc); W0; W1; PIN(PW); SBAR(); } while (0)
#define EX(v) __builtin_amdgcn_exp2f(v)
#define GAPB(MF, X, B) do { MF; X[B] = EX(X[B]); X[B + 1] = EX(X[B + 1]); X[B + 2] = EX(X[B + 2]); X[B + 3] = EX(X[B + 3]); PIN(X); SBAR(); } while (0)
#define VRD(i) do { vlo[i] = vtr(vp_ + (((i) >> 2) * 4096 + ((i) & 3) * 1024)); vhi[i] = vtr(vp_ + (((i) >> 2) * 4096 + ((i) & 3) * 1024 + 512)); } while (0)
#define KRD(G, j) do { if (G) { kload2(kf, kp0 + sl_next, j); SBAR(); } } while (0)
#define STEP(C0, C1, P0, P1, t, GK, GV, GL) do { SBAR(); \
    const lds_cptr vp_ = vp0 + sl_prev; \
    VRD(0); SBAR(); float sacc = (P0[0] + P0[1]); \
    GAPA(C0 = __builtin_amdgcn_mfma_f32_32x32x16_bf16(kf[0], qr[0], negm, 0, 0, 0), P0[2], P0[3], P0[4], P0[5],     pw0[0] = PKW(P0, 0), pw0[1] = PKW(P0, 2), pw0); \
    VRD(4); SBAR(); GAPA(C1 = __builtin_amdgcn_mfma_f32_32x32x16_bf16(kf[1], qr[0], negm, 0, 0, 0), P0[6], P0[7], P0[8], P0[9],     pw0[2] = PKW(P0, 4), pw0[3] = PKW(P0, 6), pw0); \
    VRD(1); SBAR(); GAPA(C0 = __builtin_amdgcn_mfma_f32_32x32x16_bf16(kf[2], qr[1], C0, 0, 0, 0),   P0[10], P0[11], P0[12], P0[13], pw1[0] = PKW(P0, 8), pw1[1] = PKW(P0, 10), pw1); \
    VRD(5); SBAR(); GAPA(C1 = __builtin_amdgcn_mfma_f32_32x32x16_bf16(kf[3], qr[1], C1, 0, 0, 0),   P0[14], P0[15], P1[0], P1[1],   pw1[2] = PKW(P0, 12), pw1[3] = PKW(P0, 14), pw1); \
    VRD(2); SBAR(); GAPA(C0 = __builtin_amdgcn_mfma_f32_32x32x16_bf16(kf[4], qr[2], C0, 0, 0, 0),   P1[2], P1[3], P1[4], P1[5],     pw2[0] = PKW(P1, 0), pw2[1] = PKW(P1, 2), pw2); \
    VRD(6); SBAR(); GAPA(C1 = __builtin_amdgcn_mfma_f32_32x32x16_bf16(kf[5], qr[2], C1, 0, 0, 0),   P1[6], P1[7], P1[8], P1[9],     pw2[2] = PKW(P1, 4), pw2[3] = PKW(P1, 6), pw2); \
    VRD(3); SBAR(); GAPA(C0 = __builtin_amdgcn_mfma_f32_32x32x16_bf16(kf[6], qr[3], C0, 0, 0, 0),   P1[10], P1[11], P1[12], P1[13], pw3[0] = PKW(P1, 8), pw3[1] = PKW(P1, 10), pw3); \
    VRD(7); SBAR(); GAPA(C1 = __builtin_amdgcn_mfma_f32_32x32x16_bf16(kf[7], qr[3], C1, 0, 0, 0),   P1[14], P1[15], 0.f, 0.f,       pw3[2] = PKW(P1, 12), pw3[3] = PKW(P1, 14), pw3); \
    l_reg += sacc; \
    if (GK) { DMA_K((t) + 3, sl_cur); } if (GV) { DMA_V((t) + 1, sl_next); } \
    { float a = MX3(C0[0], C0[1], C1[0]), b = MX3(C0[2], C0[3], C1[1]); a = MX3(a, C1[2], C1[3]); \
      _Pragma("unroll") for (int r = 4; r < 16; r += 4) { a = MX3(a, C0[r], C0[r + 1]); b = MX3(b, C0[r + 2], C0[r + 3]); a = MX3(a, C1[r], C1[r + 1]); b = MX3(b, C1[r + 2], C1[r + 3]); } \
      float rm = __builtin_fmaxf(a, b); { auto rr = __builtin_amdgcn_permlane32_swap(__float_as_uint(rm), __float_as_uint(rm), false, false); rm = __builtin_fmaxf(__uint_as_float(rr[0]), __uint_as_float(rr[1])); } \
      resc = false; \
      if (__builtin_expect(__any(rm > (float)THRL), 0)) { const float dl = __builtin_fmaxf(rm, 0.f); mhat += dl; \
        _Pragma("unroll") for (int r = 0; r < 16; ++r) { C0[r] -= dl; C1[r] -= dl; } \
        _Pragma("unroll") for (int r = 0; r < 16; ++r) negm[r] = -mhat; asm volatile("" : "+v"(negm)); \
        const float f = __builtin_amdgcn_exp2f(-dl); l_reg *= f; if (hi == 0) wsf[r32] = f; resc = true; } } \
    SBAR(); \
    GAPB(o[0] = __builtin_amdgcn_mfma_f32_32x32x16_bf16(PAF(0), VFR(0), o[0], 0, 0, 0), C0, 0); \
    GAPB(o[1] = __builtin_amdgcn_mfma_f32_32x32x16_bf16(PAF(0), VFR(4), o[1], 0, 0, 0), C0, 4); \
    KRD(GL, 0); GAPB(o[0] = __builtin_amdgcn_mfma_f32_32x32x16_bf16(PAF(1), VFR(1), o[0], 0, 0, 0), C0, 8); \
    KRD(GL, 1); GAPB(o[1] = __builtin_amdgcn_mfma_f32_32x32x16_bf16(PAF(1), VFR(5), o[1], 0, 0, 0), C0, 12); \
    KRD(GL, 2); GAPB(o[0] = __builtin_amdgcn_mfma_f32_32x32x16_bf16(PAF(2), VFR(2), o[0], 0, 0, 0), C1, 0); \
    KRD(GL, 3); GAPB(o[1] = __builtin_amdgcn_mfma_f32_32x32x16_bf16(PAF(2), VFR(6), o[1], 0, 0, 0), C1, 4); \
    GAPB(o[0] = __builtin_amdgcn_mfma_f32_32x32x16_bf16(PAF(3), VFR(3), o[0], 0, 0, 0), C1, 8); \
    GAPB(o[1] = __builtin_amdgcn_mfma_f32_32x32x16_bf16(PAF(3), VFR(7), o[1], 0, 0, 0), C1, 12); \
    } while (0)
    int t = 1;
    for (; t + 5 < NT; t += 2) {
        STEP(pB0, pB1, pA0, pA1, t, true, true, true);     WAIT_BAR(2); RESC(); ROT();
        STEP(pA0, pA1, pB0, pB1, t + 1, true, true, true); WAIT_BAR(2); RESC(); ROT();
    }
#define ENDW(tt) do { if ((tt) + 3 < NT) { WAIT_BAR(2); } else if ((tt) + 2 < NT) { WAIT_BAR(1); } else { WAIT_BAR(0); } } while (0)
    for (; t + 1 < NT; t += 2) {
        STEP(pB0, pB1, pA0, pA1, t, (t + 3 < NT), (t + 1 < NT), (t + 1 < NT));         ENDW(t);     RESC(); ROT();
        STEP(pA0, pA1, pB0, pB1, t + 1, (t + 4 < NT), (t + 2 < NT), (t + 2 < NT));     ENDW(t + 1); RESC(); ROT();
    }
    STEP(pB0, pB1, pA0, pA1, NT - 1, false, false, false); RESC();
    { float sacc = pB0[0] + pB0[1]; _Pragma("unroll") for (int r = 2; r < 16; ++r) sacc += pB0[r]; _Pragma("unroll") for (int r = 0; r < 16; ++r) sacc += pB1[r]; l_reg += sacc;
      pw0 = (u32x4){PKW(pB0, 0), PKW(pB0, 2), PKW(pB0, 4), PKW(pB0, 6)}; pw1 = (u32x4){PKW(pB0, 8), PKW(pB0, 10), PKW(pB0, 12), PKW(pB0, 14)}; pw2 = (u32x4){PKW(pB1, 0), PKW(pB1, 2), PKW(pB1, 4), PKW(pB1, 6)}; pw3 = (u32x4){PKW(pB1, 8), PKW(pB1, 10), PKW(pB1, 12), PKW(pB1, 14)};
      SBAR(); pv(o, vb0 + sl_cur, PAF(0), PAF(1), PAF(2), PAF(3)); }
#undef PKW
#undef PAF
#undef VFR
#undef PIN
#undef MX3
#undef GAPA
#undef GAPB
#undef EX
#undef VRD
#undef KRD
#undef STEP
#undef ENDW
    { auto rr = __builtin_amdgcn_permlane32_swap(__float_as_uint(l_reg), __float_as_uint(l_reg), false, false); l_reg = __uint_as_float(rr[0]) + __uint_as_float(rr[1]); }
    if (hi == 0) wsf[32 + r32] = l_reg; asm volatile("s_waitcnt lgkmcnt(0)" ::: "memory");
    float rli[16];
#pragma unroll
    for (int r = 0; r < 16; ++r) rli[r] = __builtin_amdgcn_rcpf(wsf[32 + crow(r, hi)]);
    bf16_t* Ow = Ou + (long)(wid * QBLK) * TP;
    { bf16_t* stg = (bf16_t*)(shm + LDS_OST) + wid * 2048;
#pragma unroll
      for (int r = 0; r < 16; ++r) { const int orow = crow(r, hi);
#pragma unroll
        for (int d0 = 0; d0 < 2; ++d0) stg[orow * 64 + d0 * 32 + r32] = (bf16_t)f2bf(o[d0][r] * rli[r]); }
      asm volatile("s_waitcnt lgkmcnt(0)" ::: "memory");
#pragma unroll
      for (int i = 0; i < 4; ++i) { const int row = i * 8 + (lane >> 3), ch = lane & 7; const u32x4 v = *(const u32x4*)(stg + row * 64 + ch * 8); *(u32x4*)(Ow + (long)row * TP + ch * 8) = v; } }
    asm volatile("s_waitcnt lgkmcnt(0)\n\ts_barrier" ::: "memory");
#undef DMA_K
#undef DMA_V
#undef START
#undef RESC
#undef ROT
}
#undef SBAR
#undef WAIT_BAR
}
constexpr int NA_KL = 0, NA_VL = 45056, NA_KC = 94720, NA_VC = 111104, NA_RPB = 128000;
constexpr int NA_VLP = 1552, NA_VCP = 528;
__device__ __forceinline__ int na_kaddr(int key, int c) { return key * 64 + ((c ^ ((key >> 2) & 3)) << 4); }
__device__ __forceinline__ void na_task(int b, int r, int ct, int h, int kr0, const bf16_t* NQ, bf16_t* OB, const LAS unsigned char* L, int lane) {
    const int qi = lane & 15, g = lane >> 4;
    const int c0 = ct * 16; const int kc0 = min(max(c0 - 8, 0), 32);
    const int r_start = min(max(r - 4, 0), 24);
    const int krl = r_start - kr0;
    const size_t qrow = (size_t)b * 2048 + r * 64 + c0 + qi;
    const bf16x8 qf = *(const bf16x8*)(NQ + qrow * 512 + h * 32 + 8 * g);
    f32x4 s[32];
    const f32x4 z4 = {0.f, 0.f, 0.f, 0.f};
#pragma unroll
    for (int kr = 0; kr < 8; ++kr)
#pragma unroll
        for (int cg = 0; cg < 2; ++cg) {
            const int key = (krl + kr) * 64 + kc0 + 16 * cg + qi;
            const bf16x8 kf = *(const LAS bf16x8*)(L + NA_KL + na_kaddr(key, g));
            s[kr * 2 + cg] = __builtin_amdgcn_mfma_f32_16x16x32_bf16(kf, qf, z4, 0, 0, 0);
        }
#pragma unroll
    for (int tc = 0; tc < 16; ++tc) {
        const bf16x8 kf = *(const LAS bf16x8*)(L + NA_KC + na_kaddr(16 * tc + qi, g));
        s[16 + tc] = __builtin_amdgcn_mfma_f32_16x16x32_bf16(kf, qf, z4, 0, 0, 0);
    }
    const int qc = c0 + qi; const int cs = min(max(qc - 8, 0), 48);
    const LAS float* rp = (const LAS float*)(L + NA_RPB);
    float mk[2][4]; int dcv[2][4];
#pragma unroll
    for (int cg = 0; cg < 2; ++cg)
#pragma unroll
        for (int e = 0; e < 4; ++e) { const int kc = kc0 + 16 * cg + 4 * g + e; mk[cg][e] = ((kc >= cs) && (kc < cs + 16)) ? 0.f : -INFINITY; dcv[cg][e] = min(max(kc - qc + 15, 0), 30); }
    float mx = -INFINITY;
#pragma unroll
    for (int kr = 0; kr < 8; ++kr) {
        const LAS float* rpr = rp + (r_start + kr - r + 7) * 31;
#pragma unroll
        for (int cg = 0; cg < 2; ++cg)
#pragma unroll
            for (int e = 0; e < 4; ++e) { const float v = (s[kr * 2 + cg][e] + rpr[dcv[cg][e]]) + mk[cg][e]; s[kr * 2 + cg][e] = v; mx = fmaxf(mx, v); }
    }
#pragma unroll
    for (int tc = 0; tc < 16; ++tc)
#pragma unroll
        for (int e = 0; e < 4; ++e) mx = fmaxf(mx, s[16 + tc][e]);
    mx = fmaxf(mx, __shfl_xor(mx, 16)); mx = fmaxf(mx, __shfl_xor(mx, 32));
    float l = 0.f;
    u32x4 pf[16];
#pragma unroll
    for (int ks = 0; ks < 16; ++ks) {
        f32x4 a = s[2 * ks], c = s[2 * ks + 1];
#pragma unroll
        for (int e = 0; e < 4; ++e) { a[e] = __builtin_amdgcn_exp2f(a[e] - mx); c[e] = __builtin_amdgcn_exp2f(c[e] - mx); }
        l += (a[0] + a[1]) + (a[2] + a[3]) + (c[0] + c[1]) + (c[2] + c[3]);
        pf[ks] = pack8(a, c);
    }
    l += __shfl_xor(l, 16); l += __shfl_xor(l, 32);
    f32x4 o0 = z4, o1 = z4;
    const LAS unsigned char* vl0 = L + NA_VL + qi * NA_VLP + (krl * 64 + kc0 + 4 * g) * 2;
#pragma unroll
    for (int ks = 0; ks < 8; ++ks) {
        const u32x2 a0 = *(const LAS u32x2*)(vl0 + ks * 128), a1 = *(const LAS u32x2*)(vl0 + ks * 128 + 32);
        const u32x2 b0 = *(const LAS u32x2*)(vl0 + 16 * NA_VLP + ks * 128), b1 = *(const LAS u32x2*)(vl0 + 16 * NA_VLP + ks * 128 + 32);
        const bf16x8 pfr = __builtin_bit_cast(bf16x8, pf[ks]);
        o0 = __builtin_amdgcn_mfma_f32_16x16x32_bf16(__builtin_bit_cast(bf16x8, (u32x4){a0.x, a0.y, a1.x, a1.y}), pfr, o0, 0, 0, 0);
        o1 = __builtin_amdgcn_mfma_f32_16x16x32_bf16(__builtin_bit_cast(bf16x8, (u32x4){b0.x, b0.y, b1.x, b1.y}), pfr, o1, 0, 0, 0);
    }
    const LAS unsigned char* vc0 = L + NA_VC + qi * NA_VCP + (4 * g) * 2;
#pragma unroll
    for (int ks = 0; ks < 8; ++ks) {
        const u32x2 a0 = *(const LAS u32x2*)(vc0 + ks * 64), a1 = *(const LAS u32x2*)(vc0 + ks * 64 + 32);
        const u32x2 b0 = *(const LAS u32x2*)(vc0 + 16 * NA_VCP + ks * 64), b1 = *(const LAS u32x2*)(vc0 + 16 * NA_VCP + ks * 64 + 32);
        const bf16x8 pfr = __builtin_bit_cast(bf16x8, pf[8 + ks]);
        o0 = __builtin_amdgcn_mfma_f32_16x16x32_bf16(__builtin_bit_cast(bf16x8, (u32x4){a0.x, a0.y, a1.x, a1.y}), pfr, o0, 0, 0, 0);
        o1 = __builtin_amdgcn_mfma_f32_16x16x32_bf16(__builtin_bit_cast(bf16x8, (u32x4){b0.x, b0.y, b1.x, b1.y}), pfr, o1, 0, 0, 0);
    }
    const float rl = 1.f / l;
    bf16_t* op = OB + qrow * 512 + h * 32 + 4 * g;
    u32x2 w0, w1; w0.x = pk2(o0[0] * rl, o0[1] * rl); w0.y = pk2(o0[2] * rl, o0[3] * rl); w1.x = pk2(o1[0] * rl, o1[1] * rl); w1.y = pk2(o1[2] * rl, o1[3] * rl);
    *(u32x2*)op = w0; *(u32x2*)(op + 16) = w1;
}

__device__ __forceinline__ void na_phase(Frame& F, const float* na_rpb, const bf16_t* NQ, bf16_t* OB, const bf16_t* NK, const bf16_t* NKC, const bf16_t* NVT, const bf16_t* NVCT) {
    LAS unsigned char* L = F.lds;
    const int tid = F.tid;
    const int npair = BATCH * 16, per = (npair + F.G - 1) / F.G;
    for (int pi = 0; pi < per; ++pi) {
        const int p = F.vcu * per + pi; if (p >= npair) break;
        const int b = p >> 4, h = p & 15;
        __syncthreads();
        for (int i = tid; i < 15 * 31; i += NTHREADS) ((LAS float*)(L + NA_RPB))[i] = na_rpb[h * (15 * 31) + i] * LOG2E;
#pragma unroll
        for (int j = 0; j < 2; ++j) { const int pid = tid + 512 * j, key = pid >> 2, c = pid & 3;
            *(LAS u32x4*)(L + NA_KC + na_kaddr(key, c)) = *(const u32x4*)(NKC + ((size_t)b * 256 + key) * 512 + h * 32 + 8 * c); }
#pragma unroll
        for (int j = 0; j < 2; ++j) { const int pid = tid + 512 * j, dim = pid >> 5, c16 = pid & 31;
            *(LAS u32x4*)(L + NA_VC + dim * NA_VCP + c16 * 16) = *(const u32x4*)(NVCT + (size_t)(h * 32 + dim) * MCTX + (size_t)b * 256 + 8 * c16); }
        for (int rq = 0; rq < 8; ++rq) {
            const int kr0 = min(max(4 * rq - 4, 0), 21);
            if (rq > 0) __syncthreads();
            int tid = F.tid; asm volatile("" : "+v"(tid));
            { u32x4 kv[6];
#pragma unroll
              for (int j = 0; j < 6; ++j) { const int pid = tid + 512 * j; const int key = pid >> 2, c = pid & 3;
                  if (j < 5 || pid < 11 * 64 * 4) kv[j] = *(const u32x4*)(NK + ((size_t)b * 2048 + kr0 * 64 + key) * 512 + h * 32 + 8 * c); }
#pragma unroll
              for (int j = 0; j < 6; ++j) { const int pid = tid + 512 * j; const int key = pid >> 2, c = pid & 3;
                  if (j < 5 || pid < 11 * 64 * 4) *(LAS u32x4*)(L + NA_KL + na_kaddr(key, c)) = kv[j]; } }
            asm volatile("" ::: "memory");
            { u32x4 vv[6];
#pragma unroll
              for (int j = 0; j < 6; ++j) { const int pid = tid + 512 * j; const int dim = pid / 88, rem = pid - dim * 88;
                  if (j < 5 || pid < 32 * 88) vv[j] = *(const u32x4*)(NVT + (size_t)(h * 32 + dim) * MTOK + (size_t)b * 2048 + kr0 * 64 + 8 * rem); }
#pragma unroll
              for (int j = 0; j < 6; ++j) { const int pid = tid + 512 * j; const int dim = pid / 88, rem = pid - dim * 88;
                  if (j < 5 || pid < 32 * 88) *(LAS u32x4*)(L + NA_VL + dim * NA_VLP + rem * 16) = vv[j]; } }
            __syncthreads();
            na_task(b, 4 * rq + (F.wave >> 2), F.wave & 3, h, kr0, NQ, OB, L, F.lane);
            na_task(b, 4 * rq + (F.wave >> 2) + 2, F.wave & 3, h, kr0, NQ, OB, L, F.lane);
        }
    }
    __syncthreads();
}

constexpr int SG_P = 200;
__device__ __forceinline__ void sgu_phase(Frame& F, const bf16_t* VT, const bf16_t* U, bf16_t* OA, const bf16_t* TA, const bf16_t* WS, const bf16_t* WO_T,
                                          const float* ln_g, const float* ln_b, const float* b_s) {
    LAS bf16_t* XS = (LAS bf16_t*)F.lds;
    LAS bf16_t* WM = XS + 128 * SG_P;
    LAS float* red = (LAS float*)(F.lds + 2 * 128 * SG_P * 2);
    LAS float* stat = red + 32 * 128 * 2;
    const int tid = F.tid, lane = F.lane, w = F.wave;
    const int nchunk = MTOK / 128;
    for (int ck = F.vcu; ck < nchunk; ck += F.G) {
        const size_t tok0 = (size_t)ck * 128;
        { const int q8 = tid & 15, cg = tid >> 4; float sm[8], sq[8];
#pragma unroll
          for (int i = 0; i < 8; ++i) { sm[i] = 0.f; sq[i] = 0.f; }
          for (int j = 0; j < 32; ++j) { const int ch = cg + 32 * j; f32x4 a, c; unpack8(*(const u32x4*)(VT + (size_t)ch * MTOK + tok0 + 8 * q8), a, c);
#pragma unroll
              for (int i = 0; i < 4; ++i) { sm[i] += a[i]; sq[i] += a[i] * a[i]; sm[4 + i] += c[i]; sq[4 + i] += c[i] * c[i]; } }
#pragma unroll
          for (int i = 0; i < 8; ++i) { red[(cg * 128 + q8 * 8 + i) * 2] = sm[i]; red[(cg * 128 + q8 * 8 + i) * 2 + 1] = sq[i]; }
          __syncthreads();
          if (tid < 128) { float s = 0.f, q = 0.f; for (int j = 0; j < 32; ++j) { s += red[(j * 128 + tid) * 2]; q += red[(j * 128 + tid) * 2 + 1]; }
              const float mean = s * (1.f / 1024.f), var = fmaxf(q * (1.f / 1024.f) - mean * mean, 0.f); stat[tid * 2] = mean; stat[tid * 2 + 1] = 1.f / sqrtf(var + NORM_EPS); }
#pragma unroll
          for (int j = 0; j < 2; ++j) { const int pid = tid + 512 * j, p = pid >> 3, c8 = pid & 7; *(LAS u32x4*)(XS + p * SG_P + 128 + 8 * c8) = *(const u32x4*)(TA + (tok0 + p) * 64 + 8 * c8); }
          __syncthreads(); }
        for (int g = 0; g < 8; ++g) {
#pragma unroll
            for (int j = 0; j < 4; ++j) { const int pid = tid + 512 * j, p = pid >> 4, q8 = pid & 15; *(LAS u32x4*)(XS + p * SG_P + 8 * q8) = *(const u32x4*)(WS + ((size_t)g * 128 + p) * 128 + 8 * q8); }
#pragma unroll
            for (int j = 0; j < 4; ++j) { const int pid = tid + 512 * j, c = pid >> 4, q8 = pid & 15; const int ch = g * 128 + c;
                f32x4 a, d; unpack8(*(const u32x4*)(VT + (size_t)ch * MTOK + tok0 + 8 * q8), a, d);
                const float lg = ln_g[ch], lb = ln_b[ch];
#pragma unroll
                for (int i = 0; i < 4; ++i) { a[i] = (a[i] - stat[(8 * q8 + i) * 2]) * stat[(8 * q8 + i) * 2 + 1] * lg + lb; d[i] = (d[i] - stat[(8 * q8 + 4 + i) * 2]) * stat[(8 * q8 + 4 + i) * 2 + 1] * lg + lb; }
                *(LAS u32x4*)(WM + c * SG_P + 8 * q8) = pack8(a, d); }
#pragma unroll
            for (int j = 0; j < 2; ++j) { const int pid = tid + 512 * j, c = pid >> 3, c8 = pid & 7; *(LAS u32x4*)(WM + c * SG_P + 128 + 8 * c8) = *(const u32x4*)(WO_T + ((size_t)g * 128 + c) * 64 + 8 * c8); }
            __syncthreads();
            f32x4 acc[2][4];
#pragma unroll
            for (int mi = 0; mi < 2; ++mi)
#pragma unroll
                for (int ni = 0; ni < 4; ++ni) acc[mi][ni] = (f32x4){0.f, 0.f, 0.f, 0.f};
            const int fr = lane & 15, fq = lane >> 4;
#pragma unroll
            for (int kk = 0; kk < 6; ++kk) {
                bf16x8 xf[2], wf[4];
#pragma unroll
                for (int mi = 0; mi < 2; ++mi) xf[mi] = *(const LAS bf16x8*)(XS + (32 * (w >> 1) + 16 * mi + fr) * SG_P + 32 * kk + 8 * fq);
#pragma unroll
                for (int ni = 0; ni < 4; ++ni) wf[ni] = *(const LAS bf16x8*)(WM + (64 * (w & 1) + 16 * ni + fr) * SG_P + 32 * kk + 8 * fq);
#pragma unroll
                for (int mi = 0; mi < 2; ++mi)
#pragma unroll
                    for (int ni = 0; ni < 4; ++ni) acc[mi][ni] = __builtin_amdgcn_mfma_f32_16x16x32_bf16(wf[ni], xf[mi], acc[mi][ni], 0, 0, 0);
            }
#pragma unroll
            for (int mi = 0; mi < 2; ++mi) { const int p = 32 * (w >> 1) + 16 * mi + fr; const float bs = b_s[g * 128 + p];
#pragma unroll
                for (int ni = 0; ni < 4; ++ni) { const size_t uo = (tok0 + p) * 1024 + g * 128 + 64 * (w & 1) + 16 * ni + 4 * fq;
                    const u32x2 uw = *(const u32x2*)(U + uo);
                    const float u0 = __builtin_bit_cast(float, uw.x << 16), u1 = __builtin_bit_cast(float, uw.x & 0xffff0000u), u2 = __builtin_bit_cast(float, uw.y << 16), u3 = __builtin_bit_cast(float, uw.y & 0xffff0000u);
                    u32x2 ow; ow.x = pk2(u0 * (acc[mi][ni][0] + bs), u1 * (acc[mi][ni][1] + bs)); ow.y = pk2(u2 * (acc[mi][ni][2] + bs), u3 * (acc[mi][ni][3] + bs));
                    *(u32x2*)(OA + uo) = ow; } }
            __syncthreads();
        }
    }
}

constexpr int RT_WP = 264;
__device__ __forceinline__ void router_phase(Frame& F, const bf16_t* xmid, const float* mod, const float* gn, const float* b_router, const bf16_t* WRH, const bf16_t* WRL, const float* w_router,
                                             bf16_t* H2, int* list_crow, float* list_w, unsigned* gcount, bool dry) {
    LAS float* t_g = (LAS float*)F.lds;
    LAS float* t_s = t_g + 1024;
    LAS float* br = t_s + 1024;
    LAS float* cvec = br + 64;
    LAS unsigned* lcnt = (LAS unsigned*)(cvec + 64);
    LAS unsigned* lbase = lcnt + 64;
    LAS bf16_t* WH = (LAS bf16_t*)(lbase + 64);
    LAS bf16_t* WL = WH + 64 * RT_WP;
    const int tid = F.tid, lane = F.lane;
    const int fr = lane & 15, fq = lane >> 4;
    for (int blk = F.vcu; blk < MTOK / 256; blk += F.G) {
        const int b = blk >> 3, grp = blk / (GTOK / 256);
        const float* mb = mod + (size_t)b * 6144;
        __syncthreads();
        for (int i = tid; i < 1024; i += NTHREADS) { t_g[i] = gn[i] * (1.f + mb[4 * 1024 + i]); t_s[i] = mb[3 * 1024 + i]; }
        if (tid < 64) { br[tid] = b_router[tid]; lcnt[tid] = 0u; }
        __syncthreads();
        { const int e = tid >> 3, part = tid & 7; float a = 0.f;
#pragma unroll 8
          for (int k = part * 128; k < part * 128 + 128; ++k) a += t_s[k] * w_router[(size_t)k * 64 + e];
          a += __shfl_xor(a, 1); a += __shfl_xor(a, 2); a += __shfl_xor(a, 4);
          if (part == 0) cvec[e] = a; }
        const int tokw = blk * 256 + F.wave * 32;
        f32x4 acc[2][4]; float ssq[2] = {0.f, 0.f};
#pragma unroll
        for (int it = 0; it < 2; ++it)
#pragma unroll
            for (int j = 0; j < 4; ++j) acc[it][j] = (f32x4){0.f, 0.f, 0.f, 0.f};
        for (int kc = 0; kc < 4; ++kc) {
            __syncthreads();
#pragma unroll
            for (int j = 0; j < 4; ++j) { const int pid = tid + 512 * j, e = pid >> 5, c = pid & 31;
                *(LAS u32x4*)(WH + e * RT_WP + 8 * c) = *(const u32x4*)(WRH + (size_t)e * DM + kc * 256 + 8 * c);
                *(LAS u32x4*)(WL + e * RT_WP + 8 * c) = *(const u32x4*)(WRL + (size_t)e * DM + kc * 256 + 8 * c); }
            __syncthreads();
#pragma unroll
            for (int it = 0; it < 2; ++it) {
                const bf16_t* xrow = xmid + (size_t)(tokw + 16 * it + fr) * DM + kc * 256 + 8 * fq;
#pragma unroll 2
                for (int s = 0; s < 8; ++s) {
                    const int kl = 32 * s + 8 * fq;
                    f32x4 x0, x1; unpack8(*(const u32x4*)(xrow + 32 * s), x0, x1);
                    const f32x4 g0 = *(const LAS f32x4*)(t_g + kc * 256 + kl), g1 = *(const LAS f32x4*)(t_g + kc * 256 + kl + 4);
                    ssq[it] += (x0.x * x0.x + x0.y * x0.y) + (x0.z * x0.z + x0.w * x0.w) + (x1.x * x1.x + x1.y * x1.y) + (x1.z * x1.z + x1.w * x1.w);
                    const f32x4 h0 = x0 * g0, h1 = x1 * g1;
                    const u32x4 hi = pack8(h0, h1);
                    f32x4 f0, f1; unpack8(hi, f0, f1);
                    const u32x4 lo = pack8(h0 - f0, h1 - f1);
                    const bf16x8 xh = __builtin_bit_cast(bf16x8, hi), xl = __builtin_bit_cast(bf16x8, lo);
#pragma unroll
                    for (int j = 0; j < 4; ++j) {
                        const bf16x8 wh = *(const LAS bf16x8*)(WH + (16 * j + fr) * RT_WP + kl), wl = *(const LAS bf16x8*)(WL + (16 * j + fr) * RT_WP + kl);
                        acc[it][j] = __builtin_amdgcn_mfma_f32_16x16x32_bf16(wh, xh, acc[it][j], 0, 0, 0);
                        acc[it][j] = __builtin_amdgcn_mfma_f32_16x16x32_bf16(wh, xl, acc[it][j], 0, 0, 0);
                        acc[it][j] = __builtin_amdgcn_mfma_f32_16x16x32_bf16(wl, xh, acc[it][j], 0, 0, 0);
                    }
                }
            }
        }
        float rinv[2]; int sel_e[2][8]; float sel_w[2][8]; unsigned sel_p[2][8];
#pragma unroll
        for (int it = 0; it < 2; ++it) {
            float ss = ssq[it]; ss += __shfl_xor(ss, 16); ss += __shfl_xor(ss, 32);
            rinv[it] = 1.f / sqrtf(ss * (1.f / DM) + NORM_EPS);
            float scv[16], selv[16];
#pragma unroll
            for (int j = 0; j < 4; ++j)
#pragma unroll
                for (int e = 0; e < 4; ++e) { const int ex = 16 * j + 4 * fq + e; const float lg = rinv[it] * acc[it][j][e] + cvec[ex]; const float sg = 1.f / (1.f + __expf(-lg)); scv[4 * j + e] = sg; selv[4 * j + e] = sg + br[ex]; }
            float ssum = 0.f;
#pragma unroll
            for (int kk = 0; kk < 8; ++kk) {
                float bv = -INFINITY, bs = 0.f; int be = 0;
#pragma unroll
                for (int p = 0; p < 16; ++p) { const int ex = 16 * (p >> 2) + 4 * fq + (p & 3); const bool t = selv[p] > bv; bv = t ? selv[p] : bv; bs = t ? scv[p] : bs; be = t ? ex : be; }
#pragma unroll
                for (int o = 16; o <= 32; o <<= 1) { const float ov = __shfl_xor(bv, o), os = __shfl_xor(bs, o); const int oe = __shfl_xor(be, o);
                    const bool t = (ov > bv) || (ov == bv && oe < be); bv = t ? ov : bv; bs = t ? os : bs; be = t ? oe : be; }
#pragma unroll
                for (int p = 0; p < 16; ++p) { const int ex = 16 * (p >> 2) + 4 * fq + (p & 3); selv[p] = (ex == be) ? -INFINITY : selv[p]; }
                sel_e[it][kk] = be; sel_w[it][kk] = bs; ssum += bs;
            }
            const float inv = 2.5f / ssum;
#pragma unroll
            for (int kk = 0; kk < 8; ++kk) sel_w[it][kk] *= inv;
            if (lane < 16) {
#pragma unroll
                for (int kk = 0; kk < 8; ++kk) sel_p[it][kk] = atomicAdd((unsigned*)&lcnt[sel_e[it][kk]], 1u);
            }
        }
#pragma unroll 1
        for (int r2 = 0; r2 < 32; r2 += 2) {
            f32x4 v[2][4];
#pragma unroll
            for (int q = 0; q < 2; ++q)
#pragma unroll
                for (int j = 0; j < 4; ++j) { const u32x2 w = ((const u32x2*)(xmid + (size_t)(tokw + r2 + q) * DM))[lane + 64 * j];
                    v[q][j] = (f32x4){__builtin_bit_cast(float, w.x << 16), __builtin_bit_cast(float, w.x & 0xffff0000u), __builtin_bit_cast(float, w.y << 16), __builtin_bit_cast(float, w.y & 0xffff0000u)}; }
            const float rsel = r2 < 16 ? rinv[0] : rinv[1];
#pragma unroll
            for (int q = 0; q < 2; ++q) { const int rr = r2 + q; const float rv = __shfl(rsel, rr & 15);
                u32x2* o8 = (u32x2*)(H2 + (size_t)(tokw + rr) * DM) + lane;
#pragma unroll
                for (int j = 0; j < 4; ++j) { const f32x4 gv = ((const LAS f32x4*)t_g)[lane + 64 * j], sv = ((const LAS f32x4*)t_s)[lane + 64 * j];
                    const f32x4 h = v[q][j] * rv * gv + sv; u32x2 w; w.x = pk2(h.x, h.y); w.y = pk2(h.z, h.w); o8[64 * j] = w; } }
        }
        __syncthreads();
        if (tid < 64 && !dry) lbase[tid] = atomicAdd(&gcount[grp * 64 + tid], lcnt[tid]);
        __syncthreads();
        if (lane < 16 && !dry) {
#pragma unroll
            for (int it = 0; it < 2; ++it) {
                const int tok = tokw + it * 16 + lane; const int tl = tok - grp * GTOK;
#pragma unroll
                for (int kk = 0; kk < 8; ++kk) { const int e = sel_e[it][kk]; const size_t pos = (size_t)(grp * 64 + e) * GTOK + lbase[e] + sel_p[it][kk];
                    list_crow[pos] = tl * 9 + kk; list_w[pos] = sel_w[it][kk]; }
            }
        }
    }
    __syncthreads();
}

__device__ __forceinline__ void final_phase(Frame& F, int grp, const unsigned char* C, const bf16_t* xmid, const float* mod, const float* fg, float* out) {
    const int gw = F.vcu * NWAVES + F.wave, NGW = F.G * NWAVES, lane = F.lane;
    for (int tl = gw; tl < GTOK; tl += NGW) {
        const int tok = grp * GTOK + tl, b = tok >> 11;
        const float* gf = mod + (size_t)b * 6144 + 5 * 1024 + 16 * lane;
        const unsigned char* tp = C + (size_t)tl * CROW_BYTES;
        u32x4 c8[8];
#pragma unroll
        for (int k = 0; k < 8; ++k) c8[k] = *(const u32x4*)(tp + k * 1024 + 16 * lane);
        const u32x4 s0 = *(const u32x4*)(tp + 8192 + 32 * lane), s1 = *(const u32x4*)(tp + 8192 + 32 * lane + 16);
        const u32x4 xa = *(const u32x4*)(xmid + (size_t)tok * DM + 16 * lane), xb = *(const u32x4*)(xmid + (size_t)tok * DM + 16 * lane + 8);
        f32x4 y[4], xv[4];
        unpack8(s0, y[0], y[1]); unpack8(s1, y[2], y[3]);
        unpack8(xa, xv[0], xv[1]); unpack8(xb, xv[2], xv[3]);
#pragma unroll
        for (int k = 0; k < 8; ++k)
#pragma unroll
            for (int j = 0; j < 4; ++j) { const int d = (int)c8[k][j]; const auto lo = __builtin_amdgcn_cvt_pk_f32_fp8(d, false), hi = __builtin_amdgcn_cvt_pk_f32_fp8(d, true);
                y[j] += (f32x4){lo[0], lo[1], hi[0], hi[1]}; }
        f32x4 v[4]; float s = 0.f;
#pragma unroll
        for (int j = 0; j < 4; ++j) { v[j] = xv[j] + ((const f32x4*)gf)[j] * y[j]; s += (v[j].x * v[j].x + v[j].y * v[j].y) + (v[j].z * v[j].z + v[j].w * v[j].w); }
        const float r = 1.f / sqrtf(wave_sum(s) * (1.f / DM) + NORM_EPS);
        f32x4* orow = (f32x4*)(out + (size_t)tok * DM + 16 * lane);
#pragma unroll
        for (int j = 0; j < 4; ++j) orow[j] = v[j] * r * ((const f32x4*)(fg + 16 * lane))[j];
    }
}
struct Args { const float* in[28]; float* out; unsigned char* ws; int stage, pad1; };

__device__ __forceinline__ int tq_src_col(int j) { const int axis = j >> 5, p = j & 31; return axis * 32 + (p & 1) * 16 + (p >> 1); }
__device__ __forceinline__ int main_src_col(int c) {
    if (c < 1024) return COL_U + c;
    if (c < 2048) return COL_GA + (c - 1024);
    if (c < 3072) return COL_GB + (c - 2048);
    if (c < 3584) return COL_NQ + (c - 3072);
    if (c < 4096) return COL_NK + (c - 3584);
    const int j = c - 4096;
    if (j < 64) return COL_TQ + tq_src_col(j);
    if (j < 128) return COL_TK + tq_src_col(j - 64);
    if (j < 192) return COL_TV + (j - 128);
    return -1;
}
typedef const __attribute__((address_space(4))) Args* KArgs0;
__device__ __forceinline__ void p0_elementwise(Frame& F, KArgs0 ap) {
    unsigned char* ws = ap->ws;
    const size_t gt = (size_t)F.vcu * NTHREADS + F.tid, NT_ = (size_t)F.G * NTHREADS;
    const float* w_in = ap->in[8]; const float* b_in = ap->in[9];
    float* rope = (float*)(ws + WS_ROPE);
    for (size_t i = gt; i < 2 * 64 * 16; i += NT_) { const int f = (int)(i & 15), pos = (int)((i >> 4) & 63); const float inv = powf(10000.f, -(float)f / 16.f); const float ang = (float)pos * inv; rope[2 * i] = cosf(ang); rope[2 * i + 1] = sinf(ang); }
    float* bin = (float*)(ws + WS_BIN); float* bt = (float*)(ws + WS_BT);
    for (size_t i = gt; i < 4352; i += NT_) { const int sc = main_src_col((int)i); bin[i] = sc >= 0 ? b_in[sc] : 0.f; }
    for (size_t i = gt; i < 1536; i += NT_) bt[i] = i < 1024 ? b_in[COL_V + i] : b_in[COL_NV + (i - 1024)];
    bf16_t* win = (bf16_t*)(ws + WS_WIN);
    for (size_t i = gt; i < (size_t)128 * 1024; i += NT_) { const int j = (int)(i >> 10), k = (int)(i & 1023); const int sc = main_src_col(4096 + j); win[(size_t)(4096 + j) * 1024 + k] = (bf16_t)f2bf(w_in[(size_t)k * IN_W + sc]); }
    for (size_t i = gt; i < (size_t)64 * 1024; i += NT_) win[(size_t)(4096 + 192) * 1024 + i] = 0;
    bf16_t* wrh = (bf16_t*)(ws + WS_WRH); bf16_t* wrl = (bf16_t*)(ws + WS_WRL); const float* w_router = ap->in[19];
    for (size_t i = gt; i < (size_t)64 * 1024; i += NT_) { const int e = (int)(i >> 10), k = (int)(i & 1023); const float v = w_router[(size_t)k * 64 + e]; const unsigned h = f2bf(v); wrh[i] = (bf16_t)h; wrl[i] = (bf16_t)f2bf(v - bf2f((unsigned short)h)); }
    bf16_t* wsb = (bf16_t*)(ws + WS_WS); const float* w_s = ap->in[12];
    for (size_t i = gt; i < (size_t)8 * 128 * 128; i += NT_) wsb[i] = (bf16_t)f2bf(w_s[i]);
}

__device__ __forceinline__ void p0_weights(Frame& F, KArgs0 ap) {
    unsigned char* ws = ap->ws;
    LAS float* scr = (LAS float*)(F.lds + F.wave * 16384);
    const int gw = F.vcu * NWAVES + F.wave, NGW = F.G * NWAVES;
    const float* w_in = ap->in[8];
    bf16_t* win = (bf16_t*)(ws + WS_WIN); bf16_t* wt = (bf16_t*)(ws + WS_WT);
    const TrJob jobs[18] = {
        {w_in, win, IN_W, 1024, 1024, COL_U, 0, 1, 0, 0, 0},
        {w_in, win, IN_W, 1024, 1024, COL_GA, 1024, 1, 0, 0, 0},
        {w_in, win, IN_W, 1024, 1024, COL_GB, 2048, 1, 0, 0, 0},
        {w_in, win, IN_W, 1024, 512, COL_NQ, 3072, 1, 0, 0, 0},
        {w_in, win, IN_W, 1024, 512, COL_NK, 3584, 1, 0, 0, 0},
        {w_in, win, IN_W, 1024, 64, COL_TV, 4096 + 128, 1, 0, 0, 0},
        {w_in, wt, IN_W, 1024, 1024, COL_V, 0, 1, 0, 0, 0},
        {w_in, wt, IN_W, 1024, 512, COL_NV, 1024, 1, 0, 0, 0},
        {ap->in[16], (bf16_t*)(ws + WS_WUPA), 1024, 1024, 1024, 0, 0, 1, 0, 0, 0},
        {ap->in[17], (bf16_t*)(ws + WS_WUPB), 1024, 512, 1024, 0, 0, 1, 0, 0, 0},
        {ap->in[18], (bf16_t*)(ws + WS_WOUT), 1024, 1024, 1024, 0, 0, 1, 0, 0, 0},
        {ap->in[14], (bf16_t*)(ws + WS_WO), 1024, 64, 1024, 0, 0, 1, 0, 0, 0},
        {ap->in[21], (bf16_t*)(ws + WS_WGU), 256, 1024, 256, 0, 0, 64, 1, (size_t)1024 * 256, (size_t)512 * 1024},
        {ap->in[22], (bf16_t*)(ws + WS_WGU), 256, 1024, 256, 0, 0, 64, 2, (size_t)1024 * 256, (size_t)512 * 1024},
        {ap->in[23], (bf16_t*)(ws + WS_WD), 1024, 256, 1024, 0, 0, 64, 0, (size_t)256 * 1024, (size_t)1024 * 256},
        {ap->in[24], (bf16_t*)(ws + WS_WGU) + (size_t)64 * 512 * 1024, 256, 1024, 256, 0, 0, 1, 1, 0, 0},
        {ap->in[25], (bf16_t*)(ws + WS_WGU) + (size_t)64 * 512 * 1024, 256, 1024, 256, 0, 0, 1, 2, 0, 0},
        {ap->in[26], (bf16_t*)(ws + WS_WD) + (size_t)64 * 1024 * 256, 1024, 256, 1024, 0, 0, 1, 0, 0, 0},
    };
    int base = 0;
#pragma unroll
    for (int j = 0; j < 18; ++j) {
        const TrJob job = jobs[j]; const int n = trjob_items(job);
        int it = (gw - base % NGW + NGW) % NGW;
        for (; it < n; it += NGW) trjob_run(job, it, scr, F.lane);
        base += n;
    }
}

typedef const __attribute__((address_space(4))) Args* KArgs;
__device__ __forceinline__ KArgs get_args() { KArgs p = (KArgs)__builtin_amdgcn_kernarg_segment_ptr(); asm volatile("" : "+s"(p)); return p; }
#define WSP(T, off) ((T*)(ws + (off)))

__device__ __forceinline__ void moe_gu_phase(Frame& F, int g) {
    volatile LAS unsigned* blk = (volatile LAS unsigned*)(F.lds + MOE_BLK_LDS) + (g & 1) * (MOE_MAXBLK + 66);
    volatile LAS unsigned* pre = blk + MOE_MAXBLK;
    __syncthreads();
    { const unsigned* cnt = F.ctl + CW_GCOUNT + g * 64;
      if (F.tid == 0) { unsigned p = 0;
#pragma unroll 1
        for (int e = 0; e < 65; ++e) { pre[e] = p; const unsigned c = e < 64 ? __hip_atomic_load(cnt + e, RLX_AGENT) : (unsigned)GTOK; p += (c + 255u) >> 8; } pre[65] = p; }
      __syncthreads(); }
    const int nblk = (int)pre[65];
    for (int j = F.tid; j < nblk; j += NTHREADS) { int e = 0; while (pre[e + 1] <= (unsigned)j) ++e; blk[j] = ((unsigned)e << 16) | ((unsigned)j - pre[e]); }
    __syncthreads();
    unsigned char* ws = get_args()->ws;
    MoeLists L{WSP(int, WS_LCROW) + (size_t)g * 64 * GTOK, WSP(float, WS_LW) + (size_t)g * 64 * GTOK, F.ctl + CW_GCOUNT + g * 64};
    pg8::Gemm gm{WSP(bf16_t, WS_H), WSP(bf16_t, WS_WGU), 1024, (size_t)512 * 1024 * 2};
    MoeOrder S{blk, nblk, 2, F.G, F.vcu, L, 2048, g * GTOK};
    EpiMoeGU E{WSP(bf16_t, WS_ACT + (size_t)(g & 1) * ACT_BYTES)};
    pg8::gemm_phase<EpiMoeGU, MoeOrder, true, true>(F.lds, gm, S, E);
}
__device__ __forceinline__ void moe_down_phase(Frame& F, int g) {
    volatile LAS unsigned* blk = (volatile LAS unsigned*)(F.lds + MOE_BLK_LDS) + (g & 1) * (MOE_MAXBLK + 66);
    const int nblk = (int)blk[MOE_MAXBLK + 65];
    unsigned char* ws = get_args()->ws;
    MoeLists L{WSP(int, WS_LCROW) + (size_t)g * 64 * GTOK, WSP(float, WS_LW) + (size_t)g * 64 * GTOK, F.ctl + CW_GCOUNT + g * 64};
    pg8::Gemm gm{WSP(bf16_t, WS_ACT + (size_t)(g & 1) * ACT_BYTES), WSP(bf16_t, WS_WD), 256, (size_t)1024 * 256 * 2};
    MoeOrder S{blk, nblk, 4, F.G, F.vcu, L, 2048, g * GTOK};
    EpiMoeDown E{WSP(unsigned char, WS_C), L};
    pg8::gemm_phase<EpiMoeDown, MoeOrder, false, true>(F.lds, gm, S, E);
}

__global__ void __launch_bounds__(NTHREADS, 2) mega_fwd(Args args_unused) {
    extern __shared__ __attribute__((aligned(16))) unsigned char lds[];
    Frame F;
    F.lds = (LAS unsigned char*)lds;
    F.MISC = (volatile LAS unsigned*)(F.lds + MISC_OFF);
    F.tid = threadIdx.x; F.lane = F.tid & 63; F.wave = __builtin_amdgcn_readfirstlane(F.tid >> 6);
    F.G = gridDim.x; { const int bx = blockIdx.x; F.vcu = (F.G % 8 == 0) ? (bx % 8) * (F.G / 8) + bx / 8 : bx; }
    { KArgs A = get_args(); F.ctl = (unsigned*)(A->ws + WS_CTL); }
    for (int u = F.tid; u < (LDS_BYTES - LDSCTL_OFF) / 4; u += NTHREADS) ((LAS unsigned*)(F.lds + LDSCTL_OFF))[u] = 0u;
    __syncthreads();
    XcdBarrier bar = xcd_barrier_post(F.ctl + CW_BAR, F.MISC + 8);
#define GRID_BAR() xcd_barrier(bar)
    const int stage = get_args()->stage;
#define PHASE_BEGIN() do { F.tid = threadIdx.x; asm volatile("" : "+v"(F.tid)); F.lane = F.tid & 63; } while (0)
      { PHASE_BEGIN(); {
        for (int rep_ = 0; rep_ < (((PROBE_MASK >> 11) & 1) ? 2 : 1); ++rep_) {
        { KArgs A = get_args(); p0_adaln(F, A->in[1], A->in[3], A->in[4], A->in[5], (float*)(A->ws + WS_MOD)); }
        { KArgs A = get_args(); p0_elementwise(F, A); }
        { KArgs A = get_args(); p0_weights(F, A); } }
      } } GRID_BAR();
      { PHASE_BEGIN(); {
        KArgs A = get_args(); unsigned char* ws = A->ws; const float* x = A->in[0]; const float* mod = WSP(const float, WS_MOD); const float* gmix = A->in[6];
        bf16_t* H = WSP(bf16_t, WS_H); bf16_t* HC = WSP(bf16_t, WS_HC);
        const int gw = F.vcu * NWAVES + F.wave, NGW = F.G * NWAVES;
        for (int rep_ = 0; rep_ < (((PROBE_MASK >> 12) & 1) ? 2 : 1); ++rep_) {
        for (int m = gw; m < MTOK; m += NGW) { const float* mb = mod + (size_t)(m >> 11) * 6144; norm_mod_row(x + (size_t)m * DM, gmix, mb, mb + 1024, H + (size_t)m * DM, F.lane); }
        const float* mc = mod + (size_t)32 * 6144; const float* cx = A->in[2];
        for (int m = gw; m < MCTX; m += NGW) norm_mod_row(cx + (size_t)m * DM, gmix, mc, mc + 1024, HC + (size_t)m * DM, F.lane); }
      } } GRID_BAR();
      { PHASE_BEGIN(); {
        { unsigned char* ws = get_args()->ws;
          pg8::Gemm g{WSP(bf16_t, WS_H), WSP(bf16_t, WS_WIN), 1024, 0}; pg8::StaticOrder S; S.init(MTOK, 4096, F.G, (int)blockIdx.x);
          EpiMain E{0, WSP(const float, WS_BIN), ws};
          if constexpr ((PROBE_MASK >> 18) & 1) { pg8::DupOrder<pg8::StaticOrder> S2{S}; pg8::gemm_phase<EpiMain, pg8::DupOrder<pg8::StaticOrder>, false, true>(F.lds, g, S2, E); } else
          for (int rep_ = 0; rep_ < (((PROBE_MASK >> 2) & 1) ? 2 : 1); ++rep_) pg8::gemm_phase<EpiMain, pg8::StaticOrder, false, true>(F.lds, g, S, E); }
        { unsigned char* ws = get_args()->ws;
          pg8::Gemm g{WSP(bf16_t, WS_WT), WSP(bf16_t, WS_H), 1024, 0}; pg8::StaticOrder S; S.init(1536, MTOK, F.G, (int)blockIdx.x);
          EpiT E{ws, WSP(const float, WS_BT), MTOK, 0, 0};
          for (int rep_ = 0; rep_ < (((PROBE_MASK >> 3) & 1) ? 2 : 1); ++rep_) pg8::gemm_phase<EpiT, pg8::StaticOrder, false, true>(F.lds, g, S, E); }
        { unsigned char* ws = get_args()->ws;
          pg8::Gemm g{WSP(bf16_t, WS_H), WSP(bf16_t, WS_WIN) + (size_t)4096 * 1024, 1024, 0}; pg8::StaticOrder S; S.init(MTOK, 256, F.G, (int)blockIdx.x);
          EpiTT<0> E{WSP(const float, WS_BIN) + 4096, WSP(bf16_t, WS_TQ), WSP(bf16_t, WS_TKA), WSP(bf16_t, WS_TVA), WSP(const float, WS_ROPE)};
          for (int rep_ = 0; rep_ < (((PROBE_MASK >> 4) & 1) ? 2 : 1); ++rep_) pg8::gemm_phase<EpiTT<0>, pg8::StaticOrder, false, true>(F.lds, g, S, E); }
        { unsigned char* ws = get_args()->ws;
          pg8::Gemm g{WSP(bf16_t, WS_HC), WSP(bf16_t, WS_WIN) + (size_t)3584 * 1024, 1024, 0}; pg8::StaticOrder S; S.init(MCTX, 512, F.G, (int)blockIdx.x);
          EpiMain E{1, WSP(const float, WS_BIN) + 3584, ws};
          for (int rep_ = 0; rep_ < (((PROBE_MASK >> 5) & 1) ? 2 : 1); ++rep_) pg8::gemm_phase<EpiMain, pg8::StaticOrder, false, true>(F.lds, g, S, E); }
        { unsigned char* ws = get_args()->ws;
          pg8::Gemm g{WSP(bf16_t, WS_HC), WSP(bf16_t, WS_WIN) + (size_t)4096 * 1024, 1024, 0}; pg8::StaticOrder S; S.init(MCTX, 256, F.G, (int)((blockIdx.x + F.G - 64) % F.G));
          EpiTT<1> E{WSP(const float, WS_BIN) + 4096, WSP(bf16_t, WS_TQ), WSP(bf16_t, WS_TKA), WSP(bf16_t, WS_TVA), WSP(const float, WS_ROPE)};
          for (int rep_ = 0; rep_ < (((PROBE_MASK >> 6) & 1) ? 2 : 1); ++rep_) pg8::gemm_phase<EpiTT<1>, pg8::StaticOrder, false, true>(F.lds, g, S, E); }
        { unsigned char* ws = get_args()->ws;
          pg8::Gemm g{WSP(bf16_t, WS_WT) + (size_t)1024 * 1024, WSP(bf16_t, WS_HC), 1024, 0}; pg8::StaticOrder S; S.init(512, MCTX, F.G, (int)((blockIdx.x + F.G - 96) % F.G));
          EpiT E{ws, WSP(const float, WS_BT), MCTX, 4, 1};
          for (int rep_ = 0; rep_ < (((PROBE_MASK >> 7) & 1) ? 2 : 1); ++rep_) pg8::gemm_phase<EpiT, pg8::StaticOrder, false, true>(F.lds, g, S, E); }
      } } GRID_BAR();
      { PHASE_BEGIN(); if (stage >= 2) {
        { unsigned char* ws = get_args()->ws;
          for (int rep_ = (((PROBE_MASK >> 13) & 1) ? 0 : 1); rep_ < 2; ++rep_)
          for (int u = F.vcu; u < BATCH * 8; u += F.G) { const int b = u >> 3, qb = u & 7;
            bf16_t* qp = WSP(bf16_t, WS_TQ) + ((size_t)b * 2048 + qb * 256) * 64;
            bf16_t* op = rep_ == 1 ? qp : WSP(bf16_t, WS_H) + ((size_t)b * 2048 + qb * 256) * 64;
            tattn::attn_unit<8, 2304>(qp, WSP(bf16_t, WS_TKA) + (size_t)b * 2304 * 64, WSP(bf16_t, WS_TVA) + (size_t)b * 2304 * 64, op, (char*)lds); }
          __syncthreads(); }
        { KArgs A = get_args(); unsigned char* ws = A->ws;
          if ((PROBE_MASK >> 14) & 1) na_phase(F, A->in[15], WSP(bf16_t, WS_NQ), WSP(bf16_t, WS_H) + (size_t)8 * MiB, WSP(bf16_t, WS_NK), WSP(bf16_t, WS_NKC), WSP(bf16_t, WS_NVT), WSP(bf16_t, WS_NVCT));
          na_phase(F, A->in[15], WSP(bf16_t, WS_NQ), WSP(bf16_t, WS_NQ), WSP(bf16_t, WS_NK), WSP(bf16_t, WS_NKC), WSP(bf16_t, WS_NVT), WSP(bf16_t, WS_NVCT)); }
      } } GRID_BAR();
      { PHASE_BEGIN(); if (stage >= 2) {
        { KArgs A = get_args(); unsigned char* ws = A->ws;
          if ((PROBE_MASK >> 15) & 1) { sgu_phase(F, WSP(bf16_t, WS_VT), WSP(bf16_t, WS_U), WSP(bf16_t, WS_NK), WSP(bf16_t, WS_TQ), WSP(const bf16_t, WS_WS), WSP(const bf16_t, WS_WO), A->in[10], A->in[11], A->in[13]); __syncthreads(); }
          sgu_phase(F, WSP(bf16_t, WS_VT), WSP(bf16_t, WS_U), WSP(bf16_t, WS_U), WSP(bf16_t, WS_TQ), WSP(const bf16_t, WS_WS), WSP(const bf16_t, WS_WO), A->in[10], A->in[11], A->in[13]);
          __syncthreads(); }
        { unsigned char* ws = get_args()->ws;
          pg8::Gemm g{WSP(bf16_t, WS_NQ), WSP(bf16_t, WS_WUPB), 512, 0}; pg8::StaticOrder S; S.init(MTOK, 1024, F.G, (int)blockIdx.x);
          EpiGate E{WSP(bf16_t, WS_GB), nullptr, WSP(bf16_t, WS_H)};
          for (int rep_ = 0; rep_ < (((PROBE_MASK >> 8) & 1) ? 2 : 1); ++rep_) pg8::gemm_phase<EpiGate, pg8::StaticOrder, false, true>(F.lds, g, S, E); }
      } } GRID_BAR();
      { PHASE_BEGIN(); if (stage >= 2) {
        unsigned char* ws = get_args()->ws;
        pg8::Gemm g{WSP(bf16_t, WS_U), WSP(bf16_t, WS_WUPA), 1024, 0}; pg8::StaticOrder S; S.init(MTOK, 1024, F.G, (int)blockIdx.x);
        EpiGate E{WSP(bf16_t, WS_GA), WSP(bf16_t, WS_H), WSP(bf16_t, WS_MERGED)};
        for (int rep_ = 0; rep_ < (((PROBE_MASK >> 9) & 1) ? 2 : 1); ++rep_) pg8::gemm_phase<EpiGate, pg8::StaticOrder, false, true>(F.lds, g, S, E);
      } } GRID_BAR();
      { PHASE_BEGIN(); if (stage >= 2) {
        KArgs A = get_args(); unsigned char* ws = A->ws;
        pg8::Gemm g{WSP(bf16_t, WS_MERGED), WSP(bf16_t, WS_WOUT), 1024, 0}; pg8::StaticOrder S; S.init(MTOK, 1024, F.G, (int)blockIdx.x);
        EpiXmid E{A->in[0], WSP(const float, WS_MOD), WSP(bf16_t, WS_XMID)};
        for (int rep_ = 0; rep_ < (((PROBE_MASK >> 10) & 1) ? 2 : 1); ++rep_) pg8::gemm_phase<EpiXmid, pg8::StaticOrder, false, true>(F.lds, g, S, E);
      } else {
        KArgs A = get_args(); unsigned char* ws = A->ws; const float* x = A->in[0]; bf16_t* xmid = WSP(bf16_t, WS_XMID);
        const size_t gt = (size_t)F.vcu * NTHREADS + F.tid, NT_ = (size_t)F.G * NTHREADS;
        for (size_t i = gt; i < (size_t)MTOK * DM / 8; i += NT_) ((u32x4*)xmid)[i] = pack8(((const f32x4*)x)[2 * i], ((const f32x4*)x)[2 * i + 1]);
      } } GRID_BAR();
      { PHASE_BEGIN(); if (stage >= 3) {
        KArgs A = get_args(); unsigned char* ws = A->ws; bf16_t* H2 = WSP(bf16_t, WS_H);
        if (blockIdx.x == 0) for (int i = F.tid; i < DM / 2; i += NTHREADS) ((unsigned*)(H2 + (size_t)MTOK * DM))[i] = 0u;
        if ((PROBE_MASK >> 16) & 1) { router_phase(F, WSP(const bf16_t, WS_XMID), WSP(const float, WS_MOD), A->in[7], A->in[20], WSP(const bf16_t, WS_WRH), WSP(const bf16_t, WS_WRL), A->in[19], H2, WSP(int, WS_LCROW), WSP(float, WS_LW), F.ctl + CW_GCOUNT, true); __syncthreads(); }
        router_phase(F, WSP(const bf16_t, WS_XMID), WSP(const float, WS_MOD), A->in[7], A->in[20], WSP(const bf16_t, WS_WRH), WSP(const bf16_t, WS_WRL), A->in[19], H2, WSP(int, WS_LCROW), WSP(float, WS_LW), F.ctl + CW_GCOUNT, false);
      } } GRID_BAR();
      if (stage >= 3) {
        volatile LAS unsigned* lv = F.MISC + 16;
        if (threadIdx.x == 0) lv[0] = 0u;
        __syncthreads();
#pragma unroll 1
        for (;;) {
          PHASE_BEGIN();
          { const int s = __builtin_amdgcn_readfirstlane((int)lv[0]);
            if (s > 2 * NGRP) break;
            const int g = s >> 1;
            if ((s & 1) == 0) {
              if (g > 0) { KArgs A = get_args(); unsigned char* ws = A->ws; final_phase(F, g - 1, WSP(const unsigned char, WS_C), WSP(const bf16_t, WS_XMID), WSP(const float, WS_MOD), A->in[27], A->out); }
              if (g < NGRP) moe_gu_phase(F, g);
            } else moe_down_phase(F, g); }
          __syncthreads();
          const int s2 = __builtin_amdgcn_readfirstlane((int)lv[0]);
          __syncthreads();
          if (threadIdx.x == 0) lv[0] = (unsigned)(s2 + 1);
          if (s2 < 2 * NGRP) GRID_BAR(); else __syncthreads();
        }
      } else {
        PHASE_BEGIN();
        KArgs A = get_args(); unsigned char* ws = A->ws;
        float* out = A->out; const float* fg = A->in[27]; const bf16_t* xmid = WSP(const bf16_t, WS_XMID);
        const int gw = F.vcu * NWAVES + F.wave, NGW = F.G * NWAVES;
        for (int tl = gw; tl < MTOK; tl += NGW) {
            f32x4 v[4]; float s = 0.f;
            unpack8(*(const u32x4*)(xmid + (size_t)tl * DM + 16 * F.lane), v[0], v[1]); unpack8(*(const u32x4*)(xmid + (size_t)tl * DM + 16 * F.lane + 8), v[2], v[3]);
#pragma unroll
            for (int j = 0; j < 4; ++j) s += (v[j].x * v[j].x + v[j].y * v[j].y) + (v[j].z * v[j].z + v[j].w * v[j].w);
            const float r = 1.f / sqrtf(wave_sum(s) * (1.f / DM) + NORM_EPS);
#pragma unroll
            for (int j = 0; j < 4; ++j) ((f32x4*)(out + (size_t)tl * DM + 16 * F.lane))[j] = v[j] * r * ((const f32x4*)(fg + 16 * F.lane))[j];
        }
      }
}

extern "C" void kernel_launch(void* const* d_in, const int* in_sizes, int n_in, void* d_out, int out_size, void* d_ws, size_t ws_size, hipStream_t stream) {
    static int grid = 0;
    if (grid == 0) {
        int dev = 0, cus = 0, per_cu = 0;
        if (n_in != 28 || ws_size < WS_END) { fprintf(stderr, "kernel_launch: n_in %d ws %zu (need %zu)\n", n_in, ws_size, (size_t)WS_END); grid = -1; return; }
        if (hipGetDevice(&dev) != hipSuccess || hipDeviceGetAttribute(&cus, hipDeviceAttributeMultiprocessorCount, dev) != hipSuccess) { fprintf(stderr, "kernel_launch: device query failed\n"); grid = -1; return; }
        if (hipFuncSetAttribute((const void*)mega_fwd, hipFuncAttributeMaxDynamicSharedMemorySize, LDS_BYTES) != hipSuccess) { fprintf(stderr, "kernel_launch: hipFuncSetAttribute failed\n"); grid = -1; return; }
        if (hipOccupancyMaxActiveBlocksPerMultiprocessor(&per_cu, (const void*)mega_fwd, NTHREADS, LDS_BYTES) != hipSuccess || per_cu < 1) { fprintf(stderr, "kernel_launch: occupancy query says %d\n", per_cu); }
        (void)hipGetLastError();
        grid = cus;
    }
    if (grid < 0) return;
    (void)hipMemsetAsync((char*)d_ws + WS_CTL, 0, CTL_ZERO_BYTES, stream);
    Args a{};
    for (int i = 0; i < 28; ++i) a.in[i] = (const float*)d_in[i];
    a.out = (float*)d_out; a.ws = (unsigned char*)d_ws; a.stage = KSTAGE;
    void* kargs[] = {&a};
    hipError_t e = hipLaunchCooperativeKernel((const void*)mega_fwd, dim3(grid), dim3(NTHREADS), kargs, LDS_BYTES, stream);
    if (e != hipSuccess) fprintf(stderr, "kernel_launch: cooperative launch failed: %s\n", hipGetErrorString(e));
}
```

```cpp
#define KSTAGE 3
#define PROBE_MASK 0
#define ALIGN_EPI_ true
#include <hip/hip_runtime.h>
#include <hip/hip_bf16.h>
#include <cstdio>
#include <cstdint>
#include <cmath>

#define GAS __attribute__((address_space(1)))
#define LAS __attribute__((address_space(3)))
typedef unsigned short bf16_t;
typedef float f32x4 __attribute__((ext_vector_type(4)));
typedef float f32x2 __attribute__((ext_vector_type(2)));
typedef unsigned u32x4 __attribute__((ext_vector_type(4)));
typedef unsigned u32x2 __attribute__((ext_vector_type(2)));
typedef short bf16x8 __attribute__((ext_vector_type(8)));

constexpr int DM = 1024, BATCH = 32, SEQ = 2048, MTOK = BATCH * SEQ, CTXL = 256, MCTX = BATCH * CTXL;
constexpr int IN_W = 5824;
constexpr int COL_U = 0, COL_V = 1024, COL_TQ = 2048, COL_TK = 2112, COL_TV = 2176, COL_NQ = 2240, COL_NK = 2752, COL_NV = 3264, COL_GA = 3776, COL_GB = 4800;
constexpr float NORM_EPS = 1e-6f;
constexpr int NWAVES = 8, NTHREADS = 512;

constexpr int SCR_BYTES = 147456;
constexpr int LDSCTL_OFF = SCR_BYTES, MISC_OFF = LDSCTL_OFF + 320;
constexpr int WTAB_OFF = MISC_OFF + 128;
__device__ __forceinline__ int lane_id_() { int l; asm volatile("v_mbcnt_lo_u32_b32 %0, -1, 0\n\tv_mbcnt_hi_u32_b32 %0, -1, %0" : "=v"(l)); return l; }
__device__ __forceinline__ int wave_idx_() { const unsigned slot = __builtin_amdgcn_s_getreg((5 << 11) | 4) & 63u;
    return __builtin_amdgcn_readfirstlane((int)*(volatile LAS unsigned*)(size_t)(WTAB_OFF + 4 * slot)); }
#define TIDX() ((int)threadIdx.x)
constexpr int EPL_LDS = SCR_BYTES + 2048;
constexpr int LDS_BYTES = EPL_LDS + 8192;

constexpr size_t MiB = 1u << 20;
constexpr size_t WS_CTL = 0, CTL_ZERO_BYTES = 1 * MiB;
constexpr int CW_BAR = 4096, CW_GCOUNT = 8192;
constexpr size_t WS_MOD = 1 * MiB;
constexpr size_t WS_ROPE = 2 * MiB;
constexpr size_t WS_BIN = 2 * MiB + 64 * 1024;
constexpr size_t WS_BT = 2 * MiB + 128 * 1024;
constexpr size_t WS_WIN = 3 * MiB;
constexpr size_t WS_WT = 12 * MiB;
constexpr size_t WS_WUPA = 15 * MiB, WS_WUPB = 17 * MiB, WS_WOUT = 18 * MiB;
constexpr size_t WS_WO = 20 * MiB, WS_WS = 20 * MiB + 256 * 1024, WS_WRH = 20 * MiB + 512 * 1024, WS_WRL = 20 * MiB + 768 * 1024;
constexpr size_t WS_WGU = 24 * MiB;
constexpr size_t WS_WD = 89 * MiB;
constexpr size_t WS_U = 122 * MiB, WS_VT = 250 * MiB, WS_GA = 378 * MiB, WS_GB = 506 * MiB, WS_NQ = 634 * MiB;
constexpr size_t WS_C = 122 * MiB;
constexpr int CROW_BYTES = 9 * 1024;
constexpr size_t WS_H8 = 442 * MiB;
constexpr size_t WS_WIN8 = 60 * MiB;
constexpr size_t WS_WT8 = 64 * MiB;
constexpr size_t WS_XMID = 506 * MiB;
constexpr size_t C_BYTES = 0;
constexpr size_t WS_MERGED = WS_VT;
constexpr size_t WS_H = 698 * MiB;
constexpr size_t WS_NK = 827 * MiB, WS_NKC = 891 * MiB, WS_NVT = 899 * MiB, WS_NVCT = 963 * MiB, WS_TQ = 971 * MiB, WS_TKA = 979 * MiB, WS_TVA = 988 * MiB, WS_HC = 997 * MiB;
constexpr size_t WS_ACT = 827 * MiB;
constexpr size_t ACT_BYTES = 0;
constexpr size_t WS_LCROW = 984 * MiB, WS_LW = 1001 * MiB;
constexpr int NGRP = 2;
constexpr int GSPLIT = 124 * 256, GCAP = MTOK - GSPLIT;
__host__ __device__ constexpr int gbase(int g) { return g == 0 ? 0 : GSPLIT; }
__host__ __device__ constexpr int gsize(int g) { return g == 0 ? GSPLIT : MTOK - GSPLIT; }
constexpr size_t WS_DUMMY = 1018 * MiB;
constexpr size_t WS_END = 1020 * MiB;
constexpr int MOE_BLK_LDS = 131072;
constexpr int MOE_MAXBLK = GCAP * 9 / 256 + 64;

#ifndef ALIGN_EPI_
#define ALIGN_EPI_ true
#endif
#ifndef PROBE_MASK
#define PROBE_MASK 0
#endif
#ifndef KSTAGE
#define KSTAGE 3
#endif

#define RLX_AGENT __ATOMIC_RELAXED, __HIP_MEMORY_SCOPE_AGENT

#define XB_TMO      128
#define XB_XCNT(j)  (256  + 64 * (j))
#define XB_XSUB(j)  (1280 + 64 * (j))
#define XB_XGEN(j)  (2304 + 64 * (j))
#define XB_TOP      3328
#define XB_TOPGEN   3392
#define XCD_BAR_WORDS 3456
#define XB_SPIN_CAP (1u << 18)
__device__ __forceinline__ unsigned xb_ld(unsigned* p)              { return __hip_atomic_load(p, __ATOMIC_RELAXED, __HIP_MEMORY_SCOPE_AGENT); }
__device__ __forceinline__ unsigned xb_add(unsigned* p, unsigned v) { return __hip_atomic_fetch_add(p, v, __ATOMIC_RELAXED, __HIP_MEMORY_SCOPE_AGENT); }
__device__ __forceinline__ unsigned xb_xcc_id() { return (unsigned)__builtin_amdgcn_s_getreg((3 << 11) | 20) & 0xFu; }
#define XB_SPIN(cond, bar) do { unsigned _sp = 0; while (cond) { __builtin_amdgcn_s_sleep(1); \
    if ((++_sp & 255u) == 0u) { if (xb_ld(&(bar)[XB_TMO])) break; if (_sp > XB_SPIN_CAP) { atomicAdd(&(bar)[XB_TMO], 1u); break; } } } } while (0)
struct XcdBarrier { unsigned* bar; unsigned x; volatile LAS unsigned* st; };
__device__ __forceinline__ XcdBarrier xcd_barrier_post(unsigned* bar, volatile LAS unsigned* st) {
    XcdBarrier b; b.bar = bar; b.x = xb_xcc_id(); b.st = st;
    if (TIDX() == 0) { const unsigned rank = xb_add(&bar[XB_XCNT(b.x)], 1u); st[4] = b.x; st[5] = rank; }
    return b;
}
__device__ __forceinline__ void xcd_barrier_complete(unsigned* bar, unsigned x, unsigned& nloc, unsigned& nx) {
    const unsigned G = gridDim.x * gridDim.y * gridDim.z;
    unsigned sum, cnt, mine, sp = 0u;
    for (;;) {
        sum = 0u; cnt = 0u; mine = 0u;
#pragma unroll 1
        for (unsigned j = 0; j < 16; ++j) { const unsigned c = xb_ld(&bar[XB_XCNT(j)]); sum += c; cnt += (c > 0u) ? 1u : 0u; mine = (j == x) ? c : mine; }
        if (sum == G) break;
        __builtin_amdgcn_s_sleep(1);
        if ((++sp & 255u) == 0u) { if (xb_ld(&bar[XB_TMO])) break; if (sp > XB_SPIN_CAP) { atomicAdd(&bar[XB_TMO], 1u); break; } }
    }
    nloc = mine > 0u ? mine : 1u; nx = cnt > 0u ? cnt : 1u;
}
__device__ __forceinline__ void xcd_barrier(const XcdBarrier& b) {
    asm volatile("s_waitcnt vmcnt(0)" ::: "memory");
    __syncthreads();
    if (TIDX() == 0) {
        unsigned* bar = b.bar;
        __builtin_amdgcn_s_waitcnt(0);
        unsigned nloc = b.st[0], nx = b.st[1];
        if (nloc == 0u) { xcd_barrier_complete(bar, b.x, nloc, nx); b.st[0] = nloc; b.st[1] = nx; }
        const unsigned old = xb_add(&bar[XB_XSUB(b.x)], 1u);
        const unsigned gen = old / nloc;
        if (old + 1u == (gen + 1u) * nloc) {
            __builtin_amdgcn_fence(__ATOMIC_RELEASE, "agent");
            asm volatile("s_waitcnt vmcnt(0)" ::: "memory");
            const unsigned og = xb_add(&bar[XB_TOP], 1u);
            const unsigned tg = og / nx;
            if (og + 1u == (tg + 1u) * nx) xb_add(&bar[XB_TOPGEN], 1u);
            else XB_SPIN(xb_ld(&bar[XB_TOPGEN]) == tg, bar);
            __builtin_amdgcn_fence(__ATOMIC_ACQUIRE, "agent");
            xb_add(&bar[XB_XGEN(b.x)], 1u);
            asm volatile("s_waitcnt vmcnt(0)" ::: "memory");
        } else {
            XB_SPIN(xb_ld(&bar[XB_XGEN(b.x)]) == gen, bar);
            __builtin_amdgcn_fence(__ATOMIC_ACQUIRE, "agent");
            asm volatile("s_waitcnt vmcnt(0)" ::: "memory");
        }
    }
    __syncthreads();
}

__device__ __forceinline__ float wave_sum(float v) {
#pragma unroll
    for (int o = 1; o < 64; o <<= 1) v += __shfl_xor(v, o);
    return v;
}
__device__ __forceinline__ float wave_sum_l(float v, int lane) {
#pragma unroll
    for (int o = 1; o < 64; o <<= 1) v += __builtin_bit_cast(float, __builtin_amdgcn_ds_bpermute((lane ^ o) << 2, __builtin_bit_cast(int, v)));
    return v;
}
__device__ __forceinline__ unsigned f2bf(float f) { unsigned u = __builtin_bit_cast(unsigned, f); return (u + 0x7fffu + ((u >> 16) & 1u)) >> 16; }
__device__ __forceinline__ unsigned pk2(float lo, float hi) { return f2bf(lo) | (f2bf(hi) << 16); }
__device__ __forceinline__ float bf2f(unsigned short b) { return __builtin_bit_cast(float, (unsigned)b << 16); }

#include <type_traits>
namespace pg8 {
#define PG8_LAS __attribute__((address_space(3)))
constexpr int BM = 256, BK = 64, HALF = 128, HTB = HALF * BK * 2, STAGE_BYTES = 8 * HTB, NXCD = 8, WGM = 8;
__host__ __device__ __forceinline__ int lds_byte(int r, int c) { const int st = (r >> 4) * 2 + (c >> 5), rr = r & 15, cc = c & 31, ob = rr * 64 + cc * 2; return st * 1024 + (ob ^ (((ob >> 9) & 1) << 5)); }
__host__ __device__ __forceinline__ void stage_rc(int b, int& R, int& C) { const int st = b / 1024, sb = b % 1024, swz = sb ^ (((sb >> 9) & 1) << 5); R = (st >> 1) * 16 + swz / 64; C = (st & 1) * 32 + (swz % 64) / 2; }
__host__ __device__ __forceinline__ int perm32(int rho) { const int n = rho >> 4, i = rho & 15; return 8 * (i >> 2) + 4 * n + (i & 3); }

typedef int i32x4_ __attribute__((ext_vector_type(4)));
struct Unit { int pm, pn, e, r0, skip, cnt; };
struct Gemm { const bf16_t* A; const bf16_t* Bt; int K; size_t b_estride; };

struct StaticOrder {
    int nM, nN, nwg, G, c;
    __host__ __device__ void init(int M, int N, int G_, int c_) { nM = M / BM; nN = N / BM; nwg = nM * nN; G = G_; c = c_; }
    __host__ __device__ bool next(int i, Unit& u) const {
        const long L = (long)i * G + c; if (L >= nwg) return false;
        int wgid = (int)L; { const int q = nwg / NXCD, r = nwg % NXCD, xcd = wgid % NXCD, off = wgid / NXCD; wgid = (xcd < r ? xcd * (q + 1) : r * (q + 1) + (xcd - r) * q) + off; }
        const int nig = WGM * nN, gid = wgid / nig, fm = gid * WGM, gsz = (nM - fm) < WGM ? (nM - fm) : WGM;
        u.pm = fm + ((wgid % nig) % gsz); u.pn = (wgid % nig) / gsz; u.e = 0; u.r0 = 0; u.skip = 0; u.cnt = 0; return true;
    }
    __device__ __forceinline__ unsigned rowoff(const Unit&, int) const { return 0u; }
    __device__ __forceinline__ int rowraw(const Unit&, int) const { return 0; }
    __device__ __forceinline__ unsigned rowfin(const Unit&, int, int) const { return 0u; }
    static constexpr int NRAW = 0;
    __device__ __forceinline__ int nt(const Unit&, int ntdef) const { return ntdef; }
    __device__ __forceinline__ bool keep_acc(const Unit&) const { return false; }
};

struct FusedOrder { StaticOrder b; unsigned aoff0, apitch0, aoff1, apitch1; int nt0, nt1;
    __device__ __forceinline__ bool next(int i, Unit& u) const { const bool ok = b.next(i >> 1, u); u.e = i & 1; return ok; }
    __device__ __forceinline__ unsigned rowoff(const Unit& u, int r) const { const unsigned row = (unsigned)(u.pm * BM + r); return u.e ? aoff1 + row * apitch1 : aoff0 + row * apitch0; }
    __device__ __forceinline__ int rowraw(const Unit&, int) const { return 0; }
    __device__ __forceinline__ unsigned rowfin(const Unit& u, int r, int) const { return rowoff(u, r); }
    static constexpr int NRAW = 0;
    __device__ __forceinline__ int nt(const Unit& u, int) const { return u.e ? nt1 : nt0; }
    __device__ __forceinline__ bool keep_acc(const Unit& u) const { return u.e == 0; }
};

template <class Base> struct SkipOrder { Base b;
    __device__ __forceinline__ bool next(int i, Unit& u) const { const bool ok = b.next(i, u); u.skip = 1; return ok; }
    __device__ __forceinline__ unsigned rowoff(const Unit& u, int r) const { return b.rowoff(u, r); }
    __device__ __forceinline__ int rowraw(const Unit& u, int r) const { return b.rowraw(u, r); }
    __device__ __forceinline__ unsigned rowfin(const Unit& u, int r, int raw) const { return b.rowfin(u, r, raw); }
    static constexpr int NRAW = Base::NRAW;
    __device__ __forceinline__ int nt(const Unit& u, int d) const { return b.nt(u, d); }
    __device__ __forceinline__ bool keep_acc(const Unit& u) const { return b.keep_acc(u); } };
template <class Base> struct DupOrder { Base b;
    __device__ __forceinline__ bool next(int i, Unit& u) const { const bool ok = b.next(i >> 1, u); u.skip = (i & 1) == 0; return ok; }
    __device__ __forceinline__ unsigned rowoff(const Unit& u, int r) const { return b.rowoff(u, r); }
    __device__ __forceinline__ int rowraw(const Unit& u, int r) const { return b.rowraw(u, r); }
    __device__ __forceinline__ unsigned rowfin(const Unit& u, int r, int raw) const { return b.rowfin(u, r, raw); }
    static constexpr int NRAW = Base::NRAW;
    __device__ __forceinline__ int nt(const Unit& u, int d) const { return b.nt(u, d); }
    __device__ __forceinline__ bool keep_acc(const Unit& u) const { return b.keep_acc(u); } };

__device__ __forceinline__ unsigned cvt_pk_bf16(float lo, float hi) { unsigned r; asm volatile("v_cvt_pk_bf16_f32 %0, %1, %2" : "=v"(r) : "v"(lo), "v"(hi)); return r; }
__device__ __forceinline__ f32x2 gelu_pk(f32x2 v) {
    const f32x2 av = __builtin_elementwise_abs(v), d = av * 0.2316418882f + 1.0f;
    f32x2 t; t.x = __builtin_amdgcn_rcpf(d.x); t.y = __builtin_amdgcn_rcpf(d.y);
    f32x2 q = t * 0.5307027145f + (-0.7265760135f); q = q * t + 0.7107068705f; q = q * t + (-0.142248368f); q = q * t + 0.127414796f; q = q * t;
    const f32x2 s = (v * v) * (-0.72134752044f);
    f32x2 e; e.x = __builtin_amdgcn_exp2f(s.x); e.y = __builtin_amdgcn_exp2f(s.y);
    const f32x2 m = v * (q * e), r = v - m;
    f32x2 o; o.x = v.x < 0.f ? m.x : r.x; o.y = v.y < 0.f ? m.y : r.y; return o;
}

template <class Epi, class Sched, bool GATHER, bool ALIGN_EPI, bool FP8 = false>
__device__ __forceinline__ void gemm_phase(PG8_LAS unsigned char* lds, const Gemm g, const Sched& S, const Epi& E) {
    int tid = TIDX(); asm volatile("" : "+v"(tid));
    const int wid = __builtin_amdgcn_readfirstlane(tid >> 6), lane = tid & 63, wr = wid >> 2, wc = wid & 3, fr = lane & 15, fq = lane >> 4;
    const int K = g.K, nt = K / BK;
    unsigned voffA[2], voffB[2];
#pragma unroll
    for (int i = 0; i < 2; ++i) { int R, C; stage_rc(tid * 16 + i * 8192, R, C); const int Rb = Epi::PERM ? (64 * (R >> 5) + 16 * ((R & 15) >> 2) + 4 * ((R >> 4) & 1) + (R & 3)) : R;
        voffA[i] = (unsigned)(R * K + C) * 2u; voffB[i] = (unsigned)(Rb * K + C) * 2u; }
#define PG8_ROWOFFS(U, d0, d1) do { _Pragma("unroll") for (int i_ = 0; i_ < 2; ++i_) { int R_, C_; stage_rc(tid * 16 + i_ * 8192, R_, C_); d0[i_] = S.rowoff(U, R_) + (unsigned)C_ * 2u; d1[i_] = S.rowoff(U, HALF + R_) + (unsigned)C_ * 2u; } } while (0)
#define PG8_ROWRAW(U, w) do { int tid_ = tid; asm volatile("" : "+v"(tid_));        \
        _Pragma("unroll") for (int i_ = 0; i_ < 2; ++i_) { int R_, C_; stage_rc(tid_ * 16 + i_ * 8192, R_, C_); w[i_][0] = S.rowraw(U, R_); w[i_][1] = S.rowraw(U, HALF + R_); } } while (0)
#define PG8_ROWFIN(U, w, d0, d1) do { int tid_ = tid; asm volatile("" : "+v"(tid_)); _Pragma("unroll") for (int i_ = 0; i_ < 2; ++i_) { int R_, C_; stage_rc(tid_ * 16 + i_ * 8192, R_, C_); d0[i_] = S.rowfin(U, R_, w[i_][0]) + (unsigned)C_ * 2u; d1[i_] = S.rowfin(U, HALF + R_, w[i_][1]) + (unsigned)C_ * 2u; } } while (0)
    const size_t kstep = (size_t)(BK * 2);
    const size_t hstep = (size_t)HALF * K * 2;
    const size_t tstep = 2 * hstep;
    const size_t ahstep = GATHER ? 0 : hstep;
    const size_t bhstep = Epi::PERM ? (size_t)8 * K * 2 : hstep;
    const unsigned ldsw = (unsigned)wid * 1024u;
    const int aoff = lds_byte(wr * 64 + fr, fq * 8), boff = lds_byte(wc * 32 + fr, fq * 8);
#define PG8_SA(b, h) (((b) * 2 + (h)) * HTB)
#define PG8_SB(b, h) ((4 + (b) * 2 + (h)) * HTB)
#define PG8_STAGE(bufoff, gbase, voff) do { const char* gb_ = (const char*)(gbase); if constexpr (FP8) { asm volatile("" : "+s"(gb_)); }        \
        _Pragma("unroll") for (int _i = 0; _i < 2; ++_i) \
        __builtin_amdgcn_global_load_lds((const unsigned*)(gb_ + (voff)[_i]), (PG8_LAS unsigned*)(lds + (bufoff) + ldsw + _i * 8192), 16, 0, 0); } while (0)
#define PG8_LDA(dst, b, h) do { _Pragma("unroll") for (int m = 0; m < 4; ++m) { \
        if constexpr (FP8) dst[m][0] = PG8_CAT8(*(const PG8_LAS bf16x8*)(lds + PG8_SA(b, h) + aoff + m * 2048), *(const PG8_LAS bf16x8*)(lds + PG8_SA(b, h) + aoff + m * 2048 + 1024)); \
        else { _Pragma("unroll") for (int k = 0; k < 2; ++k) dst[m][k] = __builtin_bit_cast(typename std::remove_reference<decltype(dst[m][k])>::type, *(const PG8_LAS bf16x8*)(lds + PG8_SA(b, h) + aoff + m * 2048 + k * 1024)); } } } while (0)
#define PG8_LDB(dst, b, h) do { _Pragma("unroll") for (int n = 0; n < 2; ++n) { \
        if constexpr (FP8) dst[n][0] = PG8_CAT8(*(const PG8_LAS bf16x8*)(lds + PG8_SB(b, h) + boff + n * 2048), *(const PG8_LAS bf16x8*)(lds + PG8_SB(b, h) + boff + n * 2048 + 1024)); \
        else { _Pragma("unroll") for (int k = 0; k < 2; ++k) dst[n][k] = __builtin_bit_cast(typename std::remove_reference<decltype(dst[n][k])>::type, *(const PG8_LAS bf16x8*)(lds + PG8_SB(b, h) + boff + n * 2048 + k * 1024)); } } } while (0)
#define PG8_CAT8(lo, hi) __builtin_shufflevector(__builtin_bit_cast(i32x4_, lo), __builtin_bit_cast(i32x4_, hi), 0, 1, 2, 3, 4, 5, 6, 7)
#define PG8_MMA(ai, bj, At, Bt) do { __builtin_amdgcn_s_setprio(1); \
        if constexpr (FP8) { _Pragma("unroll") for (int m = 0; m < 4; ++m) _Pragma("unroll") for (int n = 0; n < 2; ++n) \
            acc[ai][bj][m][n] = __builtin_amdgcn_mfma_scale_f32_16x16x128_f8f6f4(__builtin_bit_cast(i32x8_, Bt[n][0]), __builtin_bit_cast(i32x8_, At[m][0]), acc[ai][bj][m][n], 0, 0, 0, 0x7f7f7f7f, 0, 0x7f7f7f7f); } \
        else { _Pragma("unroll") for (int m = 0; m < 4; ++m) _Pragma("unroll") for (int n = 0; n < 2; ++n) _Pragma("unroll") for (int k = 0; k < 2; ++k) \
            acc[ai][bj][m][n] = __builtin_amdgcn_mfma_f32_16x16x32_bf16(__builtin_bit_cast(bf16x8, Bt[n][k & (FP8 ? 0 : 1)]), __builtin_bit_cast(bf16x8, At[m][k & (FP8 ? 0 : 1)]), acc[ai][bj][m][n], 0, 0, 0); } \
        __builtin_amdgcn_s_setprio(0); } while (0)
#define PG8_WAIT_V(n) asm volatile("s_waitcnt vmcnt(" #n ")" ::: "memory")
#define PG8_WAIT_VC(N) do { constexpr int n_ = (N); static_assert(n_ <= 63, "vmcnt"); asm volatile("s_waitcnt vmcnt(%0)" :: "n"(n_) : "memory"); } while (0)
#define PG8_WAIT_L(n) asm volatile("s_waitcnt lgkmcnt(" #n ")" ::: "memory")
#define PG8_BAR __builtin_amdgcn_s_barrier()
#define PG8_SCHED __builtin_amdgcn_sched_barrier(0)
#define PG8_AV0 (GATHER ? vA0 : voffA)
#define PG8_AV1 (GATHER ? vA1 : voffA)
    Unit cur, nxt; int ui = 0;
    if (!S.next(0, cur)) return;
    float zero_ = 0.f; if constexpr (FP8) { if (nt <= 2 || GATHER) { asm volatile("" : "+v"(zero_)); } }
    f32x4 acc[2][2][4][2];
#pragma unroll
    for (int a = 0; a < 2; ++a)
#pragma unroll
        for (int b = 0; b < 2; ++b)
#pragma unroll
            for (int m = 0; m < 4; ++m)
#pragma unroll
                for (int n = 0; n < 2; ++n) acc[a][b][m][n] = (f32x4){zero_, zero_, zero_, zero_};
    typedef int i32x8_ __attribute__((ext_vector_type(8)));
    typename std::conditional<FP8, i32x8_, bf16x8>::type At[4][FP8 ? 1 : 2], B0[2][FP8 ? 1 : 2], B1[2][FP8 ? 1 : 2];
    unsigned vA0[2] = {0u, 0u}, vA1[2] = {0u, 0u};
    if constexpr (GATHER) { PG8_ROWOFFS(cur, vA0, vA1); }
    int graw[2][2] = {{0, 0}, {0, 0}};
    typename Epi::Pre pre{};
    constexpr bool EARLY_RAW = true;
    constexpr int NX = Epi::NPRE + ((GATHER && EARLY_RAW) ? Sched::NRAW : 0);
    const char* cA = GATHER ? (const char*)g.A : (const char*)g.A + (size_t)cur.pm * tstep;
    const char* cB = (const char*)g.Bt + (size_t)cur.e * g.b_estride + (size_t)cur.pn * tstep;
    PG8_STAGE(PG8_SB(0, 0), cB, voffB); PG8_STAGE(PG8_SB(0, 1), cB + bhstep, voffB); PG8_STAGE(PG8_SA(0, 0), cA, PG8_AV0); PG8_STAGE(PG8_SA(0, 1), cA + ahstep, PG8_AV1);
    if (wr == 1) PG8_BAR;
    PG8_WAIT_V(2); PG8_BAR;
    PG8_STAGE(PG8_SB(1, 0), cB + kstep, voffB); PG8_STAGE(PG8_SA(1, 0), cA + kstep, PG8_AV0); PG8_STAGE(PG8_SB(1, 1), cB + bhstep + kstep, voffB);
    PG8_WAIT_V(6); PG8_BAR;
    int epi_st = -1;
    for (;;) {
        const bool has_next = S.next(ui + 1, nxt);
        const char* nA = GATHER ? (const char*)g.A : (has_next ? (const char*)g.A + (size_t)nxt.pm * tstep : cA);
        const char* nB = has_next ? (const char*)g.Bt + (size_t)nxt.e * g.b_estride + (size_t)nxt.pn * tstep : cB;
        int unt = S.nt(cur, nt);
        if constexpr (FP8 && !GATHER) { if (nt <= 2) { asm volatile("" : "+s"(unt)); } }
        int t0_ = 0; if constexpr (FP8 && !GATHER) { if (nt <= 2) { asm volatile("" : "+s"(t0_)); } }
#pragma unroll 1
        for (int t = 0; t < unt; t += 2) {
            const bool last = (t == unt - 2);
            const char* a1 = cA + (size_t)(t + 1) * kstep;
            const char* a2 = last ? nA : cA + (size_t)(t + 2) * kstep; const char* b2 = last ? nB : cB + (size_t)(t + 2) * kstep;
            const char* a3 = a2 + kstep; const char* b3 = b2 + kstep;
            unsigned nA0[2] = {0u, 0u}, nA1[2] = {0u, 0u};
            if (t == t0_) { E.preload(pre, cur, wr, wc, fr, fq); if constexpr (GATHER && EARLY_RAW) { if (has_next) { PG8_ROWRAW(nxt, graw); } } }
            if constexpr (GATHER) { if (last && has_next) { if constexpr (EARLY_RAW) { PG8_ROWFIN(nxt, graw, nA0, nA1); } else { PG8_ROWOFFS(nxt, nA0, nA1); } } }
            const bool relax = (t == t0_) && epi_st >= 0;
            PG8_LDB(B0, 0, 0); PG8_LDB(B1, 0, 1); PG8_SCHED; PG8_LDA(At, 0, 0); PG8_STAGE(PG8_SA(1, 1), a1 + ahstep, PG8_AV1);
            if (relax) { if (epi_st >= 16) { PG8_WAIT_VC(8 + NX + 16); } else if (epi_st >= 8) { PG8_WAIT_VC(8 + NX + 8); } else { PG8_WAIT_VC(8 + NX); } } else if (t == t0_) { PG8_WAIT_VC(8 + NX); } else PG8_WAIT_V(8);
            PG8_WAIT_L(0); PG8_BAR; PG8_MMA(0, 0, At, B0); PG8_MMA(0, 1, At, B1); PG8_BAR; PG8_SCHED;
            if constexpr (GATHER) { if (last && has_next) { vA0[0] = nA0[0]; vA0[1] = nA0[1]; vA1[0] = nA1[0]; vA1[1] = nA1[1]; } }
            PG8_LDA(At, 0, 1); PG8_STAGE(PG8_SB(0, 0), b2, voffB); PG8_STAGE(PG8_SB(0, 1), b2 + bhstep, voffB); PG8_STAGE(PG8_SA(0, 0), a2, PG8_AV0);
            if (relax) { if (epi_st >= 16) { PG8_WAIT_VC(8 + NX + 16); } else if (epi_st >= 8) { PG8_WAIT_VC(8 + NX + 8); } else { PG8_WAIT_VC(8 + NX); } } else if (t == t0_) { PG8_WAIT_VC(8 + NX); } else PG8_WAIT_V(8);
            PG8_WAIT_L(0); PG8_BAR; PG8_MMA(1, 0, At, B0); PG8_MMA(1, 1, At, B1); PG8_BAR; PG8_SCHED;
            PG8_LDB(B0, 1, 0); PG8_LDB(B1, 1, 1); PG8_SCHED; PG8_LDA(At, 1, 0); PG8_STAGE(PG8_SA(0, 1), a2 + ahstep, PG8_AV1);
            PG8_WAIT_V(8); PG8_WAIT_L(0); PG8_BAR; PG8_MMA(0, 0, At, B0); PG8_MMA(0, 1, At, B1); PG8_BAR; PG8_SCHED;
            PG8_LDA(At, 1, 1); PG8_STAGE(PG8_SB(1, 0), b3, voffB); PG8_STAGE(PG8_SB(1, 1), b3 + bhstep, voffB); PG8_STAGE(PG8_SA(1, 0), a3, PG8_AV0);
            PG8_WAIT_V(8); PG8_WAIT_L(0); PG8_BAR; PG8_MMA(1, 0, At, B0); PG8_MMA(1, 1, At, B1); PG8_BAR; PG8_SCHED;
        }
        if constexpr (ALIGN_EPI) { if (wr == 0) PG8_BAR; }
        if (!cur.skip) { int t_ = tid; asm volatile("" : "+v"(t_)); const int fr_ = t_ & 15, fq_ = (t_ >> 4) & 3;
                         E(acc, cur, wr, wc, fr_, fq_, pre); }
        epi_st = cur.skip ? -1 : E.stores(cur);
        if (!has_next) break;
        if (!S.keep_acc(cur)) {
#pragma unroll
        for (int a = 0; a < 2; ++a)
#pragma unroll
            for (int b = 0; b < 2; ++b)
#pragma unroll
                for (int m = 0; m < 4; ++m)
#pragma unroll
                    for (int n = 0; n < 2; ++n) acc[a][b][m][n] = (f32x4){zero_, zero_, zero_, zero_};
        }
        cur = nxt; cA = nA; cB = nB; ++ui;
        if constexpr (ALIGN_EPI) { if (wr == 1) PG8_BAR; }
    }
    PG8_WAIT_V(0);
    if constexpr (!ALIGN_EPI) { if (wr == 0) PG8_BAR; }
    PG8_BAR;
#undef PG8_SA
#undef PG8_SB
#undef PG8_STAGE
#undef PG8_LDA
#undef PG8_LDB
#undef PG8_MMA
#undef PG8_CAT8
#undef PG8_WAIT_V
#undef PG8_WAIT_VC
#undef PG8_WAIT_L
#undef PG8_BAR
#undef PG8_SCHED
#undef PG8_ROWOFFS
#undef PG8_ROWRAW
#undef PG8_ROWFIN
#undef PG8_AV0
#undef PG8_AV1
}
}
#define EPI_ARGS f32x4 (&acc)[2][2][4][2], const pg8::Unit& u, int wr, int wc, int fr, int fq, const Pre& pre
#define EPI_NOPRE struct Pre {}; static constexpr int NPRE = 0; __device__ __forceinline__ void preload(Pre&, const pg8::Unit&, int, int, int, int) const {}
constexpr float LOG2E = 1.4426950408889634f;
constexpr float TINY_C2 = 0.125f * LOG2E;
constexpr float NA_QS = 0.17677669529663687f * LOG2E;

__device__ __forceinline__ u32x4 pack8(f32x4 a, f32x4 b) { u32x4 w; w.x = pg8::cvt_pk_bf16(a[0], a[1]); w.y = pg8::cvt_pk_bf16(a[2], a[3]); w.z = pg8::cvt_pk_bf16(b[0], b[1]); w.w = pg8::cvt_pk_bf16(b[2], b[3]); return w; }
__device__ __forceinline__ f32x4 gelu4(f32x4 v) { const f32x2 a = pg8::gelu_pk((f32x2){v[0], v[1]}), b = pg8::gelu_pk((f32x2){v[2], v[3]}); return (f32x4){a.x, a.y, b.x, b.y}; }
__device__ __forceinline__ float sigmoidf_(float x) { return __builtin_amdgcn_rcpf(1.f + __builtin_amdgcn_exp2f(-x * LOG2E)); }
__device__ __forceinline__ unsigned q4_u8(f32x4 v) { const unsigned a = (unsigned)(v[0] * 255.f + 0.5f), b = (unsigned)(v[1] * 255.f + 0.5f), c = (unsigned)(v[2] * 255.f + 0.5f), d = (unsigned)(v[3] * 255.f + 0.5f); return a | (b << 8) | (c << 16) | (d << 24); }
__device__ __forceinline__ f32x4 dq4_u8(unsigned w) { return (f32x4){(float)(w & 0xffu), (float)((w >> 8) & 0xffu), (float)((w >> 16) & 0xffu), (float)(w >> 24)} * (1.f / 255.f); }
__device__ __forceinline__ f32x4 sigmoid4(f32x4 v) { return (f32x4){sigmoidf_(v[0]), sigmoidf_(v[1]), sigmoidf_(v[2]), sigmoidf_(v[3])}; }
__device__ __forceinline__ void unpack8(u32x4 w, f32x4& a, f32x4& b) {
    a = (f32x4){__builtin_bit_cast(float, w.x << 16), __builtin_bit_cast(float, w.x & 0xffff0000u), __builtin_bit_cast(float, w.y << 16), __builtin_bit_cast(float, w.y & 0xffff0000u)};
    b = (f32x4){__builtin_bit_cast(float, w.z << 16), __builtin_bit_cast(float, w.z & 0xffff0000u), __builtin_bit_cast(float, w.w << 16), __builtin_bit_cast(float, w.w & 0xffff0000u)};
}

__device__ __forceinline__ unsigned pk4_fp8(f32x4 v) {
    const float L = 448.f;
    int d = __builtin_amdgcn_cvt_pk_fp8_f32(__builtin_amdgcn_fmed3f(v[0], -L, L), __builtin_amdgcn_fmed3f(v[1], -L, L), 0, false);
    d = __builtin_amdgcn_cvt_pk_fp8_f32(__builtin_amdgcn_fmed3f(v[2], -L, L), __builtin_amdgcn_fmed3f(v[3], -L, L), d, true);
    return (unsigned)d;
}
__device__ __forceinline__ void unpk8_fp8(u32x2 w, f32x4& a, f32x4& b) {
    const auto a0 = __builtin_amdgcn_cvt_pk_f32_fp8((int)w.x, false), a1 = __builtin_amdgcn_cvt_pk_f32_fp8((int)w.x, true), b0 = __builtin_amdgcn_cvt_pk_f32_fp8((int)w.y, false), b1 = __builtin_amdgcn_cvt_pk_f32_fp8((int)w.y, true);
    a = (f32x4){a0[0], a0[1], a1[0], a1[1]}; b = (f32x4){b0[0], b0[1], b1[0], b1[1]};
}
struct EpiMain {
    __device__ __forceinline__ int stores(const pg8::Unit& u) const { const int tile = u.pn + tile0; return (tile >= 4 && tile < 12) ? 8 : 16; }
    EPI_NOPRE
    static constexpr int MIN_STORES = 8;
    static constexpr bool PERM = true;
    int mode; const LAS float* bias; unsigned char* ws; void* dup; float sc; int tile0;
    __device__ __forceinline__ void operator()(EPI_ARGS) const {
        const int tile = u.pn + tile0;
        const int bcol0 = (mode == 0 ? tile : u.pn) * 256 + wc * 64 + 16 * fq;
#pragma unroll
        for (int bj = 0; bj < 2; ++bj)
#pragma unroll
            for (int n = 0; n < 2; ++n) { const f32x4 bv = *(const LAS f32x4*)(bias + bcol0 + bj * 8 + 4 * n);
#pragma unroll
                for (int ai = 0; ai < 2; ++ai)
#pragma unroll
                    for (int m = 0; m < 4; ++m) acc[ai][bj][m][n] = acc[ai][bj][m][n] * sc + bv; }
        const int row0 = u.pm * 256 + wr * 64 + fr;
        if (tile >= 4 && tile < 12) {
            unsigned char* O8 = ws + (tile < 8 ? WS_GA : WS_GB); const int col0 = (tile & 3) * 256 + wc * 64 + 16 * fq;
#pragma unroll
            for (int ai = 0; ai < 2; ++ai)
#pragma unroll
                for (int m = 0; m < 4; ++m) { u32x4 o; o.x = q4_u8(sigmoid4(acc[ai][0][m][0])); o.y = q4_u8(sigmoid4(acc[ai][0][m][1])); o.z = q4_u8(sigmoid4(acc[ai][1][m][0])); o.w = q4_u8(sigmoid4(acc[ai][1][m][1]));
                    *(u32x4*)(O8 + (size_t)(row0 + ai * 128 + m * 16) * 1024 + col0) = o; }
        } else if (tile < 4) {
            const size_t woff = WS_U;
            bf16_t* O = (bf16_t*)(ws + woff); const int col0 = (tile & 3) * 256 + wc * 64 + 16 * fq;
#pragma unroll
            for (int ai = 0; ai < 2; ++ai)
#pragma unroll
                for (int m = 0; m < 4; ++m) { bf16_t* rowp = O + (size_t)(row0 + ai * 128 + m * 16) * 1024 + col0;
#pragma unroll
                    for (int bj = 0; bj < 2; ++bj) { const u32x4 pv = pack8(acc[ai][bj][m][0], acc[ai][bj][m][1]); *(u32x4*)(rowp + bj * 8) = pv;
                        if constexpr ((PROBE_MASK >> 23) & 1) { *(u32x4*)((bf16_t*)dup + (rowp - O) + bj * 8) = pv; } } }
        } else {
            const size_t woff = tile < 14 ? WS_NQ : (mode == 0 ? WS_NK : WS_NKC);
            bf16_t* O = (bf16_t*)(ws + woff); const float sc = tile < 14 ? NA_QS : 1.f; const int col0 = (tile & 1) * 256 + wc * 64 + 16 * fq;
            if (tile >= 14 && mode == 0) {
#pragma unroll
                for (int ai = 0; ai < 2; ++ai)
#pragma unroll
                    for (int m = 0; m < 4; ++m) { const int row = row0 + ai * 128 + m * 16; const int b = row >> 11, s = row & 2047;
#pragma unroll
                        for (int bj = 0; bj < 2; ++bj) { const int col = col0 + bj * 8; *(u32x4*)(O + ((size_t)(b * 16 + (col >> 5)) * 2048 + s) * 32 + (col & 31)) = pack8(acc[ai][bj][m][0], acc[ai][bj][m][1]); } }
            } else {
#pragma unroll
            for (int ai = 0; ai < 2; ++ai)
#pragma unroll
                for (int m = 0; m < 4; ++m) { bf16_t* rowp = O + (size_t)(row0 + ai * 128 + m * 16) * 512 + col0;
#pragma unroll
                    for (int bj = 0; bj < 2; ++bj) *(u32x4*)(rowp + bj * 8) = pack8(acc[ai][bj][m][0] * sc, acc[ai][bj][m][1] * sc); }
            }
        }
    }
};
template <int MODE> struct EpiTT {
    __device__ __forceinline__ int stores(const pg8::Unit&) const { return MIN_STORES; }
    EPI_NOPRE
    static constexpr int MIN_STORES = 0;
    static constexpr bool PERM = true;
    const float* bias; bf16_t *TQ, *TKA, *TVA; const float* rope;
    __device__ __forceinline__ void operator()(EPI_ARGS) const {
        const int row0 = u.pm * 256 + wr * 64 + fr;
        const int axis = fq >> 1, c16 = 16 * fq;
#pragma unroll
        for (int bj = 0; bj < 2; ++bj)
#pragma unroll
            for (int n = 0; n < 2; ++n) { const f32x4 bv = *(const f32x4*)(bias + wc * 64 + c16 + 8 * bj + 4 * n);
#pragma unroll
                for (int ai = 0; ai < 2; ++ai)
#pragma unroll
                    for (int m = 0; m < 4; ++m) acc[ai][bj][m][n] += bv; }
        if (wc == 3) return;
#pragma unroll
        for (int ah = 0; ah < 4; ++ah) { const int ai = ah >> 1, mh = ah & 1;
            f32x4 cs[2][2][2];
            if (MODE == 0 && wc < 2) {
#pragma unroll
                for (int mm = 0; mm < 2; ++mm) { const int s = (row0 + ai * 128 + (2 * mh + mm) * 16) & 2047; const int pos = axis == 0 ? (s >> 6) : (s & 63);
#pragma unroll
                    for (int bj = 0; bj < 2; ++bj) { const float* rb = rope + ((axis * 64 + pos) * 16 + 8 * (fq & 1) + 4 * bj) * 2; cs[mm][bj][0] = *(const f32x4*)rb; cs[mm][bj][1] = *(const f32x4*)(rb + 4); } }
            }
#pragma unroll
            for (int mm = 0; mm < 2; ++mm) { const int m = 2 * mh + mm;
                const int row = row0 + ai * 128 + m * 16;
                int b, s; size_t kvrow;
                if (MODE == 0) { b = row >> 11; s = row & 2047; kvrow = (size_t)b * 2304 + s; } else { b = row >> 8; s = row & 255; kvrow = (size_t)b * 2304 + 2048 + s; }
#pragma unroll
                for (int bj = 0; bj < 2; ++bj) {
                    f32x4 v0 = acc[ai][bj][m][0], v1 = acc[ai][bj][m][1];
                    if (MODE == 0 && wc < 2) {
                        const f32x4 cs0 = cs[mm][bj][0], cs1 = cs[mm][bj][1];
                        v0 = (f32x4){v0[0] * cs0[0] - v0[1] * cs0[1], v0[1] * cs0[0] + v0[0] * cs0[1], v0[2] * cs0[2] - v0[3] * cs0[3], v0[3] * cs0[2] + v0[2] * cs0[3]};
                        v1 = (f32x4){v1[0] * cs1[0] - v1[1] * cs1[1], v1[1] * cs1[0] + v1[0] * cs1[1], v1[2] * cs1[2] - v1[3] * cs1[3], v1[3] * cs1[2] + v1[2] * cs1[3]};
                    }
                    if (wc == 0) { if (MODE == 0) *(u32x4*)(TQ + (size_t)row * 64 + c16 + 8 * bj) = pack8(v0 * TINY_C2, v1 * TINY_C2); }
                    else if (wc == 1) *(u32x4*)(TKA + kvrow * 64 + c16 + 8 * bj) = pack8(v0, v1);
                    else *(u32x4*)(TVA + kvrow * 64 + c16 + 8 * bj) = pack8(v0, v1);
                }
            }
            asm volatile("" ::: "memory");
        }
    }
};

struct EpiT {
    __device__ __forceinline__ int stores(const pg8::Unit&) const { return MIN_STORES; }
    EPI_NOPRE
    static constexpr int MIN_STORES = 16;
    static constexpr bool PERM = true;
    unsigned char* ws; const float* biasT; int ldc, pm_off, ctx; float sc;
    __device__ __forceinline__ void operator()(EPI_ARGS) const {
        const int rt = u.pm + pm_off;
        const int col0 = u.pn * 256 + wc * 64 + 16 * fq;
        const size_t woff = rt < 4 ? WS_VT : (ctx ? WS_NVCT : WS_NVT);
        bf16_t* O = (bf16_t*)(ws + woff);
        float bvv[2][4];
#pragma unroll
        for (int ai = 0; ai < 2; ++ai)
#pragma unroll
            for (int m = 0; m < 4; ++m) bvv[ai][m] = biasT[rt * 256 + ai * 128 + wr * 64 + m * 16 + fr];
#pragma unroll
        for (int ai = 0; ai < 2; ++ai)
#pragma unroll
            for (int m = 0; m < 4; ++m) {
                const int ch = rt * 256 + ai * 128 + wr * 64 + m * 16 + fr; const float bv = bvv[ai][m];
#pragma unroll
                for (int bj = 0; bj < 2; ++bj) { f32x4 v0 = acc[ai][bj][m][0] * sc + bv, v1 = acc[ai][bj][m][1] * sc + bv;
                    if (rt < 4) { v0 = gelu4(v0); v1 = gelu4(v1); }
                    const int t = col0 + bj * 8;
                    size_t idx;
                    if (rt < 4) idx = (size_t)(t >> 7) * (1024 * 128) + (size_t)ch * 128 + (t & 127);
                    else if (!ctx) { const int cn = ch - 1024, b = t >> 11, s = t & 2047; idx = ((size_t)((b * 16 + (cn >> 5)) * 32 + (s >> 6)) * 32 + (cn & 31)) * 64 + (s & 63); }
                    else idx = (size_t)(ch - 1024) * ldc + t;
                    *(u32x4*)(O + idx) = pack8(v0, v1); } }
    }
};

struct EpiGate {
    __device__ __forceinline__ int stores(const pg8::Unit&) const { return MIN_STORES; }
    EPI_NOPRE
    static constexpr int MIN_STORES = 16;
    static constexpr bool PERM = true;
    const unsigned char* gate; const bf16_t* addend; bf16_t* out;
    __device__ __forceinline__ void operator()(EPI_ARGS) const {
        const int row0 = u.pm * 256 + wr * 64 + fr, col0 = u.pn * 256 + wc * 64 + 16 * fq;
#pragma unroll
        for (int ai = 0; ai < 2; ++ai) {
            u32x4 gv[4], av[4][2];
#pragma unroll
            for (int m = 0; m < 4; ++m) { const size_t off = (size_t)(row0 + ai * 128 + m * 16) * 1024 + col0; gv[m] = *(const u32x4*)(gate + off);
#pragma unroll
                for (int bj = 0; bj < 2; ++bj) av[m][bj] = addend ? *(const u32x4*)(addend + off + bj * 8) : (u32x4){0u, 0u, 0u, 0u}; }
#pragma unroll
            for (int m = 0; m < 4; ++m) { const size_t off = (size_t)(row0 + ai * 128 + m * 16) * 1024 + col0;
#pragma unroll
                for (int bj = 0; bj < 2; ++bj) { f32x4 a0, a1; unpack8(av[m][bj], a0, a1);
                    *(u32x4*)(out + off + bj * 8) = pack8(a0 + dq4_u8(gv[m][2 * bj]) * acc[ai][bj][m][0], a1 + dq4_u8(gv[m][2 * bj + 1]) * acc[ai][bj][m][1]); } }
            asm volatile("" ::: "memory");
        }
    }
};

struct EpiMerge {
    EPI_NOPRE
    static constexpr int MIN_STORES = 0;
    static constexpr bool PERM = true;
    const unsigned char* ga; const unsigned char* gb; bf16_t* out;
    __device__ __forceinline__ int stores(const pg8::Unit& u) const { return u.e ? 16 : 0; }
    __device__ __forceinline__ static f32x4 codes(unsigned w) { return (f32x4){(float)(w & 0xffu), (float)((w >> 8) & 0xffu), (float)((w >> 16) & 0xffu), (float)(w >> 24)}; }
    __device__ __forceinline__ static f32x4 max4(f32x4 v, float lo) { return (f32x4){fmaxf(v[0], lo), fmaxf(v[1], lo), fmaxf(v[2], lo), fmaxf(v[3], lo)}; }
    __device__ __forceinline__ static f32x4 rcp4(f32x4 v) { return (f32x4){__builtin_amdgcn_rcpf(v[0]), __builtin_amdgcn_rcpf(v[1]), __builtin_amdgcn_rcpf(v[2]), __builtin_amdgcn_rcpf(v[3])}; }
    __device__ __forceinline__ void operator()(EPI_ARGS) const {
        const int row0 = u.pm * 256 + wr * 64 + fr, col0 = u.pn * 256 + wc * 64 + 16 * fq;
        if (u.e == 0) {
#pragma unroll
            for (int ai = 0; ai < 2; ++ai) { u32x4 va[4], vb[4];
#pragma unroll
                for (int m = 0; m < 4; ++m) { const size_t off = (size_t)(row0 + ai * 128 + m * 16) * 1024 + col0; va[m] = *(const u32x4*)(ga + off); vb[m] = *(const u32x4*)(gb + off); }
#pragma unroll
                for (int m = 0; m < 4; ++m)
#pragma unroll
                    for (int bj = 0; bj < 2; ++bj)
#pragma unroll
                        for (int n = 0; n < 2; ++n) acc[ai][bj][m][n] = acc[ai][bj][m][n] * (codes(vb[m][2 * bj + n]) * rcp4(max4(codes(va[m][2 * bj + n]), 0.5f))); }
        } else {
#pragma unroll
            for (int ai = 0; ai < 2; ++ai) { u32x4 va[4];
#pragma unroll
                for (int m = 0; m < 4; ++m) va[m] = *(const u32x4*)(ga + (size_t)(row0 + ai * 128 + m * 16) * 1024 + col0);
#pragma unroll
                for (int m = 0; m < 4; ++m) { const size_t off = (size_t)(row0 + ai * 128 + m * 16) * 1024 + col0;
#pragma unroll
                    for (int bj = 0; bj < 2; ++bj) *(u32x4*)(out + off + bj * 8) = pack8(max4(codes(va[m][2 * bj]), 0.5f) * (1.f / 255.f) * acc[ai][bj][m][0], max4(codes(va[m][2 * bj + 1]), 0.5f) * (1.f / 255.f) * acc[ai][bj][m][1]); }
                asm volatile("" ::: "memory"); }
        }
    }
};

struct EpiXmid {
    __device__ __forceinline__ int stores(const pg8::Unit&) const { return MIN_STORES; }
    EPI_NOPRE
    static constexpr int MIN_STORES = 16;
    static constexpr bool PERM = true;
    const float* x; const float* mod; bf16_t* xmid; float* ssq;
    __device__ __forceinline__ void operator()(EPI_ARGS) const {
        const int row0 = u.pm * 256 + wr * 64 + fr, col0 = u.pn * 256 + wc * 64 + 16 * fq;
        const float* gm = mod + (size_t)(u.pm >> 3) * 6144 + 2048;
        f32x4 gv[2][2];
#pragma unroll
        for (int bj = 0; bj < 2; ++bj)
#pragma unroll
            for (int n = 0; n < 2; ++n) gv[bj][n] = *(const f32x4*)(gm + col0 + bj * 8 + n * 4);
#pragma unroll
        for (int ai = 0; ai < 2; ++ai)
#pragma unroll
            for (int mh = 0; mh < 2; ++mh) {
                f32x4 xv[2][2][2];
#pragma unroll
                for (int mm = 0; mm < 2; ++mm) { const size_t off = (size_t)(row0 + ai * 128 + (2 * mh + mm) * 16) * 1024 + col0;
#pragma unroll
                    for (int bj = 0; bj < 2; ++bj) { xv[mm][bj][0] = *(const f32x4*)(x + off + bj * 8); xv[mm][bj][1] = *(const f32x4*)(x + off + bj * 8 + 4); } }
#pragma unroll
                for (int mm = 0; mm < 2; ++mm) { const int m = 2 * mh + mm; const size_t off = (size_t)(row0 + ai * 128 + m * 16) * 1024 + col0; float ss = 0.f;
#pragma unroll
                    for (int bj = 0; bj < 2; ++bj) { const f32x4 p0 = xv[mm][bj][0] + gv[bj][0] * acc[ai][bj][m][0], p1 = xv[mm][bj][1] + gv[bj][1] * acc[ai][bj][m][1];
                        ss += ((p0.x * p0.x + p0.y * p0.y) + (p0.z * p0.z + p0.w * p0.w)) + ((p1.x * p1.x + p1.y * p1.y) + (p1.z * p1.z + p1.w * p1.w));
                        *(u32x4*)(xmid + off + bj * 8) = pack8(p0, p1); }
                    ss += __shfl_xor(ss, 16); ss += __shfl_xor(ss, 32);
                    if (fq == 0) ssq[(size_t)(row0 + ai * 128 + m * 16) * 16 + u.pn * 4 + wc] = ss; }
                asm volatile("" ::: "memory");
            }
    }
};

struct EpiMoeGU {
    __device__ __forceinline__ int stores(const pg8::Unit&) const { return MIN_STORES; }
    EPI_NOPRE
    static constexpr int MIN_STORES = 8;
    static constexpr bool PERM = true;
    bf16_t* act;
    __device__ __forceinline__ void operator()(EPI_ARGS) const {
        const int row0 = u.pm * 256 + wr * 64 + fr, col0 = u.pn * 128 + wc * 32 + 8 * fq;
#pragma unroll
        for (int ai = 0; ai < 2; ++ai)
#pragma unroll
            for (int m = 0; m < 4; ++m) { f32x4 o[2];
#pragma unroll
                for (int n = 0; n < 2; ++n) { const f32x4 g = acc[ai][0][m][n] * (1.f / 64.f), up = acc[ai][1][m][n] * (1.f / 64.f); o[n] = g * sigmoid4(g) * up; }
                *(u32x2*)((unsigned char*)act + (size_t)(row0 + ai * 128 + m * 16) * 256 + col0) = (u32x2){pk4_fp8(o[0] * 8.f), pk4_fp8(o[1] * 8.f)}; }
    }
};

struct MoeLists { const int* crow; const float* w; const unsigned* cnt; int gt; };
__device__ __forceinline__ bool moe_lookup(const MoeLists& L, int e, int idx, int& crow, float& w) {
    if (e == 64) { crow = idx * 9 + 8; w = 1.f; return true; }
    if (idx >= (int)L.cnt[e]) { crow = 0; w = 0.f; return false; }
    crow = L.crow[(size_t)e * GCAP + idx]; w = L.w[(size_t)e * GCAP + idx]; return true;
}
struct EpiMoeDown {
    __device__ __forceinline__ int stores(const pg8::Unit&) const { return MIN_STORES; }
    static constexpr int MIN_STORES = 0;
    static constexpr bool PERM = true;
    static constexpr int NPRE = 4;
    struct Pre {};
    unsigned char* C; MoeLists L; LAS unsigned char* lds;
    __device__ __forceinline__ void preload(Pre&, const pg8::Unit& u, int wr, int wc, int fr, int fq) const {
        const int ec = min(u.e, 63), lane = lane_id_();
        LAS unsigned char* wl = lds + EPL_LDS + (wr * 4 + wc) * 1024;
#pragma unroll
        for (int ai = 0; ai < 2; ++ai) { const size_t off = (size_t)ec * GCAP + min(u.r0 + ai * 128 + wr * 64 + lane, GCAP - 1);
            __builtin_amdgcn_global_load_lds((const unsigned*)(L.crow + off), (LAS unsigned*)(wl + ai * 256), 4, 0, 0);
            __builtin_amdgcn_global_load_lds((const unsigned*)(L.w + off), (LAS unsigned*)(wl + 512 + ai * 256), 4, 0, 0); }
    }
    __device__ __forceinline__ void operator()(EPI_ARGS) const {
        const int col0 = u.pn * 256 + wc * 64 + 16 * fq;
        const LAS unsigned char* wl = lds + EPL_LDS + (wr * 4 + wc) * 1024;
#pragma unroll
        for (int ai = 0; ai < 2; ++ai)
#pragma unroll
            for (int m = 0; m < 4; ++m) { const int idx = u.r0 + ai * 128 + wr * 64 + m * 16 + fr;
                if (idx < u.cnt) {
                    if (u.e == 64) { unsigned char* tp = C + (size_t)idx * CROW_BYTES;
                        const float sc_ = 1.f / 512.f;
                        u32x4 o; o.x = pk4_fp8(acc[ai][0][m][0] * sc_); o.y = pk4_fp8(acc[ai][0][m][1] * sc_); o.z = pk4_fp8(acc[ai][1][m][0] * sc_); o.w = pk4_fp8(acc[ai][1][m][1] * sc_); *(u32x4*)(tp + 8 * 1024 + col0) = o;
                    } else { const int crow = *(const LAS int*)(wl + ai * 256 + (m * 16 + fr) * 4); const float w = *(const LAS float*)(wl + 512 + ai * 256 + (m * 16 + fr) * 4) * (1.f / 512.f);
                        const int tl = crow / 9, k = crow - tl * 9; unsigned char* tp = C + (size_t)tl * CROW_BYTES;
                        u32x4 o; o.x = pk4_fp8(acc[ai][0][m][0] * w); o.y = pk4_fp8(acc[ai][0][m][1] * w); o.z = pk4_fp8(acc[ai][1][m][0] * w); o.w = pk4_fp8(acc[ai][1][m][1] * w); *(u32x4*)(tp + k * 1024 + col0) = o; }
                } }
    }
};

struct MoeOrder {
    const volatile LAS unsigned* blk; int nblk, NT, G, c; MoeLists L; int K2, hb;
    __device__ __forceinline__ bool next(int i, pg8::Unit& u) const {
        const int Lq = i * G + c; if (Lq >= nblk * NT) return false;
        const int j = Lq / NT; const unsigned v = (unsigned)__builtin_amdgcn_readfirstlane((int)blk[j]);
        u.pm = j; u.pn = Lq - j * NT; u.e = (int)(v >> 16); u.r0 = (int)(v & 0xffffu) * 256; u.skip = 0;
        u.cnt = u.e == 64 ? L.gt : __builtin_amdgcn_readfirstlane((int)blk[MOE_MAXBLK + 66 + min(u.e, 63)]); return true;
    }
    __device__ __forceinline__ int rowraw(const pg8::Unit& u, int r) const {
        return L.crow[(size_t)min(u.e, 63) * GCAP + min(u.r0 + r, GCAP - 1)];
    }
    __device__ __forceinline__ unsigned rowfin(const pg8::Unit& u, int r, int raw) const {
        const int idx = u.r0 + r;
        const int tokv = u.e == 64 ? hb + idx : hb + raw / 9;
        const int tok = idx < u.cnt ? tokv : MTOK;
        return (unsigned)tok * (unsigned)K2;
    }
    __device__ __forceinline__ unsigned rowoff(const pg8::Unit& u, int r) const { return rowfin(u, r, rowraw(u, r)); }
    static constexpr int NRAW = 4;
    __device__ __forceinline__ int nt(const pg8::Unit&, int ntdef) const { return ntdef; }
    __device__ __forceinline__ bool keep_acc(const pg8::Unit&) const { return false; }
};

struct Frame {
    LAS unsigned char* lds; volatile LAS unsigned* MISC; unsigned* ctl;
    int tid, lane, wave, vcu, G, cid;
};
#define LDS_WAIT() asm volatile("s_waitcnt lgkmcnt(0)" ::: "memory")

__device__ __forceinline__ void p0_adaln(Frame& F, const float* c, const float* c_ctx, const float* w_ada, const float* b_ada, float* mod) {
    LAS float* s = (LAS float*)F.lds;
    for (int cb = F.vcu; cb < 192; cb += F.G) {
        __syncthreads();
        for (int i = F.tid; i < 33 * 1024; i += NTHREADS) { const float v = (i < 32 * 1024) ? c[i] : c_ctx[i - 32 * 1024]; s[i] = v / (1.f + __expf(-v)); }
        __syncthreads();
        const int col = F.lane & 31, kh = F.lane >> 5;
        float acc[33];
#pragma unroll
        for (int b = 0; b < 33; ++b) acc[b] = 0.f;
#pragma unroll 1
        for (int i0 = 0; i0 < 64; i0 += 8) {
            float wv[8];
#pragma unroll
            for (int j = 0; j < 8; ++j) wv[j] = w_ada[(size_t)(128 * F.wave + 2 * (i0 + j) + kh) * 6144 + 32 * cb + col];
#pragma unroll
            for (int j = 0; j < 8; ++j) { const int k = 128 * F.wave + 2 * (i0 + j) + kh;
#pragma unroll
                for (int b = 0; b < 33; ++b) acc[b] += s[b * 1024 + k] * wv[j]; }
        }
#pragma unroll
        for (int b = 0; b < 33; ++b) acc[b] += __shfl_xor(acc[b], 32);
        __syncthreads();
        if (F.lane < 32) {
#pragma unroll
            for (int b = 0; b < 33; ++b) s[(F.wave * 33 + b) * 32 + col] = acc[b];
        }
        __syncthreads();
        for (int o = F.tid; o < 33 * 32; o += NTHREADS) { const int b = o >> 5, cc = o & 31; float t = 0.f;
#pragma unroll
            for (int w = 0; w < 8; ++w) t += s[(w * 33 + b) * 32 + cc];
            mod[b * 6144 + 32 * cb + cc] = t + b_ada[32 * cb + cc]; }
    }
    __syncthreads();
}

struct TrItem { const float* W; bf16_t* WT; int ldw, ldk, k0, n0, drow0, ilv, f8; unsigned char* W8; };
__device__ __forceinline__ void tr_load(const TrItem& t, float (&wv)[32], int lane) {
#pragma unroll
    for (int i = 0; i < 32; ++i) wv[i] = t.W[(size_t)(t.k0 + 2 * i + (lane >> 5)) * t.ldw + t.n0 + (lane & 31)];
}
__device__ __forceinline__ void tr_store(const TrItem& t, const float (&wv)[32], LAS float* scr, int lane) {
#pragma unroll
    for (int i = 0; i < 32; ++i) scr[(2 * i + (lane >> 5)) * 33 + (lane & 31)] = wv[i];
    LDS_WAIT(); asm volatile("" ::: "memory");
    const int c = lane & 7;
#pragma unroll
    for (int j = 0; j < 4; ++j) { const int n = (lane >> 3) + 8 * j; const LAS float* s = scr + (8 * c) * 33 + n;
        if (t.f8) { const int drow = t.drow0 + (t.ilv == 1 ? 16 * (n >> 3) + (n & 7) : t.ilv == 2 ? 2 * (n & 15) + (n >> 4) : n);
            const unsigned lo = pk4_fp8((f32x4){s[0 * 33], s[1 * 33], s[2 * 33], s[3 * 33]} * 64.f), hi = pk4_fp8((f32x4){s[4 * 33], s[5 * 33], s[6 * 33], s[7 * 33]} * 64.f);
            *(u32x2*)((unsigned char*)t.WT + (size_t)drow * t.ldk + t.k0 + 8 * c) = (u32x2){lo, hi}; continue; }
        if (t.W8) { const int drow = t.drow0 + n;
            const unsigned lo = pk4_fp8((f32x4){s[0 * 33], s[1 * 33], s[2 * 33], s[3 * 33]} * 64.f), hi = pk4_fp8((f32x4){s[4 * 33], s[5 * 33], s[6 * 33], s[7 * 33]} * 64.f);
            *(u32x2*)(t.W8 + (size_t)drow * 1024 + t.k0 + 8 * c) = (u32x2){lo, hi}; }
        u32x4 o; o.x = pk2(s[0 * 33], s[1 * 33]); o.y = pk2(s[2 * 33], s[3 * 33]); o.z = pk2(s[4 * 33], s[5 * 33]); o.w = pk2(s[6 * 33], s[7 * 33]);
        *(u32x4*)(t.WT + (size_t)(t.drow0 + (t.ilv == 1 ? 16 * (n >> 3) + (n & 7) : t.ilv == 2 ? 2 * (n & 15) + (n >> 4) : n)) * t.ldk + t.k0 + 8 * c) = o; }
    LDS_WAIT(); asm volatile("" ::: "memory");
}
struct TrJob { const float* W; bf16_t* WT; int ldw, K, ncols, n0, drow0, nrep, mode; size_t wrs, wtrs; int ldk, f8; unsigned char* W8; };
__device__ __forceinline__ int trjob_items(const TrJob& j) { return j.nrep * (j.K / 64) * (j.ncols / 32); }
__device__ __forceinline__ TrItem trjob_item(const TrJob& j, int item) {
    const int per = (j.K / 64) * (j.ncols / 32); const int rep = item / per, r = item - rep * per; const int nblk = j.ncols / 32, kb = r / nblk, nb = r - kb * nblk;
    int drow = j.drow0 + 32 * nb;
    if (j.mode == 1 || j.mode == 2) { const int c0 = 32 * nb; drow = j.drow0 + 256 * (c0 >> 7) + 64 * ((c0 & 127) >> 5) + (j.mode == 2 ? 8 : 0); }
    return TrItem{j.W + (size_t)rep * j.wrs, j.WT + (size_t)rep * j.wtrs, j.ldw, j.ldk ? j.ldk : j.K, 64 * kb, j.n0 + 32 * nb, drow, j.mode == 3 ? 2 : (j.mode != 0 ? 1 : 0), j.f8, j.W8};
}

__device__ __forceinline__ void norm_mod_rows(const float* x0, bf16_t* o0, int nrows, const float* g, const float* shift, const float* scale, int lane, unsigned char* o8f = nullptr) {
    f32x4 gs[4], sh[4];
#pragma unroll
    for (int j = 0; j < 4; ++j) { gs[j] = ((const f32x4*)g)[lane + 64 * j] * (((const f32x4*)scale)[lane + 64 * j] + 1.f); sh[j] = ((const f32x4*)shift)[lane + 64 * j]; }
#pragma unroll 1
    for (int r0 = 0; r0 < nrows; r0 += 4) {
        f32x4 v[4][4]; float s[4];
#pragma unroll
        for (int q = 0; q < 4; ++q)
#pragma unroll
            for (int j = 0; j < 4; ++j) v[q][j] = ((const f32x4*)(x0 + (size_t)(r0 + q) * DM))[lane + 64 * j];
#pragma unroll
        for (int q = 0; q < 4; ++q) { s[q] = 0.f;
#pragma unroll
            for (int j = 0; j < 4; ++j) s[q] += (v[q][j].x * v[q][j].x + v[q][j].y * v[q][j].y) + (v[q][j].z * v[q][j].z + v[q][j].w * v[q][j].w); }
#pragma unroll
        for (int o = 1; o < 64; o <<= 1) {
#pragma unroll
            for (int q = 0; q < 4; ++q) s[q] += __shfl_xor(s[q], o); }
#pragma unroll
        for (int q = 0; q < 4; ++q) { const float r = 1.f / sqrtf(s[q] * (1.f / DM) + NORM_EPS);
            u32x2* o8 = (u32x2*)(o0 + (size_t)(r0 + q) * DM) + lane;
#pragma unroll
            for (int j = 0; j < 4; ++j) { const f32x4 h = v[q][j] * r * gs[j] + sh[j]; u32x2 w; w.x = pk2(h.x, h.y); w.y = pk2(h.z, h.w); o8[64 * j] = w;
                if (o8f) ((unsigned*)(o8f + (size_t)(r0 + q) * DM))[lane + 64 * j] = pk4_fp8(h); } }
    }
}

namespace tattn {
using f32x16 = __attribute__((ext_vector_type(16))) float;
using s16x4 = __attribute__((ext_vector_type(4))) short;
constexpr int TP = 64;
constexpr int NW = 8, QBLK = 32, QB = QBLK * NW, KVBLK = 64;
__device__ __forceinline__ int crow(int r, int hi) { return (r & 3) + 8 * (r >> 2) + 4 * hi; }
#define SBAR() __builtin_amdgcn_sched_barrier(0)
constexpr int NSLOT = 3, SLOTB = 8192;
constexpr int LDS_K = 0, LDS_V = NSLOT * SLOTB, LDS_WS = 2 * NSLOT * SLOTB, LDS_OST = LDS_WS + NW * 64 * 4, LDS_BYTES_T = LDS_OST + NW * 4096;
__device__ __forceinline__ void glds16(const void* gsrc, unsigned lds_dst) { unsigned keep;
    asm volatile("s_mov_b32 %0, m0\n\ts_mov_b32 m0, %2\n\ts_nop 0\n\tglobal_load_lds_dwordx4 %1, off\n\ts_mov_b32 m0, %0" : "=&s"(keep) : "v"(gsrc), "s"(lds_dst) : "memory"); }
__device__ __forceinline__ float max3f(float a, float b, float c) { float r; asm("v_max3_f32 %0, %1, %2, %3" : "=v"(r) : "v"(a), "v"(b), "v"(c)); return r; }
__device__ __forceinline__ float max2f(float a, float b) { float r; asm("v_max_f32_e32 %0, %1, %2" : "=v"(r) : "v"(a), "v"(b)); return r; }
__device__ __forceinline__ float fadd_s(float a, float b) { float r; asm("v_add_f32_e32 %0, %1, %2" : "=v"(r) : "v"(a), "v"(b)); return r; }
__device__ __forceinline__ float fsub_s(float a, float b) { float r; asm("v_sub_f32_e32 %0, %1, %2" : "=v"(r) : "v"(a), "v"(b)); return r; }
typedef float f32x2_t __attribute__((ext_vector_type(2))); typedef __bf16 bf16x2_t __attribute__((ext_vector_type(2)));
__device__ __forceinline__ unsigned cvtpk_s(float lo, float hi) { f32x2_t v = {lo, hi}; bf16x2_t b = __builtin_convertvector(v, bf16x2_t); return __builtin_bit_cast(unsigned, b); }
#define WAIT_BAR(N) asm volatile("s_waitcnt vmcnt(" #N ") lgkmcnt(0)\n\ts_barrier" ::: "memory")
__device__ __forceinline__ void qkt(f32x16& p0, f32x16& p1, const char* Kslot, const bf16x8* qr, const f32x16& negm, int r32, int hi) {
    const char* kb = Kslot + hi * 1024 + r32 * 16;
#pragma unroll
    for (int d0 = 0; d0 < 4; ++d0) {
        const bf16x8 b0 = *reinterpret_cast<const bf16x8*>(kb + d0 * 2048);
        const bf16x8 b1 = *reinterpret_cast<const bf16x8*>(kb + d0 * 2048 + 512);
        if (d0 == 0) { p0 = __builtin_amdgcn_mfma_f32_32x32x16_bf16(b0, qr[0], negm, 0, 0, 0); p1 = __builtin_amdgcn_mfma_f32_32x32x16_bf16(b1, qr[0], negm, 0, 0, 0); }
        else { p0 = __builtin_amdgcn_mfma_f32_32x32x16_bf16(b0, qr[d0], p0, 0, 0, 0); p1 = __builtin_amdgcn_mfma_f32_32x32x16_bf16(b1, qr[d0], p1, 0, 0, 0); } }
}
typedef __attribute__((address_space(3))) const char* lds_cptr;
typedef short v4i16_t __attribute__((ext_vector_type(4)));
__device__ __forceinline__ void kload8(bf16x8* kf, lds_cptr kp) {
    kf[0] = *(const __attribute__((address_space(3))) bf16x8*)(kp);        kf[1] = *(const __attribute__((address_space(3))) bf16x8*)(kp + 512);
    kf[2] = *(const __attribute__((address_space(3))) bf16x8*)(kp + 2048); kf[3] = *(const __attribute__((address_space(3))) bf16x8*)(kp + 2560);
    kf[4] = *(const __attribute__((address_space(3))) bf16x8*)(kp + 4096); kf[5] = *(const __attribute__((address_space(3))) bf16x8*)(kp + 4608);
    kf[6] = *(const __attribute__((address_space(3))) bf16x8*)(kp + 6144); kf[7] = *(const __attribute__((address_space(3))) bf16x8*)(kp + 6656);
}
__device__ __forceinline__ void kload2(bf16x8* kf, lds_cptr kp, int j) { kf[2 * j] = *(const __attribute__((address_space(3))) bf16x8*)(kp + j * 2048); kf[2 * j + 1] = *(const __attribute__((address_space(3))) bf16x8*)(kp + j * 2048 + 512); }
__device__ __forceinline__ s16x4 vtr(lds_cptr p) { return __builtin_bit_cast(s16x4, __builtin_amdgcn_ds_read_tr16_b64_v4i16((__attribute__((address_space(3))) v4i16_t*)p)); }
__device__ __forceinline__ float rowmax(const f32x16& p0, const f32x16& p1) {
    float a = max3f(p0[0], p0[1], p1[0]), b = max3f(p0[2], p0[3], p1[1]); a = max3f(a, p1[2], p1[3]);
#pragma unroll
    for (int r = 4; r < 16; r += 4) { a = max3f(a, p0[r], p0[r + 1]); b = max3f(b, p0[r + 2], p0[r + 3]); a = max3f(a, p1[r], p1[r + 1]); b = max3f(b, p1[r + 2], p1[r + 3]); }
    const float m = max2f(a, b);
    auto rr = __builtin_amdgcn_permlane32_swap(__float_as_uint(m), __float_as_uint(m), false, false);
    return max2f(__uint_as_float(rr[0]), __uint_as_float(rr[1]));
}
__device__ __forceinline__ void pv(f32x16* o, int vb, bf16x8 pa0, bf16x8 pa1, bf16x8 pa2, bf16x8 pa3) {
#pragma unroll
    for (int d0 = 0; d0 < 2; ++d0) { s16x4 lo[4], hi[4];
#pragma unroll
        for (int ks = 0; ks < 4; ++ks) {
            asm volatile("ds_read_b64_tr_b16 %0,%1 offset:%c2" : "=&v"(lo[ks]) : "v"(vb), "i"(d0 * 4096 + ks * 1024) : "memory");
            asm volatile("ds_read_b64_tr_b16 %0,%1 offset:%c2" : "=&v"(hi[ks]) : "v"(vb), "i"(d0 * 4096 + ks * 1024 + 512) : "memory"); }
        asm volatile("s_waitcnt lgkmcnt(0)" ::: "memory"); SBAR();
#define PK(k) (bf16x8){lo[k][0], lo[k][1], lo[k][2], lo[k][3], hi[k][0], hi[k][1], hi[k][2], hi[k][3]}
        o[d0] = __builtin_amdgcn_mfma_f32_32x32x16_bf16(pa0, PK(0), o[d0], 0, 0, 0);
        o[d0] = __builtin_amdgcn_mfma_f32_32x32x16_bf16(pa1, PK(1), o[d0], 0, 0, 0);
        o[d0] = __builtin_amdgcn_mfma_f32_32x32x16_bf16(pa2, PK(2), o[d0], 0, 0, 0);
        o[d0] = __builtin_amdgcn_mfma_f32_32x32x16_bf16(pa3, PK(3), o[d0], 0, 0, 0);
#undef PK
    }
}
template <int THRL, int NKEYS> __device__ __forceinline__ void attn_unit(const bf16_t* Qu, const bf16_t* __restrict__ Kb, const bf16_t* __restrict__ Vb, bf16_t* Ou, char* shm) {
    const int tid = TIDX(), lane = tid & 63, r32 = lane & 31, hi = lane >> 5; const int wid = __builtin_amdgcn_readfirstlane(tid >> 6);
    const bf16_t* Qw = Qu + (long)(wid * QBLK) * TP;
    const bf16_t *Kh = Kb, *Vh = Vb;
    const unsigned lds0 = (unsigned)(uintptr_t)shm;
    float* wsf = (float*)(shm + LDS_WS) + wid * 64;
    const bf16_t* ksrc = Kh + (long)lane * TP + wid * 8;
    const bf16_t* vsrc = Vh + (long)(16 * (wid & 3) + (lane >> 2)) * TP + (wid >> 2) * 32 + (lane & 3) * 8;
    const unsigned kdst = lds0 + LDS_K + wid * 1024, vdst = lds0 + LDS_V + wid * 1024;
#define DMA_K(t, slot) glds16(ksrc + (long)(t) * KVBLK * TP, (unsigned)__builtin_amdgcn_readfirstlane(kdst + (slot)))
#define DMA_V(t, slot) glds16(vsrc + (long)(t) * KVBLK * TP, (unsigned)__builtin_amdgcn_readfirstlane(vdst + (slot)))
    const int vb0 = (int)(lds0 + LDS_V) + ((lane >> 4) & 1) * 32 + (lane & 3) * 8 + (4 * hi + ((lane & 15) >> 2)) * 64;
    const char* Kbase = shm + LDS_K; bf16x8 kf[8];
    const lds_cptr shm3 = (lds_cptr)shm; const lds_cptr kp0 = shm3 + LDS_K + hi * 1024 + r32 * 16; const lds_cptr vp0 = shm3 + LDS_V + ((lane >> 4) & 1) * 32 + (lane & 3) * 8 + (4 * hi + ((lane & 15) >> 2)) * 64;
    constexpr int NT = NKEYS / KVBLK;
    static_assert(NT % 2 == 0 && NT >= 8, "NT even");
    DMA_K(0, 0); DMA_V(0, 0); DMA_K(1, SLOTB);
    bf16x8 qr[4];
#pragma unroll
    for (int d0 = 0; d0 < 4; ++d0) qr[d0] = *reinterpret_cast<const bf16x8*>(&Qw[(long)r32 * TP + d0 * 16 + hi * 8]);
    float mhat = 0.f, l_reg = 0.f; f32x16 o[2]; o[0] = f32x16{}; o[1] = f32x16{}; f32x16 negm = f32x16{}; asm volatile("" : "+v"(negm));
    bool resc = false;
#define START(P0, P1) do { const float rm = rowmax(P0, P1); resc = false; \
    { const float dl = rm; mhat = fadd_s(mhat, dl); \
      _Pragma("unroll") for (int r = 0; r < 16; ++r) { P0[r] = fsub_s(P0[r], dl); P1[r] = fsub_s(P1[r], dl); } \
      _Pragma("unroll") for (int r = 0; r < 16; ++r) negm[r] = -mhat; asm volatile("" : "+v"(negm)); } \
    _Pragma("unroll") for (int r = 0; r < 16; ++r) P0[r] = __builtin_amdgcn_exp2f(P0[r]); } while (0)
#define RESC() do { if (resc) { asm volatile("s_waitcnt lgkmcnt(0)" ::: "memory"); \
      _Pragma("unroll") for (int d_ = 0; d_ < 2; ++d_) _Pragma("unroll") for (int r = 0; r < 16; ++r) o[d_][r] *= wsf[crow(r, hi)]; } } while (0)
    f32x16 pA0, pA1, pB0, pB1;
    int sl_prev = 0, sl_cur = 0, sl_next = SLOTB;
#define ROT() do { sl_prev = sl_cur; sl_cur = sl_next; sl_next = (sl_next == (NSLOT - 1) * SLOTB) ? 0 : sl_next + SLOTB; } while (0)
    DMA_K(2, 2 * SLOTB);
    WAIT_BAR(3);
    qkt(pA0, pA1, Kbase, qr, negm, r32, hi); asm volatile("s_nop 15\n\ts_nop 7" : "+v"(pA0), "+v"(pA1));
    START(pA0, pA1);
    _Pragma("unroll") for (int r = 0; r < 16; ++r) pA1[r] = __builtin_amdgcn_exp2f(pA1[r]);
    WAIT_BAR(0);
    DMA_K(3, 0); DMA_V(1, SLOTB);
    ROT();
    kload8(kf, kp0 + sl_cur);
    WAIT_BAR(2);
    s16x4 vlo[8], vhi[8]; u32x4 pw0, pw1, pw2, pw3;
#define PKW(P, B) cvtpk_s(P[B], P[B + 1])
#define PAF(k) __builtin_bit_cast(bf16x8, pw##k)
#define VFR(i) (bf16x8){vlo[i][0], vlo[i][1], vlo[i][2], vlo[i][3], vhi[i][0], vhi[i][1], vhi[i][2], vhi[i][3]}
#define PIN(x) asm volatile("" : "+v"(x))
#define MX3(a, b, c) __builtin_fmaxf(__builtin_fmaxf((a), (b)), (c))
#define GAPA(MF, A0, A1, A2, A3, W0, W1, PW) do { MF; sacc += A0; sacc += A1; sacc += A2; sacc += A3; PIN(sacc); W0; W1; PIN(PW); SBAR(); } while (0)
#define EX(v) __builtin_amdgcn_exp2f(v)
#define GAPB(MF, X, B) do { MF; X[B] = EX(X[B]); X[B + 1] = EX(X[B + 1]); X[B + 2] = EX(X[B + 2]); X[B + 3] = EX(X[B + 3]); PIN(X); SBAR(); } while (0)
#define VRD(i) do { vlo[i] = vtr(vp_ + (((i) >> 2) * 4096 + ((i) & 3) * 1024)); vhi[i] = vtr(vp_ + (((i) >> 2) * 4096 + ((i) & 3) * 1024 + 512)); } while (0)
#define KRD(G, j) do { if (G) { kload2(kf, kp0 + sl_next, j); SBAR(); } } while (0)
#define STEP(C0, C1, P0, P1, t, GK, GV, GL) do { SBAR(); \
    const lds_cptr vp_ = vp0 + sl_prev; \
    VRD(0); SBAR(); float sacc = (P0[0] + P0[1]); \
    GAPA(C0 = __builtin_amdgcn_mfma_f32_32x32x16_bf16(kf[0], qr[0], negm, 0, 0, 0), P0[2], P0[3], P0[4], P0[5],     pw0[0] = PKW(P0, 0), pw0[1] = PKW(P0, 2), pw0); \
    VRD(4); SBAR(); GAPA(C1 = __builtin_amdgcn_mfma_f32_32x32x16_bf16(kf[1], qr[0], negm, 0, 0, 0), P0[6], P0[7], P0[8], P0[9],     pw0[2] = PKW(P0, 4), pw0[3] = PKW(P0, 6), pw0); \
    VRD(1); SBAR(); GAPA(C0 = __builtin_amdgcn_mfma_f32_32x32x16_bf16(kf[2], qr[1], C0, 0, 0, 0),   P0[10], P0[11], P0[12], P0[13], pw1[0] = PKW(P0, 8), pw1[1] = PKW(P0, 10), pw1); \
    VRD(5); SBAR(); GAPA(C1 = __builtin_amdgcn_mfma_f32_32x32x16_bf16(kf[3], qr[1], C1, 0, 0, 0),   P0[14], P0[15], P1[0], P1[1],   pw1[2] = PKW(P0, 12), pw1[3] = PKW(P0, 14), pw1); \
    VRD(2); SBAR(); GAPA(C0 = __builtin_amdgcn_mfma_f32_32x32x16_bf16(kf[4], qr[2], C0, 0, 0, 0),   P1[2], P1[3], P1[4], P1[5],     pw2[0] = PKW(P1, 0), pw2[1] = PKW(P1, 2), pw2); \
    VRD(6); SBAR(); GAPA(C1 = __builtin_amdgcn_mfma_f32_32x32x16_bf16(kf[5], qr[2], C1, 0, 0, 0),   P1[6], P1[7], P1[8], P1[9],     pw2[2] = PKW(P1, 4), pw2[3] = PKW(P1, 6), pw2); \
    VRD(3); SBAR(); GAPA(C0 = __builtin_amdgcn_mfma_f32_32x32x16_bf16(kf[6], qr[3], C0, 0, 0, 0),   P1[10], P1[11], P1[12], P1[13], pw3[0] = PKW(P1, 8), pw3[1] = PKW(P1, 10), pw3); \
    VRD(7); SBAR(); GAPA(C1 = __builtin_amdgcn_mfma_f32_32x32x16_bf16(kf[7], qr[3], C1, 0, 0, 0),   P1[14], P1[15], 0.f, 0.f,       pw3[2] = PKW(P1, 12), pw3[3] = PKW(P1, 14), pw3); \
    l_reg += sacc; \
    if (GK) { DMA_K((t) + 3, sl_cur); } if (GV) { DMA_V((t) + 1, sl_next); } \
    { float a = MX3(C0[0], C0[1], C1[0]), b = MX3(C0[2], C0[3], C1[1]); a = MX3(a, C1[2], C1[3]); \
      _Pragma("unroll") for (int r = 4; r < 16; r += 4) { a = MX3(a, C0[r], C0[r + 1]); b = MX3(b, C0[r + 2], C0[r + 3]); a = MX3(a, C1[r], C1[r + 1]); b = MX3(b, C1[r + 2], C1[r + 3]); } \
      float rm = __builtin_fmaxf(a, b); { auto rr = __builtin_amdgcn_permlane32_swap(__float_as_uint(rm), __float_as_uint(rm), false, false); rm = __builtin_fmaxf(__uint_as_float(rr[0]), __uint_as_float(rr[1])); } \
      resc = false; \
      if (__builtin_expect(__any(rm > (float)THRL), 0)) { const float dl = __builtin_fmaxf(rm, 0.f); mhat += dl; \
        _Pragma("unroll") for (int r = 0; r < 16; ++r) { C0[r] -= dl; C1[r] -= dl; } \
        _Pragma("unroll") for (int r = 0; r < 16; ++r) negm[r] = -mhat; asm volatile("" : "+v"(negm)); \
        const float f = __builtin_amdgcn_exp2f(-dl); l_reg *= f; if (hi == 0) wsf[r32] = f; resc = true; } } \
    SBAR(); \
    GAPB(o[0] = __builtin_amdgcn_mfma_f32_32x32x16_bf16(PAF(0), VFR(0), o[0], 0, 0, 0), C0, 0); \
    GAPB(o[1] = __builtin_amdgcn_mfma_f32_32x32x16_bf16(PAF(0), VFR(4), o[1], 0, 0, 0), C0, 4); \
    KRD(GL, 0); GAPB(o[0] = __builtin_amdgcn_mfma_f32_32x32x16_bf16(PAF(1), VFR(1), o[0], 0, 0, 0), C0, 8); \
    KRD(GL, 1); GAPB(o[1] = __builtin_amdgcn_mfma_f32_32x32x16_bf16(PAF(1), VFR(5), o[1], 0, 0, 0), C0, 12); \
    KRD(GL, 2); GAPB(o[0] = __builtin_amdgcn_mfma_f32_32x32x16_bf16(PAF(2), VFR(2), o[0], 0, 0, 0), C1, 0); \
    KRD(GL, 3); GAPB(o[1] = __builtin_amdgcn_mfma_f32_32x32x16_bf16(PAF(2), VFR(6), o[1], 0, 0, 0), C1, 4); \
    GAPB(o[0] = __builtin_amdgcn_mfma_f32_32x32x16_bf16(PAF(3), VFR(3), o[0], 0, 0, 0), C1, 8); \
    GAPB(o[1] = __builtin_amdgcn_mfma_f32_32x32x16_bf16(PAF(3), VFR(7), o[1], 0, 0, 0), C1, 12); \
    } while (0)
    int t = 1;
    for (; t + 5 < NT; t += 2) {
        STEP(pB0, pB1, pA0, pA1, t, true, true, true);     WAIT_BAR(2); RESC(); ROT();
        STEP(pA0, pA1, pB0, pB1, t + 1, true, true, true); WAIT_BAR(2); RESC(); ROT();
    }
#define ENDW(tt) do { if ((tt) + 3 < NT) { WAIT_BAR(2); } else if ((tt) + 2 < NT) { WAIT_BAR(1); } else { WAIT_BAR(0); } } while (0)
    for (; t + 1 < NT; t += 2) {
        STEP(pB0, pB1, pA0, pA1, t, (t + 3 < NT), (t + 1 < NT), (t + 1 < NT));         ENDW(t);     RESC(); ROT();
        STEP(pA0, pA1, pB0, pB1, t + 1, (t + 4 < NT), (t + 2 < NT), (t + 2 < NT));     ENDW(t + 1); RESC(); ROT();
    }
    STEP(pB0, pB1, pA0, pA1, NT - 1, false, false, false); RESC();
    { float sacc = pB0[0] + pB0[1]; _Pragma("unroll") for (int r = 2; r < 16; ++r) sacc += pB0[r]; _Pragma("unroll") for (int r = 0; r < 16; ++r) sacc += pB1[r]; l_reg += sacc;
      pw0 = (u32x4){PKW(pB0, 0), PKW(pB0, 2), PKW(pB0, 4), PKW(pB0, 6)}; pw1 = (u32x4){PKW(pB0, 8), PKW(pB0, 10), PKW(pB0, 12), PKW(pB0, 14)}; pw2 = (u32x4){PKW(pB1, 0), PKW(pB1, 2), PKW(pB1, 4), PKW(pB1, 6)}; pw3 = (u32x4){PKW(pB1, 8), PKW(pB1, 10), PKW(pB1, 12), PKW(pB1, 14)};
      SBAR(); pv(o, vb0 + sl_cur, PAF(0), PAF(1), PAF(2), PAF(3)); }
#undef PKW
#undef PAF
#undef VFR
#undef PIN
#undef MX3
#undef GAPA
#undef GAPB
#undef EX
#undef VRD
#undef KRD
#undef STEP
#undef ENDW
    { auto rr = __builtin_amdgcn_permlane32_swap(__float_as_uint(l_reg), __float_as_uint(l_reg), false, false); l_reg = __uint_as_float(rr[0]) + __uint_as_float(rr[1]); }
    if (hi == 0) wsf[32 + r32] = l_reg; asm volatile("s_waitcnt lgkmcnt(0)" ::: "memory");
    float rli[16];
#pragma unroll
    for (int r = 0; r < 16; ++r) rli[r] = __builtin_amdgcn_rcpf(wsf[32 + crow(r, hi)]);
    bf16_t* Ow = Ou + (long)(wid * QBLK) * TP;
    { bf16_t* stg = (bf16_t*)(shm + LDS_OST) + wid * 2048;
#pragma unroll
      for (int r = 0; r < 16; ++r) { const int orow = crow(r, hi);
#pragma unroll
        for (int d0 = 0; d0 < 2; ++d0) stg[orow * 64 + d0 * 32 + r32] = (bf16_t)f2bf(o[d0][r] * rli[r]); }
      asm volatile("s_waitcnt lgkmcnt(0)" ::: "memory");
#pragma unroll
      for (int i = 0; i < 4; ++i) { const int row = i * 8 + (lane >> 3), ch = lane & 7; const u32x4 v = *(const u32x4*)(stg + row * 64 + ch * 8); *(u32x4*)(Ow + (long)row * TP + ch * 8) = v; } }
    asm volatile("s_waitcnt lgkmcnt(0)\n\ts_barrier" ::: "memory");
#undef DMA_K
#undef DMA_V
#undef START
#undef RESC
#undef ROT
}
#undef SBAR
#undef WAIT_BAR
}
constexpr int NA_KL = 0, NA_VL = 45056, NA_KC = 94720, NA_VC = 111104, NA_RPB = 128000;
constexpr int NA_VLP = 1552, NA_VCP = 528;
__device__ __forceinline__ int na_vslot(int dim) { return 16 * ((dim >> 2) & 1) + 4 * (dim >> 3) + (dim & 3); }
__device__ __forceinline__ int na_kaddr(int key, int c) { return key * 64 + ((c ^ ((key >> 2) & 3)) << 4); }
__device__ __forceinline__ void na_task(int b, int r, int ct, int h, int kr0, const bf16x8 qf, bf16_t* OB, const LAS unsigned char* L, int lane) {
    const int qi = lane & 15, g = lane >> 4;
    const int c0 = ct * 16; const int kc0 = min(max(c0 - 8, 0), 32);
    const int r_start = min(max(r - 4, 0), 24);
    const int krl = r_start - kr0;
    const size_t qrow = (size_t)b * 2048 + r * 64 + c0 + qi;
    const f32x4 z4 = {0.f, 0.f, 0.f, 0.f};
    f32x4 o0 = z4, o1 = z4; float m1, l1;
    {
        f32x4 s[16];
#pragma unroll
        for (int kr = 0; kr < 8; ++kr)
#pragma unroll
            for (int cg = 0; cg < 2; ++cg) {
                const int key = (krl + kr) * 64 + kc0 + 16 * cg + qi;
                const bf16x8 kf = *(const LAS bf16x8*)(L + NA_KL + na_kaddr(key, g));
                s[kr * 2 + cg] = __builtin_amdgcn_mfma_f32_16x16x32_bf16(kf, qf, z4, 0, 0, 0);
            }
        const int qc = c0 + qi; const int cs = min(max(qc - 8, 0), 48);
        const LAS float* rp = (const LAS float*)(L + NA_RPB) + 16;
        const int w = cs - kc0;
        bool in0[4]; int dsel[4]; const int d0 = kc0 + 4 * g - qc + 15;
#pragma unroll
        for (int e = 0; e < 4; ++e) { in0[e] = (4 * g + e) >= w; dsel[e] = d0 + e + (in0[e] ? 0 : 16); }
        float v[8][4];
        float mx = -INFINITY;
#pragma unroll
        for (int kr = 0; kr < 8; ++kr) {
            const LAS float* rpr = rp + (r_start + kr - r + 7) * 31;
#pragma unroll
            for (int e = 0; e < 4; ++e) { const float sv = (in0[e] ? s[kr * 2][e] : s[kr * 2 + 1][e]) + rpr[dsel[e]]; v[kr][e] = sv; mx = fmaxf(mx, sv); }
        }
        mx = fmaxf(mx, __shfl_xor(mx, 16)); mx = fmaxf(mx, __shfl_xor(mx, 32));
        float l = 0.f;
        const LAS unsigned char* vl0 = L + NA_VL + qi * NA_VLP + (krl * 64 + kc0 + 4 * g) * 2;
#pragma unroll
        for (int ks = 0; ks < 8; ++ks) {
            f32x4 a, c;
#pragma unroll
            for (int e = 0; e < 4; ++e) { const float pe = __builtin_amdgcn_exp2f(v[ks][e] - mx); l += pe; a[e] = in0[e] ? pe : 0.f; c[e] = in0[e] ? 0.f : pe; }
            const bf16x8 pfr = __builtin_bit_cast(bf16x8, pack8(a, c));
            const u32x2 a0 = *(const LAS u32x2*)(vl0 + ks * 128), a1 = *(const LAS u32x2*)(vl0 + ks * 128 + 32);
            const u32x2 b0 = *(const LAS u32x2*)(vl0 + 16 * NA_VLP + ks * 128), b1 = *(const LAS u32x2*)(vl0 + 16 * NA_VLP + ks * 128 + 32);
            o0 = __builtin_amdgcn_mfma_f32_16x16x32_bf16(__builtin_bit_cast(bf16x8, (u32x4){a0.x, a0.y, a1.x, a1.y}), pfr, o0, 0, 0, 0);
            o1 = __builtin_amdgcn_mfma_f32_16x16x32_bf16(__builtin_bit_cast(bf16x8, (u32x4){b0.x, b0.y, b1.x, b1.y}), pfr, o1, 0, 0, 0);
        }
        m1 = mx; l1 = l;
    }
    float l;
    {
        f32x4 s[16];
#pragma unroll
        for (int tc = 0; tc < 16; ++tc) {
            const bf16x8 kf = *(const LAS bf16x8*)(L + NA_KC + na_kaddr(16 * tc + qi, g));
            s[tc] = __builtin_amdgcn_mfma_f32_16x16x32_bf16(kf, qf, z4, 0, 0, 0);
        }
        float mx = m1;
#pragma unroll
        for (int tc = 0; tc < 16; ++tc)
#pragma unroll
            for (int e = 0; e < 4; ++e) mx = fmaxf(mx, s[tc][e]);
        mx = fmaxf(mx, __shfl_xor(mx, 16)); mx = fmaxf(mx, __shfl_xor(mx, 32));
        const float f1 = __builtin_amdgcn_exp2f(m1 - mx);
        o0 = o0 * f1; o1 = o1 * f1; l = l1 * f1;
        const LAS unsigned char* vc0 = L + NA_VC + qi * NA_VCP + (4 * g) * 2;
#pragma unroll
        for (int ks = 0; ks < 8; ++ks) {
            f32x4 a = s[2 * ks], c = s[2 * ks + 1];
#pragma unroll
            for (int e = 0; e < 4; ++e) { a[e] = __builtin_amdgcn_exp2f(a[e] - mx); c[e] = __builtin_amdgcn_exp2f(c[e] - mx); }
            l += (a[0] + a[1]) + (a[2] + a[3]) + (c[0] + c[1]) + (c[2] + c[3]);
            const bf16x8 pfr = __builtin_bit_cast(bf16x8, pack8(a, c));
            const u32x2 a0 = *(const LAS u32x2*)(vc0 + ks * 64), a1 = *(const LAS u32x2*)(vc0 + ks * 64 + 32);
            const u32x2 b0 = *(const LAS u32x2*)(vc0 + 16 * NA_VCP + ks * 64), b1 = *(const LAS u32x2*)(vc0 + 16 * NA_VCP + ks * 64 + 32);
            o0 = __builtin_amdgcn_mfma_f32_16x16x32_bf16(__builtin_bit_cast(bf16x8, (u32x4){a0.x, a0.y, a1.x, a1.y}), pfr, o0, 0, 0, 0);
            o1 = __builtin_amdgcn_mfma_f32_16x16x32_bf16(__builtin_bit_cast(bf16x8, (u32x4){b0.x, b0.y, b1.x, b1.y}), pfr, o1, 0, 0, 0);
        }
    }
    l += __shfl_xor(l, 16); l += __shfl_xor(l, 32);
    const float rl = 1.f / l;
    *(u32x4*)(OB + qrow * 512 + h * 32 + 8 * g) = pack8(o0 * rl, o1 * rl);
}

__device__ __forceinline__ void na_stage_load(u32x4 (&kv)[6], u32x4 (&vv)[6], const bf16_t* NK, const bf16_t* NVT, int b, int h, int kr0, int tid) {
#pragma unroll
    for (int j = 0; j < 6; ++j) { const int pid = tid + 512 * j; const int key = pid >> 2, c = pid & 3;
        if (j < 5 || pid < 11 * 64 * 4) kv[j] = *(const u32x4*)(NK + ((size_t)(b * 16 + h) * 2048 + kr0 * 64 + key) * 32 + 8 * c); }
#pragma unroll
    for (int j = 0; j < 6; ++j) { const int pid = tid + 512 * j;
        if (j < 5 || pid < 11 * 256) vv[j] = *(const u32x4*)(NVT + ((size_t)((b * 16 + h) * 32 + kr0 + (pid >> 8)) * 32) * 64 + 8 * (pid & 255)); }
}
__device__ __forceinline__ void na_stage_store(const u32x4 (&kv)[6], const u32x4 (&vv)[6], LAS unsigned char* L, int tid) {
#pragma unroll
    for (int j = 0; j < 6; ++j) { const int pid = tid + 512 * j; const int key = pid >> 2, c = pid & 3;
        if (j < 5 || pid < 11 * 64 * 4) *(LAS u32x4*)(L + NA_KL + na_kaddr(key, c)) = kv[j]; }
#pragma unroll
    for (int j = 0; j < 6; ++j) { const int pid = tid + 512 * j; const int kr = pid >> 8, dim = (pid >> 3) & 31, c8 = pid & 7;
        if (j < 5 || pid < 11 * 256) *(LAS u32x4*)(L + NA_VL + na_vslot(dim) * NA_VLP + (kr * 8 + c8) * 16) = vv[j]; }
}

__device__ __forceinline__ void na_phase(Frame& F, const float* na_rpb, const bf16_t* NQ, bf16_t* OB, const bf16_t* NK, const bf16_t* NKC, const bf16_t* NVT, const bf16_t* NVCT) {
    LAS unsigned char* L = F.lds;
    const int npair = BATCH * 16, per = (npair + F.G - 1) / F.G;
    for (int pi = 0; pi < per; ++pi) {
        const int p = F.vcu * per + pi; if (p >= npair) break;
        const int b = p >> 4, h = p & 15;
        const int tid = F.tid;
        __syncthreads();
        for (int i = tid; i < 16 + 15 * 31 + 48; i += NTHREADS) ((LAS float*)(L + NA_RPB))[i] = (i >= 16 && i < 16 + 15 * 31) ? na_rpb[h * (15 * 31) + i - 16] * LOG2E : 0.f;
        { u32x4 kv[6], vv[6], ck[2], cv[2];
          na_stage_load(kv, vv, NK, NVT, b, h, 0, tid);
#pragma unroll
          for (int j = 0; j < 2; ++j) { const int pid = tid + 512 * j, key = pid >> 2, c = pid & 3; ck[j] = *(const u32x4*)(NKC + ((size_t)b * 256 + key) * 512 + h * 32 + 8 * c); }
#pragma unroll
          for (int j = 0; j < 2; ++j) { const int pid = tid + 512 * j, dim = pid >> 5, c16 = pid & 31; cv[j] = *(const u32x4*)(NVCT + (size_t)(h * 32 + dim) * MCTX + (size_t)b * 256 + 8 * c16); }
          na_stage_store(kv, vv, L, tid);
#pragma unroll
          for (int j = 0; j < 2; ++j) { const int pid = tid + 512 * j, key = pid >> 2, c = pid & 3; *(LAS u32x4*)(L + NA_KC + na_kaddr(key, c)) = ck[j]; }
#pragma unroll
          for (int j = 0; j < 2; ++j) { const int pid = tid + 512 * j, dim = pid >> 5, c16 = pid & 31; *(LAS u32x4*)(L + NA_VC + na_vslot(dim) * NA_VCP + c16 * 16) = cv[j]; } }
        __syncthreads();
#pragma unroll 1
        for (int rq = 0; rq < 8; ++rq) {
            const int kr0 = min(max(4 * rq - 4, 0), 21);
            int t2 = F.tid; asm volatile("" : "+v"(t2));
            u32x4 kv[6];
            const int kr0n = min(max(4 * (rq + 1) - 4, 0), 21);
            const bool restage = rq < 7 && kr0n != kr0;
            if (restage) {
#pragma unroll
                for (int j = 0; j < 6; ++j) { const int pid = t2 + 512 * j; const int key = pid >> 2, c = pid & 3;
                    if (j < 5 || pid < 11 * 64 * 4) kv[j] = *(const u32x4*)(NK + ((size_t)(b * 16 + h) * 2048 + kr0n * 64 + key) * 32 + 8 * c); } }
            const int r_a = 4 * rq + (F.wave >> 2), ct_ = F.wave & 3;
            const bf16x8 qfa = *(const bf16x8*)(NQ + ((size_t)b * 2048 + r_a * 64 + ct_ * 16 + (F.lane & 15)) * 512 + h * 32 + 8 * (F.lane >> 4));
            na_task(b, r_a, ct_, h, kr0, qfa, OB, L, F.lane);
            { const bf16x8 qfb = *(const bf16x8*)(NQ + ((size_t)b * 2048 + (r_a + 2) * 64 + ct_ * 16 + (F.lane & 15)) * 512 + h * 32 + 8 * (F.lane >> 4));
              na_task(b, r_a + 2, ct_, h, kr0, qfb, OB, L, F.lane); }
            __syncthreads();
            if (restage) {
                u32x4 vv[6];
#pragma unroll
                for (int j = 0; j < 6; ++j) { const int pid = t2 + 512 * j;
                    if (j < 5 || pid < 11 * 256) vv[j] = *(const u32x4*)(NVT + ((size_t)((b * 16 + h) * 32 + kr0n + (pid >> 8)) * 32) * 64 + 8 * (pid & 255)); }
                na_stage_store(kv, vv, L, t2); }
            __syncthreads();
        }
    }
    __syncthreads();
}

constexpr int SG_P = 200;
__device__ __forceinline__ void sgu_phase(Frame& F, const bf16_t* VT, const bf16_t* U, bf16_t* OA, const bf16_t* TA, const bf16_t* WS, const bf16_t* WO_T,
                                          const float* ln_g, const float* ln_b, const float* b_s) {
    LAS bf16_t* XS = (LAS bf16_t*)F.lds;
    LAS bf16_t* WM = XS + 128 * SG_P;
    LAS float* red = (LAS float*)(F.lds + 2 * 128 * SG_P * 2);
    LAS float* stat = red + 32 * 128 * 2;
    const int tid = F.tid, lane = F.lane, w = F.wave;
    const int nchunk = MTOK / 128;
    for (int ck = F.vcu; ck < nchunk; ck += F.G) {
        const size_t tok0 = (size_t)ck * 128;
        { const int q8 = tid & 15, cg = tid >> 4; float sm[8], sq[8];
#pragma unroll
          for (int i = 0; i < 8; ++i) { sm[i] = 0.f; sq[i] = 0.f; }
#pragma unroll 1
          for (int j0 = 0; j0 < 32; j0 += 8) { u32x4 raw[8];
#pragma unroll
              for (int j = 0; j < 8; ++j) raw[j] = *(const u32x4*)(VT + (size_t)ck * (1024 * 128) + (size_t)(cg + 32 * (j0 + j)) * 128 + 8 * q8);
#pragma unroll
              for (int j = 0; j < 8; ++j) { f32x4 a, c; unpack8(raw[j], a, c);
#pragma unroll
                  for (int i = 0; i < 4; ++i) { sm[i] += a[i]; sq[i] += a[i] * a[i]; sm[4 + i] += c[i]; sq[4 + i] += c[i] * c[i]; } } }
#pragma unroll
          for (int i = 0; i < 8; ++i) { red[(cg * 128 + q8 * 8 + i) * 2] = sm[i]; red[(cg * 128 + q8 * 8 + i) * 2 + 1] = sq[i]; }
          __syncthreads();
          if (tid < 128) { float s = 0.f, q = 0.f; for (int j = 0; j < 32; ++j) { s += red[(j * 128 + tid) * 2]; q += red[(j * 128 + tid) * 2 + 1]; }
              const float mean = s * (1.f / 1024.f), var = fmaxf(q * (1.f / 1024.f) - mean * mean, 0.f); stat[tid * 2] = mean; stat[tid * 2 + 1] = 1.f / sqrtf(var + NORM_EPS); }
#pragma unroll
          for (int j = 0; j < 2; ++j) { const int pid = tid + 512 * j, p = pid >> 3, c8 = pid & 7; *(LAS u32x4*)(XS + p * SG_P + 128 + 8 * c8) = *(const u32x4*)(TA + (tok0 + p) * 64 + 8 * c8); }
          __syncthreads(); }
        u32x4 rw[4], rv[4], ro[2];
#define SGU_LOADS(G_) do { \
            _Pragma("unroll") for (int j = 0; j < 4; ++j) { const int pid = tid + 512 * j, p = pid >> 4, q8 = pid & 15; rw[j] = *(const u32x4*)(WS + ((size_t)(G_) * 128 + p) * 128 + 8 * q8); } \
            _Pragma("unroll") for (int j = 0; j < 4; ++j) { const int pid = tid + 512 * j, c = pid >> 4, q8 = pid & 15; rv[j] = *(const u32x4*)(VT + (size_t)ck * (1024 * 128) + (size_t)((G_) * 128 + c) * 128 + 8 * q8); } \
            _Pragma("unroll") for (int j = 0; j < 2; ++j) { const int pid = tid + 512 * j, c = pid >> 3, c8 = pid & 7; ro[j] = *(const u32x4*)(WO_T + ((size_t)(G_) * 128 + c) * 64 + 8 * c8); } } while (0)
        SGU_LOADS(0);
#pragma unroll 1
        for (int g = 0; g < 8; ++g) {
#pragma unroll
            for (int j = 0; j < 4; ++j) { const int pid = tid + 512 * j, p = pid >> 4, q8 = pid & 15; *(LAS u32x4*)(XS + p * SG_P + 8 * q8) = rw[j]; }
#pragma unroll
            for (int j = 0; j < 4; ++j) { const int pid = tid + 512 * j, c = pid >> 4, q8 = pid & 15; const int ch = g * 128 + c;
                f32x4 a, d; unpack8(rv[j], a, d);
                const float lg = ln_g[ch], lb = ln_b[ch];
#pragma unroll
                for (int i = 0; i < 4; ++i) { a[i] = (a[i] - stat[(8 * q8 + i) * 2]) * stat[(8 * q8 + i) * 2 + 1] * lg + lb; d[i] = (d[i] - stat[(8 * q8 + 4 + i) * 2]) * stat[(8 * q8 + 4 + i) * 2 + 1] * lg + lb; }
                *(LAS u32x4*)(WM + c * SG_P + 8 * q8) = pack8(a, d); }
#pragma unroll
            for (int j = 0; j < 2; ++j) { const int pid = tid + 512 * j, c = pid >> 3, c8 = pid & 7; *(LAS u32x4*)(WM + c * SG_P + 128 + 8 * c8) = ro[j]; }
            __syncthreads();
            const int fr = lane & 15, fq = lane >> 4;
            u32x4 uw[2][2]; float bsv[2];
#pragma unroll
            for (int mi = 0; mi < 2; ++mi) { const int p = 32 * (w >> 1) + 16 * mi + fr; bsv[mi] = b_s[g * 128 + p];
#pragma unroll
                for (int np = 0; np < 2; ++np) uw[mi][np] = *(const u32x4*)(U + (tok0 + p) * 1024 + g * 128 + 64 * (w & 1) + 32 * np + 8 * fq); }
            if (g < 7) SGU_LOADS(g + 1);
            f32x4 acc[2][4];
#pragma unroll
            for (int mi = 0; mi < 2; ++mi)
#pragma unroll
                for (int ni = 0; ni < 4; ++ni) acc[mi][ni] = (f32x4){0.f, 0.f, 0.f, 0.f};
#pragma unroll
            for (int kk = 0; kk < 6; ++kk) {
                bf16x8 xf[2], wf[4];
#pragma unroll
                for (int mi = 0; mi < 2; ++mi) xf[mi] = *(const LAS bf16x8*)(XS + (32 * (w >> 1) + 16 * mi + fr) * SG_P + 32 * kk + 8 * fq);
#pragma unroll
                for (int ni = 0; ni < 4; ++ni) wf[ni] = *(const LAS bf16x8*)(WM + (64 * (w & 1) + 32 * (ni >> 1) + pg8::perm32(16 * (ni & 1) + fr)) * SG_P + 32 * kk + 8 * fq);
#pragma unroll
                for (int mi = 0; mi < 2; ++mi)
#pragma unroll
                    for (int ni = 0; ni < 4; ++ni) acc[mi][ni] = __builtin_amdgcn_mfma_f32_16x16x32_bf16(wf[ni], xf[mi], acc[mi][ni], 0, 0, 0);
            }
#pragma unroll
            for (int mi = 0; mi < 2; ++mi) { const int p = 32 * (w >> 1) + 16 * mi + fr; const float bs = bsv[mi];
#pragma unroll
                for (int np = 0; np < 2; ++np) { const size_t uo = (tok0 + p) * 1024 + g * 128 + 64 * (w & 1) + 32 * np + 8 * fq;
                    f32x4 u0, u1; unpack8(uw[mi][np], u0, u1); u0 = gelu4(u0); u1 = gelu4(u1);
                    *(u32x4*)(OA + uo) = pack8(u0 * (acc[mi][2 * np] + bs), u1 * (acc[mi][2 * np + 1] + bs)); } }
            __syncthreads();
        }
#undef SGU_LOADS
    }
}

constexpr int RT_WP = 264;
__device__ __forceinline__ void router_phase(Frame& F, const bf16_t* xmid, const float* mod, const float* gn, const float* b_router, const bf16_t* WRH, const bf16_t* WRL, const float* w_router,
                                             bf16_t* H2, int* list_crow, float* list_w, unsigned* gcount, bool dry, const float* ssqp) {
    LAS float* t_g = (LAS float*)F.lds;
    LAS float* t_s = t_g + 1024;
    LAS float* br = t_s + 1024;
    LAS float* cvec = br + 64;
    LAS unsigned* lcnt = (LAS unsigned*)(cvec + 64);
    LAS unsigned* lbase = lcnt + 64;
    LAS bf16_t* WH = (LAS bf16_t*)(lbase + 64);
    LAS bf16_t* WL = WH + 64 * RT_WP;
    const int tid = F.tid, lane = F.lane;
    const int fr = lane & 15, fq = lane >> 4;
    for (int blk = F.vcu; blk < MTOK / 256; blk += F.G) {
        const int b = blk >> 3, grp = blk < GSPLIT / 256 ? 0 : 1;
        const float* mb = mod + (size_t)b * 6144;
        __syncthreads();
        for (int i = tid; i < 1024; i += NTHREADS) { t_g[i] = gn[i] * (1.f + mb[4 * 1024 + i]); t_s[i] = mb[3 * 1024 + i]; }
        if (tid < 64) { br[tid] = b_router[tid]; lcnt[tid] = 0u; }
        __syncthreads();
        { const int e = tid >> 3, part = tid & 7; float a = 0.f;
#pragma unroll 8
          for (int k = part * 128; k < part * 128 + 128; ++k) a += t_s[k] * w_router[(size_t)k * 64 + e];
          a += __shfl_xor(a, 1); a += __shfl_xor(a, 2); a += __shfl_xor(a, 4);
          if (part == 0) cvec[e] = a; }
        const int tokw = blk * 256 + F.wave * 32;
        f32x4 acc[2][4]; float rinv[2];
#pragma unroll
        for (int it = 0; it < 2; ++it) {
            const f32x4* sp = (const f32x4*)(ssqp + (size_t)(tokw + 16 * it + fr) * 16); const f32x4 a = (sp[0] + sp[1]) + (sp[2] + sp[3]);
            rinv[it] = 1.f / sqrtf(((a.x + a.y) + (a.z + a.w)) * (1.f / DM) + NORM_EPS);
#pragma unroll
            for (int j = 0; j < 4; ++j) acc[it][j] = (f32x4){0.f, 0.f, 0.f, 0.f}; }
#pragma unroll 1
        for (int kc = 0; kc < 4; ++kc) {
            __syncthreads();
#pragma unroll
            for (int j = 0; j < 4; ++j) { const int pid = tid + 512 * j, e = pid >> 5, c = pid & 31;
                *(LAS u32x4*)(WH + e * RT_WP + 8 * c) = *(const u32x4*)(WRH + (size_t)e * DM + kc * 256 + 8 * c);
                *(LAS u32x4*)(WL + e * RT_WP + 8 * c) = *(const u32x4*)(WRL + (size_t)e * DM + kc * 256 + 8 * c); }
            __syncthreads();
#pragma unroll
            for (int it = 0; it < 2; ++it) {
                const bf16_t* xrow = xmid + (size_t)(tokw + 16 * it + fr) * DM + kc * 256 + 16 * fq;
                unsigned char* hrow = (unsigned char*)H2 + (size_t)(tokw + 16 * it + fr) * DM + kc * 256 + 16 * fq;
                u32x4 xr[8];
#pragma unroll
                for (int s = 0; s < 8; ++s) xr[s] = *(const u32x4*)(xrow + 64 * (s >> 1) + 8 * (s & 1));
#pragma unroll
                for (int s = 0; s < 8; ++s) {
                    const int kl = 64 * (s >> 1) + 16 * fq + 8 * (s & 1);
                    f32x4 x0, x1; unpack8(xr[s], x0, x1);
                    const f32x4 g0 = *(const LAS f32x4*)(t_g + kc * 256 + kl), g1 = *(const LAS f32x4*)(t_g + kc * 256 + kl + 4);
                    const f32x4 h0 = x0 * g0, h1 = x1 * g1;
                    const u32x4 hi = pack8(h0, h1);
                    f32x4 f0, f1; unpack8(hi, f0, f1);
                    const u32x4 lo = pack8(h0 - f0, h1 - f1);
                    const bf16x8 xh = __builtin_bit_cast(bf16x8, hi), xl = __builtin_bit_cast(bf16x8, lo);
#pragma unroll
                    for (int j = 0; j < 4; ++j) {
                        const bf16x8 wh = *(const LAS bf16x8*)(WH + (16 * j + fr) * RT_WP + kl), wl = *(const LAS bf16x8*)(WL + (16 * j + fr) * RT_WP + kl);
                        acc[it][j] = __builtin_amdgcn_mfma_f32_16x16x32_bf16(wh, xh, acc[it][j], 0, 0, 0);
                        acc[it][j] = __builtin_amdgcn_mfma_f32_16x16x32_bf16(wh, xl, acc[it][j], 0, 0, 0);
                        acc[it][j] = __builtin_amdgcn_mfma_f32_16x16x32_bf16(wl, xh, acc[it][j], 0, 0, 0);
                    }
                    const f32x4 s0 = *(const LAS f32x4*)(t_s + kc * 256 + kl), s1 = *(const LAS f32x4*)(t_s + kc * 256 + kl + 4);
                    *(u32x2*)(hrow + 64 * (s >> 1) + 8 * (s & 1)) = (u32x2){pk4_fp8(h0 * rinv[it] + s0), pk4_fp8(h1 * rinv[it] + s1)};
                }
            }
        }
        int sel_e[2][8]; float sel_w[2][8]; unsigned sel_p[2][8];
#pragma unroll
        for (int it = 0; it < 2; ++it) {
            float scv[16], selv[16];
#pragma unroll
            for (int j = 0; j < 4; ++j)
#pragma unroll
                for (int e = 0; e < 4; ++e) { const int ex = 16 * j + 4 * fq + e; const float lg = rinv[it] * acc[it][j][e] + cvec[ex]; const float sg = 1.f / (1.f + __expf(-lg)); scv[4 * j + e] = sg; selv[4 * j + e] = sg + br[ex]; }
            float ssum = 0.f;
#pragma unroll
            for (int kk = 0; kk < 8; ++kk) {
                float bv = -INFINITY, bs = 0.f; int be = 0;
#pragma unroll
                for (int p = 0; p < 16; ++p) { const int ex = 16 * (p >> 2) + 4 * fq + (p & 3); const bool t = selv[p] > bv; bv = t ? selv[p] : bv; bs = t ? scv[p] : bs; be = t ? ex : be; }
#pragma unroll
                for (int o = 16; o <= 32; o <<= 1) { const float ov = __shfl_xor(bv, o), os = __shfl_xor(bs, o); const int oe = __shfl_xor(be, o);
                    const bool t = (ov > bv) || (ov == bv && oe < be); bv = t ? ov : bv; bs = t ? os : bs; be = t ? oe : be; }
#pragma unroll
                for (int p = 0; p < 16; ++p) { const int ex = 16 * (p >> 2) + 4 * fq + (p & 3); selv[p] = (ex == be) ? -INFINITY : selv[p]; }
                sel_e[it][kk] = be; sel_w[it][kk] = bs; ssum += bs;
            }
            const float inv = 2.5f / ssum;
#pragma unroll
            for (int kk = 0; kk < 8; ++kk) sel_w[it][kk] *= inv;
            if (lane < 16) {
#pragma unroll
                for (int kk = 0; kk < 8; ++kk) sel_p[it][kk] = atomicAdd((unsigned*)&lcnt[sel_e[it][kk]], 1u);
            }
        }
        __syncthreads();
        if (tid < 64 && !dry) lbase[tid] = atomicAdd(&gcount[grp * 64 + tid], lcnt[tid]);
        __syncthreads();
        if (lane < 16 && !dry) {
#pragma unroll
            for (int it = 0; it < 2; ++it) {
                const int tok = tokw + it * 16 + lane; const int tl = tok - gbase(grp);
#pragma unroll
                for (int kk = 0; kk < 8; ++kk) { const int e = sel_e[it][kk]; const size_t pos = (size_t)(grp * 64 + e) * GCAP + lbase[e] + sel_p[it][kk];
                    list_crow[pos] = tl * 9 + kk; list_w[pos] = sel_w[it][kk]; }
            }
        }
    }
    __syncthreads();
}

constexpr int FIN_EXTRA = 34;
__device__ __forceinline__ void final_phase(Frame& F, int grp, const unsigned char* C, const bf16_t* xmid, const float* mod, const float* fg, float* out, int gemm_units) {
    const int lane = F.lane, n = gsize(grp), G = F.G, c = F.vcu;
    const int r = gemm_units > 0 ? gemm_units % G : 0, nlight = (gemm_units > 0 && r != 0) ? G - r : 0;
    const int E = (nlight > 0 && FIN_EXTRA * nlight * 2 < n) ? FIN_EXTRA : 0;
    const int rest = n - E * nlight, base = rest / G, rem = rest - base * G;
    const int t0 = c * base + min(c, rem) + ((nlight > 0 && c > r) ? (c - r) * E : 0);
    const int cnt = base + (c < rem ? 1 : 0) + ((nlight > 0 && c >= r) ? E : 0);
    for (int tl = t0 + F.wave; tl < t0 + cnt; tl += NWAVES) {
        const int tok = gbase(grp) + tl, b = tok >> 11;
        const float* gf = mod + (size_t)b * 6144 + 5 * 1024 + 16 * lane;
        const unsigned char* tp = C + (size_t)tl * CROW_BYTES;
        u32x4 c8[9];
#pragma unroll
        for (int k = 0; k < 9; ++k) c8[k] = *(const u32x4*)(tp + k * 1024 + 16 * lane);
        const u32x4 xa = *(const u32x4*)(xmid + (size_t)tok * DM + 16 * lane), xb = *(const u32x4*)(xmid + (size_t)tok * DM + 16 * lane + 8);
        f32x4 y[4], xv[4];
#pragma unroll
        for (int j = 0; j < 4; ++j) y[j] = (f32x4){0.f, 0.f, 0.f, 0.f};
        unpack8(xa, xv[0], xv[1]); unpack8(xb, xv[2], xv[3]);
#pragma unroll
        for (int k = 0; k < 9; ++k)
#pragma unroll
            for (int j = 0; j < 4; ++j) { const int d = (int)c8[k][j]; const auto lo = __builtin_amdgcn_cvt_pk_f32_fp8(d, false), hi = __builtin_amdgcn_cvt_pk_f32_fp8(d, true);
                y[j] += (f32x4){lo[0], lo[1], hi[0], hi[1]}; }
        f32x4 v[4]; float s = 0.f;
#pragma unroll
        for (int j = 0; j < 4; ++j) { v[j] = xv[j] + ((const f32x4*)gf)[j] * y[j]; s += (v[j].x * v[j].x + v[j].y * v[j].y) + (v[j].z * v[j].z + v[j].w * v[j].w); }
        const float r = 1.f / sqrtf(wave_sum_l(s, lane) * (1.f / DM) + NORM_EPS);
        f32x4* orow = (f32x4*)(out + (size_t)tok * DM + 16 * lane);
#pragma unroll
        for (int j = 0; j < 4; ++j) orow[j] = v[j] * r * ((const f32x4*)(fg + 16 * lane))[j];
    }
}
struct Args { const float* in[28]; float* out; unsigned char* ws; int stage, pad1; };

__device__ __forceinline__ int tq_src_col(int j) { const int axis = j >> 5, p = j & 31; return axis * 32 + (p & 1) * 16 + (p >> 1); }
__device__ __forceinline__ int main_src_col(int c) {
    if (c < 1024) return COL_U + c;
    if (c < 2048) return COL_GA + (c - 1024);
    if (c < 3072) return COL_GB + (c - 2048);
    if (c < 3584) return COL_NQ + (c - 3072);
    if (c < 4096) return COL_NK + (c - 3584);
    const int j = c - 4096;
    if (j < 64) return COL_TQ + tq_src_col(j);
    if (j < 128) return COL_TK + tq_src_col(j - 64);
    if (j < 192) return COL_TV + (j - 128);
    return -1;
}
typedef const __attribute__((address_space(4))) Args* KArgs0;
__device__ __forceinline__ void p0_elementwise(Frame& F, KArgs0 ap) {
    unsigned char* ws = ap->ws;
    const size_t gt = (size_t)F.vcu * NTHREADS + F.tid, NT_ = (size_t)F.G * NTHREADS;
    const float* w_in = ap->in[8]; const float* b_in = ap->in[9];
    float* rope = (float*)(ws + WS_ROPE);
    for (size_t i = gt; i < 2 * 64 * 16; i += NT_) { const int f = (int)(i & 15), pos = (int)((i >> 4) & 63); const float inv = powf(10000.f, -(float)f / 16.f); const float ang = (float)pos * inv; rope[2 * i] = cosf(ang); rope[2 * i + 1] = sinf(ang); }
    float* bin = (float*)(ws + WS_BIN); float* bt = (float*)(ws + WS_BT);
    for (size_t i = gt; i < 4352; i += NT_) { const int sc = main_src_col((int)i); bin[i] = sc >= 0 ? b_in[sc] : 0.f; }
    for (size_t i = gt; i < 1536; i += NT_) bt[i] = i < 1024 ? b_in[COL_V + i] : b_in[COL_NV + (i - 1024)];
    bf16_t* win = (bf16_t*)(ws + WS_WIN);
    for (size_t i = gt; i < (size_t)64 * 1024; i += NT_) win[(size_t)(4096 + 192) * 1024 + i] = 0;
    bf16_t* wrh = (bf16_t*)(ws + WS_WRH); bf16_t* wrl = (bf16_t*)(ws + WS_WRL); const float* w_router = ap->in[19];
    for (size_t i = gt; i < (size_t)64 * 1024; i += NT_) { const int e = (int)(i >> 10), k = (int)(i & 1023); const float v = w_router[(size_t)k * 64 + e]; const unsigned h = f2bf(v); wrh[i] = (bf16_t)h; wrl[i] = (bf16_t)f2bf(v - bf2f((unsigned short)h)); }
    bf16_t* wsb = (bf16_t*)(ws + WS_WS); const float* w_s = ap->in[12];
    for (size_t i = gt; i < (size_t)8 * 128 * 128; i += NT_) wsb[i] = (bf16_t)f2bf(w_s[i]);
}

__device__ __forceinline__ void p0_weights(Frame& F, KArgs0 ap) {
    unsigned char* ws = ap->ws;
    LAS float* scr = (LAS float*)(F.lds + F.wave * 16384);
    const int gw = F.vcu * NWAVES + F.wave, NGW = F.G * NWAVES;
    const float* w_in = ap->in[8];
    bf16_t* win = (bf16_t*)(ws + WS_WIN); bf16_t* wt = (bf16_t*)(ws + WS_WT);
    auto get_job = [&](int j) -> TrJob {
        switch (j) {
        case 0: return TrJob{w_in, win, IN_W, 1024, 1024, COL_U, 0, 1, 0, 0, 0, 0, 0, ws + WS_WIN8};
        case 1: return TrJob{w_in, win, IN_W, 1024, 1024, COL_GA, 1024, 1, 0, 0, 0, 0, 0, ws + WS_WIN8};
        case 2: return TrJob{w_in, win, IN_W, 1024, 1024, COL_GB, 2048, 1, 0, 0, 0, 0, 0, ws + WS_WIN8};
        case 3: return TrJob{w_in, win, IN_W, 1024, 512, COL_NQ, 3072, 1, 0, 0, 0, 0, 0, ws + WS_WIN8};
        case 4: return TrJob{w_in, win, IN_W, 1024, 512, COL_NK, 3584, 1, 0, 0, 0, 0, 0, ws + WS_WIN8};
        case 5: return TrJob{w_in, win, IN_W, 1024, 64, COL_TV, 4096 + 128, 1, 0, 0, 0};
        case 6: return TrJob{w_in, wt, IN_W, 1024, 1024, COL_V, 0, 1, 0, 0, 0, 0, 0, ws + WS_WT8};
        case 7: return TrJob{w_in, wt, IN_W, 1024, 512, COL_NV, 1024, 1, 0, 0, 0, 0, 0, ws + WS_WT8};
        case 8: return TrJob{ap->in[16], (bf16_t*)(ws + WS_WUPA) + 512, 1024, 1024, 1024, 0, 0, 1, 0, 0, 0, 1536};
        case 9: return TrJob{ap->in[17], (bf16_t*)(ws + WS_WUPA), 1024, 512, 1024, 0, 0, 1, 0, 0, 0, 1536};
        case 10: return TrJob{ap->in[18], (bf16_t*)(ws + WS_WOUT), 1024, 1024, 1024, 0, 0, 1, 0, 0, 0};
        case 11: return TrJob{ap->in[14], (bf16_t*)(ws + WS_WO), 1024, 64, 1024, 0, 0, 1, 0, 0, 0};
        case 12: return TrJob{ap->in[21], (bf16_t*)(ws + WS_WGU), 256, 1024, 256, 0, 0, 64, 1, (size_t)1024 * 256, (size_t)512 * 512, 1024, 1};
        case 13: return TrJob{ap->in[22], (bf16_t*)(ws + WS_WGU), 256, 1024, 256, 0, 0, 64, 2, (size_t)1024 * 256, (size_t)512 * 512, 1024, 1};
        case 14: return TrJob{ap->in[23], (bf16_t*)(ws + WS_WD), 1024, 256, 1024, 0, 0, 64, 0, (size_t)256 * 1024, (size_t)1024 * 128, 256, 1};
        case 15: return TrJob{ap->in[24], (bf16_t*)(ws + WS_WGU) + (size_t)64 * 512 * 512, 256, 1024, 256, 0, 0, 1, 1, 0, 0, 1024, 1};
        case 16: return TrJob{ap->in[25], (bf16_t*)(ws + WS_WGU) + (size_t)64 * 512 * 512, 256, 1024, 256, 0, 0, 1, 2, 0, 0, 1024, 1};
        case 17: return TrJob{ap->in[26], (bf16_t*)(ws + WS_WD) + (size_t)64 * 1024 * 128, 1024, 256, 1024, 0, 0, 1, 0, 0, 0, 256, 1};
        case 18: return TrJob{w_in, win, IN_W, 1024, 64, COL_TQ, 4096, 1, 3, 0, 0};
        default: return TrJob{w_in, win, IN_W, 1024, 64, COL_TK, 4096 + 64, 1, 3, 0, 0};
        }
    };
    int total = 0;
#pragma unroll 1
    for (int j = 0; j < 20; ++j) total += trjob_items(get_job(j));
    auto locate = [&](int g) -> TrItem { int j = 0, base = 0;
#pragma unroll 1
        for (;; ++j) { const int n = trjob_items(get_job(j)); if (g < base + n) break; base += n; }
        return trjob_item(get_job(j), g - base); };
    int g = gw;
    if (g < total) {
        float wa[32], wb[32];
        TrItem cur = locate(g); tr_load(cur, wa, F.lane);
#pragma unroll 1
        for (;;) {
            g += NGW; const bool has = g < total; TrItem nxt = cur;
            if (has) { nxt = locate(g); tr_load(nxt, wb, F.lane); }
            tr_store(cur, wa, scr, F.lane);
            if (!has) break;
            cur = nxt;
#pragma unroll
            for (int i = 0; i < 32; ++i) wa[i] = wb[i];
        }
    }
}

typedef const __attribute__((address_space(4))) Args* KArgs;
__device__ __forceinline__ KArgs get_args() { KArgs p = (KArgs)__builtin_amdgcn_kernarg_segment_ptr(); asm volatile("" : "+s"(p)); return p; }
#define WSP(T, off) ((T*)(ws + (off)))

__device__ __forceinline__ int moe_table(Frame& F, int g) {
    volatile LAS unsigned* blk = (volatile LAS unsigned*)(F.lds + MOE_BLK_LDS) + (g & 1) * (MOE_MAXBLK + 130);
    volatile LAS unsigned* pre = blk + MOE_MAXBLK;
    __syncthreads();
    { const unsigned* cnt = F.ctl + CW_GCOUNT + g * 64;
      if (F.tid < 64) {
          const unsigned c = __hip_atomic_load(cnt + F.tid, RLX_AGENT); const unsigned nb = (c + 255u) >> 8; unsigned incl = nb;
#pragma unroll
          for (int d = 1; d < 64; d <<= 1) { const int ln = lane_id_(); const unsigned t = (unsigned)__builtin_amdgcn_ds_bpermute((max(ln - d, 0)) << 2, (int)incl); if (ln >= d) incl += t; }
          pre[F.tid] = incl - nb; pre[66 + F.tid] = c;
          if (F.tid == 63) { pre[64] = incl; pre[65] = incl + (((unsigned)gsize(g) + 255u) >> 8); } }
      __syncthreads(); }
    const int nblk = (int)pre[65];
    for (int j = F.tid; j < nblk; j += NTHREADS) { int lo = 0, hi = 65;
        while (hi - lo > 1) { const int mid = (lo + hi) >> 1; if (pre[mid] <= (unsigned)j) lo = mid; else hi = mid; }
        blk[j] = ((unsigned)lo << 16) | ((unsigned)j - pre[lo]); }
    __syncthreads();
    return nblk;
}
__device__ __forceinline__ void moe_gu_phase(Frame& F, int g) {
    volatile LAS unsigned* blk = (volatile LAS unsigned*)(F.lds + MOE_BLK_LDS) + (g & 1) * (MOE_MAXBLK + 130);
    const int nblk = (int)blk[MOE_MAXBLK + 65];
    unsigned char* ws = get_args()->ws;
    MoeLists L{WSP(int, WS_LCROW) + (size_t)g * 64 * GCAP, WSP(float, WS_LW) + (size_t)g * 64 * GCAP, F.ctl + CW_GCOUNT + g * 64, gsize(g)};
    pg8::Gemm gm{WSP(bf16_t, WS_H), WSP(bf16_t, WS_WGU), 512, (size_t)512 * 1024};
    MoeOrder S{blk, nblk, 2, F.G, F.vcu, L, 1024, gbase(g)};
    EpiMoeGU E{WSP(bf16_t, WS_ACT + (size_t)(g & 1) * ACT_BYTES)};
    pg8::gemm_phase<EpiMoeGU, MoeOrder, true, ALIGN_EPI_, true>(F.lds, gm, S, E);
}
__device__ __forceinline__ void moe_down_phase(Frame& F, int g) {
    volatile LAS unsigned* blk = (volatile LAS unsigned*)(F.lds + MOE_BLK_LDS) + (g & 1) * (MOE_MAXBLK + 130);
    const int nblk = (int)blk[MOE_MAXBLK + 65];
    unsigned char* ws = get_args()->ws;
    MoeLists L{WSP(int, WS_LCROW) + (size_t)g * 64 * GCAP, WSP(float, WS_LW) + (size_t)g * 64 * GCAP, F.ctl + CW_GCOUNT + g * 64, gsize(g)};
    pg8::Gemm gm{WSP(bf16_t, WS_ACT + (size_t)(g & 1) * ACT_BYTES), WSP(bf16_t, WS_WD), 128, (size_t)1024 * 256};
    MoeOrder S{blk, nblk, 4, F.G, F.vcu, L, 2048, gbase(g)};
    EpiMoeDown E{WSP(unsigned char, WS_C), L, F.lds};
    if constexpr ((PROBE_MASK >> 31) & 1) { pg8::DupOrder<MoeOrder> S2{S}; pg8::gemm_phase<EpiMoeDown, pg8::DupOrder<MoeOrder>, false, ALIGN_EPI_>(F.lds, gm, S2, E); }
    else if constexpr ((PROBE_MASK >> 26) & 1) { pg8::SkipOrder<MoeOrder> S3{S}; pg8::gemm_phase<EpiMoeDown, pg8::SkipOrder<MoeOrder>, false, ALIGN_EPI_>(F.lds, gm, S3, E); __syncthreads(); pg8::gemm_phase<EpiMoeDown, MoeOrder, false, ALIGN_EPI_, true>(F.lds, gm, S, E); }
    else pg8::gemm_phase<EpiMoeDown, MoeOrder, false, ALIGN_EPI_, true>(F.lds, gm, S, E);
}

__global__ void __launch_bounds__(NTHREADS, 2) mega_fwd(Args args_unused) {
    extern __shared__ __attribute__((aligned(16))) unsigned char lds[];
    Frame F;
    F.lds = (LAS unsigned char*)lds;
    F.MISC = (volatile LAS unsigned*)(F.lds + MISC_OFF);
    F.tid = threadIdx.x; F.lane = F.tid & 63; F.wave = __builtin_amdgcn_readfirstlane(F.tid >> 6);
    { const unsigned slot = __builtin_amdgcn_s_getreg((5 << 11) | 4) & 63u; if (F.lane == 0) *(volatile LAS unsigned*)(size_t)(WTAB_OFF + 4 * slot) = (unsigned)F.wave; }
    __syncthreads();
    F.G = gridDim.x; { const int bx = blockIdx.x; F.vcu = (F.G % 8 == 0) ? (bx % 8) * (F.G / 8) + bx / 8 : bx; F.cid = bx; }
    { KArgs A = get_args(); F.ctl = (unsigned*)(A->ws + WS_CTL); }
    for (int u = F.tid; u < (LDS_BYTES - LDSCTL_OFF) / 4; u += NTHREADS) ((LAS unsigned*)(F.lds + LDSCTL_OFF))[u] = 0u;
    __syncthreads();
    if (TIDX() == 0) { F.MISC[14] = (unsigned)F.vcu; F.MISC[15] = (unsigned)F.cid; }
    __syncthreads();
    XcdBarrier bar = xcd_barrier_post(F.ctl + CW_BAR, F.MISC + 8);
#define GRID_BAR() xcd_barrier(bar)
    const int stage = get_args()->stage;
#define MISC_PTR() ([&]() -> volatile LAS unsigned* { LAS unsigned* p_ = (LAS unsigned*)(F.lds + MISC_OFF); asm volatile("" : "+s"(p_)); return (volatile LAS unsigned*)p_; }())
#define PHASE_BEGIN() do { F.tid = TIDX(); asm volatile("" : "+v"(F.tid));        F.lane = F.tid & 63; { volatile LAS unsigned* m_ = MISC_PTR(); F.vcu = __builtin_amdgcn_readfirstlane((int)m_[14]); F.cid = __builtin_amdgcn_readfirstlane((int)m_[15]); } } while (0)
      { PHASE_BEGIN(); {
        for (int rep_ = 0; rep_ < (((PROBE_MASK >> 11) & 1) ? 2 : 1); ++rep_) {
        { KArgs A = get_args(); p0_adaln(F, A->in[1], A->in[3], A->in[4], A->in[5], (float*)(A->ws + WS_MOD)); }
        { KArgs A = get_args(); p0_elementwise(F, A); }
        { KArgs A = get_args(); p0_weights(F, A); } __syncthreads(); }
      } } GRID_BAR();
      { if (TIDX() == 0) { unsigned ok = (F.G % 8 == 0) ? 1u : 0u;
          for (unsigned j = 0; j < 16; ++j) { const unsigned c = xb_ld(&bar.bar[XB_XCNT(j)]); if (c != (j < 8 ? (unsigned)F.G / 8u : 0u)) ok = 0u; }
          const unsigned x = F.MISC[12], r = F.MISC[13];
          F.MISC[14] = ok ? x * ((unsigned)F.G / 8u) + r : (unsigned)F.vcu; F.MISC[15] = ok ? r * 8u + x : (unsigned)F.cid; }
        __syncthreads(); }
      if constexpr ((PROBE_MASK >> 24) & 1) { for (int i_ = 0; i_ < 10; ++i_) GRID_BAR(); }
      { PHASE_BEGIN(); {
        KArgs A = get_args(); unsigned char* ws = A->ws; const float* x = A->in[0]; const float* mod = WSP(const float, WS_MOD); const float* gmix = A->in[6];
        bf16_t* H = WSP(bf16_t, WS_H); bf16_t* HC = WSP(bf16_t, WS_HC);
        const int gw = F.vcu * NWAVES + F.wave, NGW = F.G * NWAVES;
        for (int rep_ = 0; rep_ < (((PROBE_MASK >> 12) & 1) ? 2 : 1); ++rep_) {
        for (int c0 = gw * 32; c0 < MTOK; c0 += NGW * 32) { const float* mb = mod + (size_t)(c0 >> 11) * 6144; norm_mod_rows(x + (size_t)c0 * DM, H + (size_t)c0 * DM, 32, gmix, mb, mb + 1024, F.lane, WSP(unsigned char, WS_H8) + (size_t)c0 * DM); }
        const float* mc = mod + (size_t)32 * 6144; const float* cx = A->in[2];
        for (int c0 = gw * 4; c0 < MCTX; c0 += NGW * 4) norm_mod_rows(cx + (size_t)c0 * DM, HC + (size_t)c0 * DM, 4, gmix, mc, mc + 1024, F.lane); }
      } } GRID_BAR();
      { PHASE_BEGIN(); {
        { unsigned char* ws = get_args()->ws;
          pg8::Gemm g{WSP(bf16_t, WS_H8), WSP(bf16_t, WS_WIN8) + (size_t)1024 * 512, 512, 0}; pg8::StaticOrder S; S.init(MTOK, 3072, F.G, F.cid);
          LAS float* bl = (LAS float*)(F.lds + MOE_BLK_LDS);
          for (int i = F.tid; i < 1024; i += NTHREADS) ((LAS f32x4*)bl)[i] = WSP(const f32x4, WS_BIN)[i];
          __syncthreads();
          EpiMain E{0, bl, ws, (void*)get_args()->out, 1.f / 64.f, 4};
          if constexpr ((PROBE_MASK >> 22) & 1) { pg8::SkipOrder<pg8::StaticOrder> S3{S}; pg8::gemm_phase<EpiMain, pg8::SkipOrder<pg8::StaticOrder>, false, ALIGN_EPI_>(F.lds, g, S3, E); }
          if constexpr ((PROBE_MASK >> 21) & 1) {
              const unsigned long long t0 = __builtin_amdgcn_s_memrealtime(); const unsigned long long dl = (unsigned long long)((blockIdx.x >> 3) & 3u) * 900ull;
              while (__builtin_amdgcn_s_memrealtime() - t0 < dl) __builtin_amdgcn_s_sleep(8); }
          if constexpr ((PROBE_MASK >> 18) & 1) { pg8::DupOrder<pg8::StaticOrder> S2{S}; pg8::gemm_phase<EpiMain, pg8::DupOrder<pg8::StaticOrder>, false, ALIGN_EPI_>(F.lds, g, S2, E); } else
          for (int rep_ = 0; rep_ < (((PROBE_MASK >> 2) & 1) ? 2 : 1); ++rep_) pg8::gemm_phase<EpiMain, pg8::StaticOrder, false, ALIGN_EPI_, true>(F.lds, g, S, E);
          { pg8::Gemm g2{WSP(bf16_t, WS_H), WSP(bf16_t, WS_WIN), 1024, 0}; pg8::StaticOrder S2; S2.init(MTOK, 1024, F.G, F.cid);
            EpiMain E2{0, bl, ws, (void*)get_args()->out, 1.f, 0};
            pg8::gemm_phase<EpiMain, pg8::StaticOrder, false, ALIGN_EPI_>(F.lds, g2, S2, E2); } }
        { unsigned char* ws = get_args()->ws;
          pg8::Gemm g{WSP(bf16_t, WS_WT8), WSP(bf16_t, WS_H8), 512, 0}; pg8::StaticOrder S; S.init(1536, MTOK, F.G, F.cid);
          EpiT E{ws, WSP(const float, WS_BT), MTOK, 0, 0, 1.f / 64.f};
          for (int rep_ = 0; rep_ < (((PROBE_MASK >> 3) & 1) ? 2 : 1); ++rep_) pg8::gemm_phase<EpiT, pg8::StaticOrder, false, ALIGN_EPI_, true>(F.lds, g, S, E); }
        { unsigned char* ws = get_args()->ws;
          pg8::Gemm g{WSP(bf16_t, WS_H), WSP(bf16_t, WS_WIN) + (size_t)4096 * 1024, 1024, 0}; pg8::StaticOrder S; S.init(MTOK, 256, F.G, F.cid);
          EpiTT<0> E{WSP(const float, WS_BIN) + 4096, WSP(bf16_t, WS_TQ), WSP(bf16_t, WS_TKA), WSP(bf16_t, WS_TVA), WSP(const float, WS_ROPE)};
          for (int rep_ = 0; rep_ < (((PROBE_MASK >> 4) & 1) ? 2 : 1); ++rep_) pg8::gemm_phase<EpiTT<0>, pg8::StaticOrder, false, ALIGN_EPI_>(F.lds, g, S, E); }
        { unsigned char* ws = get_args()->ws;
          pg8::Gemm g{WSP(bf16_t, WS_HC), WSP(bf16_t, WS_WIN) + (size_t)3584 * 1024, 1024, 0}; pg8::StaticOrder S; S.init(MCTX, 512, F.G, F.cid);
          LAS float* bl = (LAS float*)(F.lds + MOE_BLK_LDS);
          __syncthreads();
          { int t_ = TIDX(); asm volatile("" : "+v"(t_));
            for (int i = t_; i < 128; i += NTHREADS) ((LAS f32x4*)bl)[i] = (WSP(const f32x4, WS_BIN) + 3584 / 4)[i]; }
          __syncthreads();
          EpiMain E{1, bl, ws, (void*)get_args()->out, 1.f, 14};
          for (int rep_ = 0; rep_ < (((PROBE_MASK >> 5) & 1) ? 2 : 1); ++rep_) pg8::gemm_phase<EpiMain, pg8::StaticOrder, false, ALIGN_EPI_>(F.lds, g, S, E); }
        { unsigned char* ws = get_args()->ws;
          pg8::Gemm g{WSP(bf16_t, WS_HC), WSP(bf16_t, WS_WIN) + (size_t)4096 * 1024, 1024, 0}; pg8::StaticOrder S; S.init(MCTX, 256, F.G, (F.cid + F.G - 64) % F.G);
          EpiTT<1> E{WSP(const float, WS_BIN) + 4096, WSP(bf16_t, WS_TQ), WSP(bf16_t, WS_TKA), WSP(bf16_t, WS_TVA), WSP(const float, WS_ROPE)};
          for (int rep_ = 0; rep_ < (((PROBE_MASK >> 6) & 1) ? 2 : 1); ++rep_) pg8::gemm_phase<EpiTT<1>, pg8::StaticOrder, false, ALIGN_EPI_>(F.lds, g, S, E); }
        { unsigned char* ws = get_args()->ws;
          pg8::Gemm g{WSP(bf16_t, WS_WT) + (size_t)1024 * 1024, WSP(bf16_t, WS_HC), 1024, 0}; pg8::StaticOrder S; S.init(512, MCTX, F.G, (F.cid + F.G - 96) % F.G);
          EpiT E{ws, WSP(const float, WS_BT), MCTX, 4, 1, 1.f};
          for (int rep_ = 0; rep_ < (((PROBE_MASK >> 7) & 1) ? 2 : 1); ++rep_) pg8::gemm_phase<EpiT, pg8::StaticOrder, false, ALIGN_EPI_>(F.lds, g, S, E); }
      } } GRID_BAR();
      { PHASE_BEGIN(); if (stage >= 2) {
        { unsigned char* ws = get_args()->ws;
          for (int rep_ = (((PROBE_MASK >> 13) & 1) ? 0 : 1); rep_ < 2; ++rep_)
          for (int u = F.vcu; u < BATCH * 8; u += F.G) { const int b = u >> 3, qb = u & 7;
            bf16_t* qp = WSP(bf16_t, WS_TQ) + ((size_t)b * 2048 + qb * 256) * 64;
            bf16_t* op = rep_ == 1 ? qp : WSP(bf16_t, WS_H) + ((size_t)b * 2048 + qb * 256) * 64;
            tattn::attn_unit<8, 2304>(qp, WSP(bf16_t, WS_TKA) + (size_t)b * 2304 * 64, WSP(bf16_t, WS_TVA) + (size_t)b * 2304 * 64, op, (char*)lds); }
          __syncthreads(); }
        { KArgs A = get_args(); unsigned char* ws = A->ws;
          if ((PROBE_MASK >> 14) & 1) na_phase(F, A->in[15], WSP(bf16_t, WS_NQ), WSP(bf16_t, WS_H) + (size_t)8 * MiB, WSP(bf16_t, WS_NK), WSP(bf16_t, WS_NKC), WSP(bf16_t, WS_NVT), WSP(bf16_t, WS_NVCT));
          na_phase(F, A->in[15], WSP(bf16_t, WS_NQ), WSP(bf16_t, WS_NQ), WSP(bf16_t, WS_NK), WSP(bf16_t, WS_NKC), WSP(bf16_t, WS_NVT), WSP(bf16_t, WS_NVCT)); }
      } } GRID_BAR();
      { PHASE_BEGIN(); if (stage >= 2) {
        { KArgs A = get_args(); unsigned char* ws = A->ws;
          if ((PROBE_MASK >> 15) & 1) { sgu_phase(F, WSP(bf16_t, WS_VT), WSP(bf16_t, WS_U), WSP(bf16_t, WS_NK), WSP(bf16_t, WS_TQ), WSP(const bf16_t, WS_WS), WSP(const bf16_t, WS_WO), A->in[10], A->in[11], A->in[13]); __syncthreads(); }
          sgu_phase(F, WSP(bf16_t, WS_VT), WSP(bf16_t, WS_U), WSP(bf16_t, WS_U), WSP(bf16_t, WS_TQ), WSP(const bf16_t, WS_WS), WSP(const bf16_t, WS_WO), A->in[10], A->in[11], A->in[13]);
          __syncthreads(); }
      } } GRID_BAR();
      { PHASE_BEGIN(); if (stage >= 2) {
        unsigned char* ws = get_args()->ws;
        pg8::Gemm g{(const bf16_t*)ws, WSP(bf16_t, WS_WUPA), 1536, 1024};
        pg8::FusedOrder S; S.b.init(MTOK, 1024, F.G, F.cid); S.aoff0 = (unsigned)WS_NQ; S.apitch0 = 1024u; S.aoff1 = (unsigned)WS_U; S.apitch1 = 2048u; S.nt0 = 8; S.nt1 = 16;
        EpiMerge E{WSP(const unsigned char, WS_GA), WSP(const unsigned char, WS_GB), WSP(bf16_t, WS_MERGED)};
        pg8::gemm_phase<EpiMerge, pg8::FusedOrder, true, ALIGN_EPI_>(F.lds, g, S, E);
      } } GRID_BAR();
      { PHASE_BEGIN(); if (stage >= 2) {
        KArgs A = get_args(); unsigned char* ws = A->ws;
        pg8::Gemm g{WSP(bf16_t, WS_MERGED), WSP(bf16_t, WS_WOUT), 1024, 0}; pg8::StaticOrder S; S.init(MTOK, 1024, F.G, F.cid);
        EpiXmid E{A->in[0], WSP(const float, WS_MOD), WSP(bf16_t, WS_XMID), WSP(float, WS_NQ)};
        for (int rep_ = 0; rep_ < (((PROBE_MASK >> 10) & 1) ? 2 : 1); ++rep_) pg8::gemm_phase<EpiXmid, pg8::StaticOrder, false, ALIGN_EPI_>(F.lds, g, S, E);
      } else {
        KArgs A = get_args(); unsigned char* ws = A->ws; const float* x = A->in[0]; bf16_t* xmid = WSP(bf16_t, WS_XMID);
        const size_t gt = (size_t)F.vcu * NTHREADS + F.tid, NT_ = (size_t)F.G * NTHREADS;
        for (size_t i = gt; i < (size_t)MTOK * DM / 8; i += NT_) ((u32x4*)xmid)[i] = pack8(((const f32x4*)x)[2 * i], ((const f32x4*)x)[2 * i + 1]);
      } } GRID_BAR();
      { PHASE_BEGIN(); if (stage >= 3) {
        KArgs A = get_args(); unsigned char* ws = A->ws; bf16_t* H2 = WSP(bf16_t, WS_H);
        if (blockIdx.x == 0) for (int i = F.tid; i < DM / 4; i += NTHREADS) ((unsigned*)((unsigned char*)H2 + (size_t)MTOK * DM))[i] = 0u;
        if ((PROBE_MASK >> 16) & 1) { router_phase(F, WSP(const bf16_t, WS_XMID), WSP(const float, WS_MOD), A->in[7], A->in[20], WSP(const bf16_t, WS_WRH), WSP(const bf16_t, WS_WRL), A->in[19], H2, WSP(int, WS_LCROW), WSP(float, WS_LW), F.ctl + CW_GCOUNT, true, WSP(const float, WS_NQ)); __syncthreads(); }
        router_phase(F, WSP(const bf16_t, WS_XMID), WSP(const float, WS_MOD), A->in[7], A->in[20], WSP(const bf16_t, WS_WRH), WSP(const bf16_t, WS_WRL), A->in[19], H2, WSP(int, WS_LCROW), WSP(float, WS_LW), F.ctl + CW_GCOUNT, false, WSP(const float, WS_NQ));
      } } GRID_BAR();
      if (stage >= 3) {
        volatile LAS unsigned* lv = F.MISC + 16;
        if (TIDX() == 0) lv[0] = 0u;
        __syncthreads();
#pragma unroll 1
        for (;;) {
          PHASE_BEGIN();
          { const int s = __builtin_amdgcn_readfirstlane((int)MISC_PTR()[16]);
            if (s > 2 * NGRP) break;
            if constexpr ((PROBE_MASK >> 29) & 1) { if (s == ((PROBE_MASK >> 30) & 1 ? 0 : 2 * NGRP)) {
                if (TIDX() < 64) { const unsigned long long t0 = __builtin_amdgcn_s_memtime(); while (__builtin_amdgcn_s_memtime() - t0 < 400000ull) __builtin_amdgcn_s_sleep(1); }
                __syncthreads(); } }
            const int g = s >> 1;
            if ((s & 1) == 0) {
              int gu_units = 0;
              if (g < NGRP) gu_units = 2 * moe_table(F, g);
              if (g > 0) { KArgs A = get_args(); unsigned char* ws = A->ws; final_phase(F, g - 1, WSP(const unsigned char, WS_C), WSP(const bf16_t, WS_XMID), WSP(const float, WS_MOD), A->in[27], A->out, gu_units); }
              if (g < NGRP) { PHASE_BEGIN(); moe_gu_phase(F, g); }
            } else { moe_down_phase(F, g); if constexpr ((PROBE_MASK >> 28) & 1) { __syncthreads(); moe_down_phase(F, g); } } }
          __syncthreads();
          const int s2 = __builtin_amdgcn_readfirstlane((int)MISC_PTR()[16]);
          __syncthreads();
          if (TIDX() == 0) MISC_PTR()[16] = (unsigned)(s2 + 1);
          if (s2 < 2 * NGRP) GRID_BAR(); else __syncthreads();
        }
      } else {
        PHASE_BEGIN();
        KArgs A = get_args(); unsigned char* ws = A->ws;
        float* out = A->out; const float* fg = A->in[27]; const bf16_t* xmid = WSP(const bf16_t, WS_XMID);
        const int gw = F.vcu * NWAVES + F.wave, NGW = F.G * NWAVES;
        for (int tl = gw; tl < MTOK; tl += NGW) {
            f32x4 v[4]; float s = 0.f;
            unpack8(*(const u32x4*)(xmid + (size_t)tl * DM + 16 * F.lane), v[0], v[1]); unpack8(*(const u32x4*)(xmid + (size_t)tl * DM + 16 * F.lane + 8), v[2], v[3]);
#pragma unroll
            for (int j = 0; j < 4; ++j) s += (v[j].x * v[j].x + v[j].y * v[j].y) + (v[j].z * v[j].z + v[j].w * v[j].w);
            const float r = 1.f / sqrtf(wave_sum(s) * (1.f / DM) + NORM_EPS);
#pragma unroll
            for (int j = 0; j < 4; ++j) ((f32x4*)(out + (size_t)tl * DM + 16 * F.lane))[j] = v[j] * r * ((const f32x4*)(fg + 16 * F.lane))[j];
        }
      }
}

extern "C" void kernel_launch(void* const* d_in, const int* in_sizes, int n_in, void* d_out, int out_size, void* d_ws, size_t ws_size, hipStream_t stream) {
    static int grid = 0;
    if (grid == 0) {
        int dev = 0, cus = 0, per_cu = 0;
        if (n_in != 28 || ws_size < WS_END) { fprintf(stderr, "kernel_launch: n_in %d ws %zu (need %zu)\n", n_in, ws_size, (size_t)WS_END); grid = -1; return; }
        if (hipGetDevice(&dev) != hipSuccess || hipDeviceGetAttribute(&cus, hipDeviceAttributeMultiprocessorCount, dev) != hipSuccess) { fprintf(stderr, "kernel_launch: device query failed\n"); grid = -1; return; }
        if (hipFuncSetAttribute((const void*)mega_fwd, hipFuncAttributeMaxDynamicSharedMemorySize, LDS_BYTES) != hipSuccess) { fprintf(stderr, "kernel_launch: hipFuncSetAttribute failed\n"); grid = -1; return; }
        if (hipOccupancyMaxActiveBlocksPerMultiprocessor(&per_cu, (const void*)mega_fwd, NTHREADS, LDS_BYTES) != hipSuccess || per_cu < 1) { fprintf(stderr, "kernel_launch: occupancy query says %d\n", per_cu); }
        (void)hipGetLastError();
        grid = cus;
    }
    if (grid < 0) return;
    (void)hipMemsetAsync((char*)d_ws + WS_CTL, 0, CTL_ZERO_BYTES, stream);
    Args a{};
    for (int i = 0; i < 28; ++i) a.in[i] = (const float*)d_in[i];
    a.out = (float*)d_out; a.ws = (unsigned char*)d_ws; a.stage = KSTAGE;
    void* kargs[] = {&a};
    hipError_t e = hipLaunchCooperativeKernel((const void*)mega_fwd, dim3(grid), dim3(NTHREADS), kargs, LDS_BYTES, stream);
    if (e != hipSuccess) fprintf(stderr, "kernel_launch: cooperative launch failed: %s\n", hipGetErrorString(e));
}
```

```cpp
#define KSTAGE 3
#define PROBE_MASK 0
#define ALIGN_EPI_ true
#include <hip/hip_runtime.h>
#include <hip/hip_bf16.h>
#include <cstdio>
#include <cstdint>
#include <cmath>

#define GAS __attribute__((address_space(1)))
#define LAS __attribute__((address_space(3)))
typedef unsigned short bf16_t;
typedef float f32x4 __attribute__((ext_vector_type(4)));
typedef float f32x2 __attribute__((ext_vector_type(2)));
typedef unsigned u32x4 __attribute__((ext_vector_type(4)));
typedef unsigned u32x2 __attribute__((ext_vector_type(2)));
typedef short bf16x8 __attribute__((ext_vector_type(8)));

constexpr int DM = 1024, BATCH = 32, SEQ = 2048, MTOK = BATCH * SEQ, CTXL = 256, MCTX = BATCH * CTXL;
constexpr int IN_W = 5824;
constexpr int COL_U = 0, COL_V = 1024, COL_TQ = 2048, COL_TK = 2112, COL_TV = 2176, COL_NQ = 2240, COL_NK = 2752, COL_NV = 3264, COL_GA = 3776, COL_GB = 4800;
constexpr float NORM_EPS = 1e-6f;
constexpr int NWAVES = 8, NTHREADS = 512;

constexpr int SCR_BYTES = 147456;
constexpr int LDSCTL_OFF = SCR_BYTES, MISC_OFF = LDSCTL_OFF + 320;
constexpr int WTAB_OFF = MISC_OFF + 128;
__device__ __forceinline__ int lane_id_() { int l; asm volatile("v_mbcnt_lo_u32_b32 %0, -1, 0\n\tv_mbcnt_hi_u32_b32 %0, -1, %0" : "=v"(l)); return l; }
__device__ __forceinline__ int wave_idx_() { const unsigned slot = __builtin_amdgcn_s_getreg((5 << 11) | 4) & 63u;
    return __builtin_amdgcn_readfirstlane((int)*(volatile LAS unsigned*)(size_t)(WTAB_OFF + 4 * slot)); }
#define TIDX() ((int)threadIdx.x)
constexpr int EPL_LDS = SCR_BYTES + 2048;
constexpr int LDS_BYTES = EPL_LDS + 8192;

constexpr size_t MiB = 1u << 20;
constexpr size_t WS_CTL = 0, CTL_ZERO_BYTES = 1 * MiB;
constexpr int CW_BAR = 4096, CW_GCOUNT = 8192;
constexpr size_t WS_MOD = 1 * MiB;
constexpr size_t WS_ROPE = 2 * MiB;
constexpr size_t WS_BIN = 2 * MiB + 64 * 1024;
constexpr size_t WS_BT = 2 * MiB + 128 * 1024;
constexpr size_t WS_WIN = 3 * MiB;
constexpr size_t WS_WT = 12 * MiB;
constexpr size_t WS_WUPA = 15 * MiB, WS_WUPB = 17 * MiB, WS_WOUT = 18 * MiB;
constexpr size_t WS_WO = 20 * MiB, WS_WS = 20 * MiB + 256 * 1024, WS_WRH = 20 * MiB + 512 * 1024, WS_WRL = 20 * MiB + 768 * 1024;
constexpr size_t WS_WGU = 24 * MiB;
constexpr size_t WS_WD = 89 * MiB;
constexpr size_t WS_U = 122 * MiB, WS_VT = 250 * MiB, WS_GA = 378 * MiB, WS_GB = 506 * MiB, WS_NQ = 634 * MiB;
constexpr size_t WS_C = 122 * MiB;
constexpr int CROW_BYTES = 9 * 1024;
constexpr size_t WS_H8 = 442 * MiB;
constexpr size_t WS_WIN8 = 60 * MiB;
constexpr size_t WS_WT8 = 64 * MiB;
constexpr size_t WS_XMID = 506 * MiB;
constexpr size_t C_BYTES = 0;
constexpr size_t WS_MERGED = WS_VT;
constexpr size_t WS_H = 698 * MiB;
constexpr size_t WS_NK = 827 * MiB, WS_NKC = 891 * MiB, WS_NVT = 899 * MiB, WS_NVCT = 963 * MiB, WS_TQ = 971 * MiB, WS_TKA = 979 * MiB, WS_TVA = 988 * MiB, WS_HC = 997 * MiB;
constexpr size_t WS_ACT = 827 * MiB;
constexpr size_t ACT_BYTES = 0;
constexpr size_t WS_LCROW = 984 * MiB, WS_LW = 1001 * MiB;
constexpr int NGRP = 2;
constexpr int GSPLIT = 124 * 256, GCAP = MTOK - GSPLIT;
__host__ __device__ constexpr int gbase(int g) { return g == 0 ? 0 : GSPLIT; }
__host__ __device__ constexpr int gsize(int g) { return g == 0 ? GSPLIT : MTOK - GSPLIT; }
constexpr size_t WS_DUMMY = 1018 * MiB;
constexpr size_t WS_END = 1020 * MiB;
constexpr int MOE_BLK_LDS = 131072;
constexpr int MOE_MAXBLK = GCAP * 9 / 256 + 64;

#ifndef ALIGN_EPI_
#define ALIGN_EPI_ true
#endif
#ifndef PROBE_MASK
#define PROBE_MASK 0
#endif
#ifndef KSTAGE
#define KSTAGE 3
#endif

#define RLX_AGENT __ATOMIC_RELAXED, __HIP_MEMORY_SCOPE_AGENT

#define XB_TMO      128
#define XB_XCNT(j)  (256  + 64 * (j))
#define XB_XSUB(j)  (1280 + 64 * (j))
#define XB_XGEN(j)  (2304 + 64 * (j))
#define XB_TOP      3328
#define XB_TOPGEN   3392
#define XCD_BAR_WORDS 3456
#define XB_SPIN_CAP (1u << 18)
__device__ __forceinline__ unsigned xb_ld(unsigned* p)              { return __hip_atomic_load(p, __ATOMIC_RELAXED, __HIP_MEMORY_SCOPE_AGENT); }
__device__ __forceinline__ unsigned xb_add(unsigned* p, unsigned v) { return __hip_atomic_fetch_add(p, v, __ATOMIC_RELAXED, __HIP_MEMORY_SCOPE_AGENT); }
__device__ __forceinline__ unsigned xb_xcc_id() { return (unsigned)__builtin_amdgcn_s_getreg((3 << 11) | 20) & 0xFu; }
#define XB_SPIN(cond, bar) do { unsigned _sp = 0; while (cond) { __builtin_amdgcn_s_sleep(1); \
    if ((++_sp & 255u) == 0u) { if (xb_ld(&(bar)[XB_TMO])) break; if (_sp > XB_SPIN_CAP) { atomicAdd(&(bar)[XB_TMO], 1u); break; } } } } while (0)
struct XcdBarrier { unsigned* bar; unsigned x; volatile LAS unsigned* st; };
__device__ __forceinline__ XcdBarrier xcd_barrier_post(unsigned* bar, volatile LAS unsigned* st) {
    XcdBarrier b; b.bar = bar; b.x = xb_xcc_id(); b.st = st;
    if (TIDX() == 0) { const unsigned rank = xb_add(&bar[XB_XCNT(b.x)], 1u); st[4] = b.x; st[5] = rank; }
    return b;
}
__device__ __forceinline__ void xcd_barrier_complete(unsigned* bar, unsigned x, unsigned& nloc, unsigned& nx) {
    const unsigned G = gridDim.x * gridDim.y * gridDim.z;
    unsigned sum, cnt, mine, sp = 0u;
    for (;;) {
        sum = 0u; cnt = 0u; mine = 0u;
#pragma unroll 1
        for (unsigned j = 0; j < 16; ++j) { const unsigned c = xb_ld(&bar[XB_XCNT(j)]); sum += c; cnt += (c > 0u) ? 1u : 0u; mine = (j == x) ? c : mine; }
        if (sum == G) break;
        __builtin_amdgcn_s_sleep(1);
        if ((++sp & 255u) == 0u) { if (xb_ld(&bar[XB_TMO])) break; if (sp > XB_SPIN_CAP) { atomicAdd(&bar[XB_TMO], 1u); break; } }
    }
    nloc = mine > 0u ? mine : 1u; nx = cnt > 0u ? cnt : 1u;
}
__device__ __forceinline__ void xcd_barrier(const XcdBarrier& b) {
    asm volatile("s_waitcnt vmcnt(0)" ::: "memory");
    __syncthreads();
    if (TIDX() == 0) {
        unsigned* bar = b.bar;
        __builtin_amdgcn_s_waitcnt(0);
        unsigned nloc = b.st[0], nx = b.st[1];
        if (nloc == 0u) { xcd_barrier_complete(bar, b.x, nloc, nx); b.st[0] = nloc; b.st[1] = nx; }
        const unsigned old = xb_add(&bar[XB_XSUB(b.x)], 1u);
        const unsigned gen = old / nloc;
        if (old + 1u == (gen + 1u) * nloc) {
            __builtin_amdgcn_fence(__ATOMIC_RELEASE, "agent");
            asm volatile("s_waitcnt vmcnt(0)" ::: "memory");
            const unsigned og = xb_add(&bar[XB_TOP], 1u);
            const unsigned tg = og / nx;
            if (og + 1u == (tg + 1u) * nx) xb_add(&bar[XB_TOPGEN], 1u);
            else XB_SPIN(xb_ld(&bar[XB_TOPGEN]) == tg, bar);
            __builtin_amdgcn_fence(__ATOMIC_ACQUIRE, "agent");
            xb_add(&bar[XB_XGEN(b.x)], 1u);
            asm volatile("s_waitcnt vmcnt(0)" ::: "memory");
        } else {
            XB_SPIN(xb_ld(&bar[XB_XGEN(b.x)]) == gen, bar);
            __builtin_amdgcn_fence(__ATOMIC_ACQUIRE, "agent");
            asm volatile("s_waitcnt vmcnt(0)" ::: "memory");
        }
    }
    __syncthreads();
}

__device__ __forceinline__ float wave_sum(float v) {
#pragma unroll
    for (int o = 1; o < 64; o <<= 1) v += __shfl_xor(v, o);
    return v;
}
__device__ __forceinline__ float wave_sum_l(float v, int lane) {
#pragma unroll
    for (int o = 1; o < 64; o <<= 1) v += __builtin_bit_cast(float, __builtin_amdgcn_ds_bpermute((lane ^ o) << 2, __builtin_bit_cast(int, v)));
    return v;
}
__device__ __forceinline__ unsigned f2bf(float f) { unsigned u = __builtin_bit_cast(unsigned, f); return (u + 0x7fffu + ((u >> 16) & 1u)) >> 16; }
__device__ __forceinline__ unsigned pk2(float lo, float hi) { return f2bf(lo) | (f2bf(hi) << 16); }
__device__ __forceinline__ float bf2f(unsigned short b) { return __builtin_bit_cast(float, (unsigned)b << 16); }

#include <type_traits>
namespace pg8 {
#define PG8_LAS __attribute__((address_space(3)))
constexpr int BM = 256, BK = 64, HALF = 128, HTB = HALF * BK * 2, STAGE_BYTES = 8 * HTB, NXCD = 8, WGM = 8;
__host__ __device__ __forceinline__ int lds_byte(int r, int c) { const int st = (r >> 4) * 2 + (c >> 5), rr = r & 15, cc = c & 31, ob = rr * 64 + cc * 2; return st * 1024 + (ob ^ (((ob >> 9) & 1) << 5)); }
__host__ __device__ __forceinline__ void stage_rc(int b, int& R, int& C) { const int st = b / 1024, sb = b % 1024, swz = sb ^ (((sb >> 9) & 1) << 5); R = (st >> 1) * 16 + swz / 64; C = (st & 1) * 32 + (swz % 64) / 2; }
__host__ __device__ __forceinline__ int perm32(int rho) { const int n = rho >> 4, i = rho & 15; return 8 * (i >> 2) + 4 * n + (i & 3); }

typedef int i32x4_ __attribute__((ext_vector_type(4)));
struct Unit { int pm, pn, e, r0, skip, cnt; };
struct Gemm { const bf16_t* A; const bf16_t* Bt; int K; size_t b_estride; };

struct StaticOrder {
    int nM, nN, nwg, G, c;
    __host__ __device__ void init(int M, int N, int G_, int c_) { nM = M / BM; nN = N / BM; nwg = nM * nN; G = G_; c = c_; }
    __host__ __device__ bool next(int i, Unit& u) const {
        const long L = (long)i * G + c; if (L >= nwg) return false;
        int wgid = (int)L; { const int q = nwg / NXCD, r = nwg % NXCD, xcd = wgid % NXCD, off = wgid / NXCD; wgid = (xcd < r ? xcd * (q + 1) : r * (q + 1) + (xcd - r) * q) + off; }
        const int nig = WGM * nN, gid = wgid / nig, fm = gid * WGM, gsz = (nM - fm) < WGM ? (nM - fm) : WGM;
        u.pm = fm + ((wgid % nig) % gsz); u.pn = (wgid % nig) / gsz; u.e = 0; u.r0 = 0; u.skip = 0; u.cnt = 0; return true;
    }
    __device__ __forceinline__ unsigned rowoff(const Unit&, int) const { return 0u; }
    __device__ __forceinline__ int rowraw(const Unit&, int) const { return 0; }
    __device__ __forceinline__ unsigned rowfin(const Unit&, int, int) const { return 0u; }
    static constexpr int NRAW = 0;
    __device__ __forceinline__ int nt(const Unit&, int ntdef) const { return ntdef; }
    __device__ __forceinline__ bool keep_acc(const Unit&) const { return false; }
};

struct FusedOrder { StaticOrder b; unsigned aoff0, apitch0, aoff1, apitch1; int nt0, nt1;
    __device__ __forceinline__ bool next(int i, Unit& u) const { const bool ok = b.next(i >> 1, u); u.e = i & 1; return ok; }
    __device__ __forceinline__ unsigned rowoff(const Unit& u, int r) const { const unsigned row = (unsigned)(u.pm * BM + r); return u.e ? aoff1 + row * apitch1 : aoff0 + row * apitch0; }
    __device__ __forceinline__ int rowraw(const Unit&, int) const { return 0; }
    __device__ __forceinline__ unsigned rowfin(const Unit& u, int r, int) const { return rowoff(u, r); }
    static constexpr int NRAW = 0;
    __device__ __forceinline__ int nt(const Unit& u, int) const { return u.e ? nt1 : nt0; }
    __device__ __forceinline__ bool keep_acc(const Unit& u) const { return u.e == 0; }
};

template <class Base> struct SkipOrder { Base b;
    __device__ __forceinline__ bool next(int i, Unit& u) const { const bool ok = b.next(i, u); u.skip = 1; return ok; }
    __device__ __forceinline__ unsigned rowoff(const Unit& u, int r) const { return b.rowoff(u, r); }
    __device__ __forceinline__ int rowraw(const Unit& u, int r) const { return b.rowraw(u, r); }
    __device__ __forceinline__ unsigned rowfin(const Unit& u, int r, int raw) const { return b.rowfin(u, r, raw); }
    static constexpr int NRAW = Base::NRAW;
    __device__ __forceinline__ int nt(const Unit& u, int d) const { return b.nt(u, d); }
    __device__ __forceinline__ bool keep_acc(const Unit& u) const { return b.keep_acc(u); } };
template <class Base> struct DupOrder { Base b;
    __device__ __forceinline__ bool next(int i, Unit& u) const { const bool ok = b.next(i >> 1, u); u.skip = (i & 1) == 0; return ok; }
    __device__ __forceinline__ unsigned rowoff(const Unit& u, int r) const { return b.rowoff(u, r); }
    __device__ __forceinline__ int rowraw(const Unit& u, int r) const { return b.rowraw(u, r); }
    __device__ __forceinline__ unsigned rowfin(const Unit& u, int r, int raw) const { return b.rowfin(u, r, raw); }
    static constexpr int NRAW = Base::NRAW;
    __device__ __forceinline__ int nt(const Unit& u, int d) const { return b.nt(u, d); }
    __device__ __forceinline__ bool keep_acc(const Unit& u) const { return b.keep_acc(u); } };

__device__ __forceinline__ unsigned cvt_pk_bf16(float lo, float hi) { unsigned r; asm volatile("v_cvt_pk_bf16_f32 %0, %1, %2" : "=v"(r) : "v"(lo), "v"(hi)); return r; }
__device__ __forceinline__ f32x2 gelu_pk(f32x2 v) {
    const f32x2 av = __builtin_elementwise_abs(v), d = av * 0.2316418882f + 1.0f;
    f32x2 t; t.x = __builtin_amdgcn_rcpf(d.x); t.y = __builtin_amdgcn_rcpf(d.y);
    f32x2 q = t * 0.5307027145f + (-0.7265760135f); q = q * t + 0.7107068705f; q = q * t + (-0.142248368f); q = q * t + 0.127414796f; q = q * t;
    const f32x2 s = (v * v) * (-0.72134752044f);
    f32x2 e; e.x = __builtin_amdgcn_exp2f(s.x); e.y = __builtin_amdgcn_exp2f(s.y);
    const f32x2 m = v * (q * e), r = v - m;
    f32x2 o; o.x = v.x < 0.f ? m.x : r.x; o.y = v.y < 0.f ? m.y : r.y; return o;
}

template <class Epi, class Sched, bool GATHER, bool ALIGN_EPI, bool FP8 = false>
__device__ __forceinline__ void gemm_phase(PG8_LAS unsigned char* lds, const Gemm g, const Sched& S, const Epi& E) {
    int tid = TIDX(); asm volatile("" : "+v"(tid));
    const int wid = __builtin_amdgcn_readfirstlane(tid >> 6), lane = tid & 63, wr = wid >> 2, wc = wid & 3, fr = lane & 15, fq = lane >> 4;
    const int K = g.K, nt = K / BK;
    unsigned voffA[2], voffB[2];
#pragma unroll
    for (int i = 0; i < 2; ++i) { int R, C; stage_rc(tid * 16 + i * 8192, R, C); const int Rb = Epi::PERM ? (64 * (R >> 5) + 16 * ((R & 15) >> 2) + 4 * ((R >> 4) & 1) + (R & 3)) : R;
        voffA[i] = (unsigned)(R * K + C) * 2u; voffB[i] = (unsigned)(Rb * K + C) * 2u; }
#define PG8_ROWOFFS(U, d0, d1) do { _Pragma("unroll") for (int i_ = 0; i_ < 2; ++i_) { int R_, C_; stage_rc(tid * 16 + i_ * 8192, R_, C_); d0[i_] = S.rowoff(U, R_) + (unsigned)C_ * 2u; d1[i_] = S.rowoff(U, HALF + R_) + (unsigned)C_ * 2u; } } while (0)
#define PG8_ROWRAW(U, w) do { int tid_ = tid; asm volatile("" : "+v"(tid_));        \
        _Pragma("unroll") for (int i_ = 0; i_ < 2; ++i_) { int R_, C_; stage_rc(tid_ * 16 + i_ * 8192, R_, C_); w[i_][0] = S.rowraw(U, R_); w[i_][1] = S.rowraw(U, HALF + R_); } } while (0)
#define PG8_ROWFIN(U, w, d0, d1) do { int tid_ = tid; asm volatile("" : "+v"(tid_)); _Pragma("unroll") for (int i_ = 0; i_ < 2; ++i_) { int R_, C_; stage_rc(tid_ * 16 + i_ * 8192, R_, C_); d0[i_] = S.rowfin(U, R_, w[i_][0]) + (unsigned)C_ * 2u; d1[i_] = S.rowfin(U, HALF + R_, w[i_][1]) + (unsigned)C_ * 2u; } } while (0)
    const size_t kstep = (size_t)(BK * 2);
    const size_t hstep = (size_t)HALF * K * 2;
    const size_t tstep = 2 * hstep;
    const size_t ahstep = GATHER ? 0 : hstep;
    const size_t bhstep = Epi::PERM ? (size_t)8 * K * 2 : hstep;
    const unsigned ldsw = (unsigned)wid * 1024u;
    const int aoff = lds_byte(wr * 64 + fr, fq * 8), boff = lds_byte(wc * 32 + fr, fq * 8);
#define PG8_SA(b, h) (((b) * 2 + (h)) * HTB)
#define PG8_SB(b, h) ((4 + (b) * 2 + (h)) * HTB)
#define PG8_STAGE(bufoff, gbase, voff) do { const char* gb_ = (const char*)(gbase); if constexpr (FP8) { asm volatile("" : "+s"(gb_)); }        \
        _Pragma("unroll") for (int _i = 0; _i < 2; ++_i) \
        __builtin_amdgcn_global_load_lds((const unsigned*)(gb_ + (voff)[_i]), (PG8_LAS unsigned*)(lds + (bufoff) + ldsw + _i * 8192), 16, 0, 0); } while (0)
#define PG8_LDA(dst, b, h) do { _Pragma("unroll") for (int m = 0; m < 4; ++m) { \
        if constexpr (FP8) dst[m][0] = PG8_CAT8(*(const PG8_LAS bf16x8*)(lds + PG8_SA(b, h) + aoff + m * 2048), *(const PG8_LAS bf16x8*)(lds + PG8_SA(b, h) + aoff + m * 2048 + 1024)); \
        else { _Pragma("unroll") for (int k = 0; k < 2; ++k) dst[m][k] = __builtin_bit_cast(typename std::remove_reference<decltype(dst[m][k])>::type, *(const PG8_LAS bf16x8*)(lds + PG8_SA(b, h) + aoff + m * 2048 + k * 1024)); } } } while (0)
#define PG8_LDB(dst, b, h) do { _Pragma("unroll") for (int n = 0; n < 2; ++n) { \
        if constexpr (FP8) dst[n][0] = PG8_CAT8(*(const PG8_LAS bf16x8*)(lds + PG8_SB(b, h) + boff + n * 2048), *(const PG8_LAS bf16x8*)(lds + PG8_SB(b, h) + boff + n * 2048 + 1024)); \
        else { _Pragma("unroll") for (int k = 0; k < 2; ++k) dst[n][k] = __builtin_bit_cast(typename std::remove_reference<decltype(dst[n][k])>::type, *(const PG8_LAS bf16x8*)(lds + PG8_SB(b, h) + boff + n * 2048 + k * 1024)); } } } while (0)
#define PG8_CAT8(lo, hi) __builtin_shufflevector(__builtin_bit_cast(i32x4_, lo), __builtin_bit_cast(i32x4_, hi), 0, 1, 2, 3, 4, 5, 6, 7)
#define PG8_MMA(ai, bj, At, Bt) do { __builtin_amdgcn_s_setprio(1); \
        if constexpr (FP8) { _Pragma("unroll") for (int m = 0; m < 4; ++m) _Pragma("unroll") for (int n = 0; n < 2; ++n) \
            acc[ai][bj][m][n] = __builtin_amdgcn_mfma_scale_f32_16x16x128_f8f6f4(__builtin_bit_cast(i32x8_, Bt[n][0]), __builtin_bit_cast(i32x8_, At[m][0]), acc[ai][bj][m][n], 0, 0, 0, 0x7f7f7f7f, 0, 0x7f7f7f7f); } \
        else { _Pragma("unroll") for (int m = 0; m < 4; ++m) _Pragma("unroll") for (int n = 0; n < 2; ++n) _Pragma("unroll") for (int k = 0; k < 2; ++k) \
            acc[ai][bj][m][n] = __builtin_amdgcn_mfma_f32_16x16x32_bf16(__builtin_bit_cast(bf16x8, Bt[n][k & (FP8 ? 0 : 1)]), __builtin_bit_cast(bf16x8, At[m][k & (FP8 ? 0 : 1)]), acc[ai][bj][m][n], 0, 0, 0); } \
        __builtin_amdgcn_s_setprio(0); } while (0)
#define PG8_WAIT_V(n) asm volatile("s_waitcnt vmcnt(" #n ")" ::: "memory")
#define PG8_WAIT_VC(N) do { constexpr int n_ = (N); static_assert(n_ <= 63, "vmcnt"); asm volatile("s_waitcnt vmcnt(%0)" :: "n"(n_) : "memory"); } while (0)
#define PG8_WAIT_L(n) asm volatile("s_waitcnt lgkmcnt(" #n ")" ::: "memory")
#define PG8_BAR __builtin_amdgcn_s_barrier()
#define PG8_SCHED __builtin_amdgcn_sched_barrier(0)
#define PG8_AV0 (GATHER ? vA0 : voffA)
#define PG8_AV1 (GATHER ? vA1 : voffA)
    Unit cur, nxt; int ui = 0;
    if (!S.next(0, cur)) return;
    float zero_ = 0.f; if constexpr (FP8) { if (nt <= 2 || GATHER) { asm volatile("" : "+v"(zero_)); } }
    f32x4 acc[2][2][4][2];
#pragma unroll
    for (int a = 0; a < 2; ++a)
#pragma unroll
        for (int b = 0; b < 2; ++b)
#pragma unroll
            for (int m = 0; m < 4; ++m)
#pragma unroll
                for (int n = 0; n < 2; ++n) acc[a][b][m][n] = (f32x4){zero_, zero_, zero_, zero_};
    typedef int i32x8_ __attribute__((ext_vector_type(8)));
    typename std::conditional<FP8, i32x8_, bf16x8>::type At[4][FP8 ? 1 : 2], B0[2][FP8 ? 1 : 2], B1[2][FP8 ? 1 : 2];
    unsigned vA0[2] = {0u, 0u}, vA1[2] = {0u, 0u};
    if constexpr (GATHER) { PG8_ROWOFFS(cur, vA0, vA1); }
    int graw[2][2] = {{0, 0}, {0, 0}};
    typename Epi::Pre pre{};
    constexpr bool EARLY_RAW = true;
    constexpr int NX = Epi::NPRE + ((GATHER && EARLY_RAW) ? Sched::NRAW : 0);
    const char* cA = GATHER ? (const char*)g.A : (const char*)g.A + (size_t)cur.pm * tstep;
    const char* cB = (const char*)g.Bt + (size_t)cur.e * g.b_estride + (size_t)cur.pn * tstep;
    PG8_STAGE(PG8_SB(0, 0), cB, voffB); PG8_STAGE(PG8_SB(0, 1), cB + bhstep, voffB); PG8_STAGE(PG8_SA(0, 0), cA, PG8_AV0); PG8_STAGE(PG8_SA(0, 1), cA + ahstep, PG8_AV1);
    if (wr == 1) PG8_BAR;
    PG8_WAIT_V(2); PG8_BAR;
    PG8_STAGE(PG8_SB(1, 0), cB + kstep, voffB); PG8_STAGE(PG8_SA(1, 0), cA + kstep, PG8_AV0); PG8_STAGE(PG8_SB(1, 1), cB + bhstep + kstep, voffB);
    PG8_WAIT_V(6); PG8_BAR;
    int epi_st = -1;
    for (;;) {
        const bool has_next = S.next(ui + 1, nxt);
        const char* nA = GATHER ? (const char*)g.A : (has_next ? (const char*)g.A + (size_t)nxt.pm * tstep : cA);
        const char* nB = has_next ? (const char*)g.Bt + (size_t)nxt.e * g.b_estride + (size_t)nxt.pn * tstep : cB;
        int unt = S.nt(cur, nt);
        if constexpr (FP8 && !GATHER) { if (nt <= 2) { asm volatile("" : "+s"(unt)); } }
        int t0_ = 0; if constexpr (FP8 && !GATHER) { if (nt <= 2) { asm volatile("" : "+s"(t0_)); } }
#pragma unroll 1
        for (int t = 0; t < unt; t += 2) {
            const bool last = (t == unt - 2);
            const char* a1 = cA + (size_t)(t + 1) * kstep;
            const char* a2 = last ? nA : cA + (size_t)(t + 2) * kstep; const char* b2 = last ? nB : cB + (size_t)(t + 2) * kstep;
            const char* a3 = a2 + kstep; const char* b3 = b2 + kstep;
            unsigned nA0[2] = {0u, 0u}, nA1[2] = {0u, 0u};
            if (t == t0_) { E.preload(pre, cur, wr, wc, fr, fq); if constexpr (GATHER && EARLY_RAW) { if (has_next) { PG8_ROWRAW(nxt, graw); } } }
            if constexpr (GATHER) { if (last && has_next) { if constexpr (EARLY_RAW) { PG8_ROWFIN(nxt, graw, nA0, nA1); } else { PG8_ROWOFFS(nxt, nA0, nA1); } } }
            const bool relax = (t == t0_) && epi_st >= 0;
            PG8_LDB(B0, 0, 0); PG8_LDB(B1, 0, 1); PG8_SCHED; PG8_LDA(At, 0, 0); PG8_STAGE(PG8_SA(1, 1), a1 + ahstep, PG8_AV1);
            if (relax) { if (epi_st >= 16) { PG8_WAIT_VC(8 + NX + 16); } else if (epi_st >= 8) { PG8_WAIT_VC(8 + NX + 8); } else { PG8_WAIT_VC(8 + NX); } } else if (t == t0_) { PG8_WAIT_VC(8 + NX); } else PG8_WAIT_V(8);
            PG8_WAIT_L(0); PG8_BAR; PG8_MMA(0, 0, At, B0); PG8_MMA(0, 1, At, B1); PG8_BAR; PG8_SCHED;
            if constexpr (GATHER) { if (last && has_next) { vA0[0] = nA0[0]; vA0[1] = nA0[1]; vA1[0] = nA1[0]; vA1[1] = nA1[1]; } }
            PG8_LDA(At, 0, 1); PG8_STAGE(PG8_SB(0, 0), b2, voffB); PG8_STAGE(PG8_SB(0, 1), b2 + bhstep, voffB); PG8_STAGE(PG8_SA(0, 0), a2, PG8_AV0);
            if (relax) { if (epi_st >= 16) { PG8_WAIT_VC(8 + NX + 16); } else if (epi_st >= 8) { PG8_WAIT_VC(8 + NX + 8); } else { PG8_WAIT_VC(8 + NX); } } else if (t == t0_) { PG8_WAIT_VC(8 + NX); } else PG8_WAIT_V(8);
            PG8_WAIT_L(0); PG8_BAR; PG8_MMA(1, 0, At, B0); PG8_MMA(1, 1, At, B1); PG8_BAR; PG8_SCHED;
            PG8_LDB(B0, 1, 0); PG8_LDB(B1, 1, 1); PG8_SCHED; PG8_LDA(At, 1, 0); PG8_STAGE(PG8_SA(0, 1), a2 + ahstep, PG8_AV1);
            PG8_WAIT_V(8); PG8_WAIT_L(0); PG8_BAR; PG8_MMA(0, 0, At, B0); PG8_MMA(0, 1, At, B1); PG8_BAR; PG8_SCHED;
            PG8_LDA(At, 1, 1); PG8_STAGE(PG8_SB(1, 0), b3, voffB); PG8_STAGE(PG8_SB(1, 1), b3 + bhstep, voffB); PG8_STAGE(PG8_SA(1, 0), a3, PG8_AV0);
            PG8_WAIT_V(8); PG8_WAIT_L(0); PG8_BAR; PG8_MMA(1, 0, At, B0); PG8_MMA(1, 1, At, B1); PG8_BAR; PG8_SCHED;
        }
        if constexpr (ALIGN_EPI) { if (wr == 0) PG8_BAR; }
        if (!cur.skip) { int t_ = tid; asm volatile("" : "+v"(t_)); const int fr_ = t_ & 15, fq_ = (t_ >> 4) & 3;
                         E(acc, cur, wr, wc, fr_, fq_, pre); }
        epi_st = cur.skip ? -1 : E.stores(cur);
        if (!has_next) break;
        if (!S.keep_acc(cur)) {
#pragma unroll
        for (int a = 0; a < 2; ++a)
#pragma unroll
            for (int b = 0; b < 2; ++b)
#pragma unroll
                for (int m = 0; m < 4; ++m)
#pragma unroll
                    for (int n = 0; n < 2; ++n) acc[a][b][m][n] = (f32x4){zero_, zero_, zero_, zero_};
        }
        cur = nxt; cA = nA; cB = nB; ++ui;
        if constexpr (ALIGN_EPI) { if (wr == 1) PG8_BAR; }
    }
    PG8_WAIT_V(0);
    if constexpr (!ALIGN_EPI) { if (wr == 0) PG8_BAR; }
    PG8_BAR;
#undef PG8_SA
#undef PG8_SB
#undef PG8_STAGE
#undef PG8_LDA
#undef PG8_LDB
#undef PG8_MMA
#undef PG8_CAT8
#undef PG8_WAIT_V
#undef PG8_WAIT_VC
#undef PG8_WAIT_L
#undef PG8_BAR
#undef PG8_SCHED
#undef PG8_ROWOFFS
#undef PG8_ROWRAW
#undef PG8_ROWFIN
#undef PG8_AV0
#undef PG8_AV1
}
}
#define EPI_ARGS f32x4 (&acc)[2][2][4][2], const pg8::Unit& u, int wr, int wc, int fr, int fq, const Pre& pre
#define EPI_NOPRE struct Pre {}; static constexpr int NPRE = 0; __device__ __forceinline__ void preload(Pre&, const pg8::Unit&, int, int, int, int) const {}
constexpr float LOG2E = 1.4426950408889634f;
constexpr float TINY_C2 = 0.125f * LOG2E;
constexpr float NA_QS = 0.17677669529663687f * LOG2E;

__device__ __forceinline__ u32x4 pack8(f32x4 a, f32x4 b) { u32x4 w; w.x = pg8::cvt_pk_bf16(a[0], a[1]); w.y = pg8::cvt_pk_bf16(a[2], a[3]); w.z = pg8::cvt_pk_bf16(b[0], b[1]); w.w = pg8::cvt_pk_bf16(b[2], b[3]); return w; }
__device__ __forceinline__ f32x4 gelu4(f32x4 v) { const f32x2 a = pg8::gelu_pk((f32x2){v[0], v[1]}), b = pg8::gelu_pk((f32x2){v[2], v[3]}); return (f32x4){a.x, a.y, b.x, b.y}; }
__device__ __forceinline__ float sigmoidf_(float x) { return __builtin_amdgcn_rcpf(1.f + __builtin_amdgcn_exp2f(-x * LOG2E)); }
__device__ __forceinline__ unsigned q4_u8(f32x4 v) { const unsigned a = (unsigned)(v[0] * 255.f + 0.5f), b = (unsigned)(v[1] * 255.f + 0.5f), c = (unsigned)(v[2] * 255.f + 0.5f), d = (unsigned)(v[3] * 255.f + 0.5f); return a | (b << 8) | (c << 16) | (d << 24); }
__device__ __forceinline__ f32x4 dq4_u8(unsigned w) { return (f32x4){(float)(w & 0xffu), (float)((w >> 8) & 0xffu), (float)((w >> 16) & 0xffu), (float)(w >> 24)} * (1.f / 255.f); }
__device__ __forceinline__ f32x4 sigmoid4(f32x4 v) { return (f32x4){sigmoidf_(v[0]), sigmoidf_(v[1]), sigmoidf_(v[2]), sigmoidf_(v[3])}; }
__device__ __forceinline__ void unpack8(u32x4 w, f32x4& a, f32x4& b) {
    a = (f32x4){__builtin_bit_cast(float, w.x << 16), __builtin_bit_cast(float, w.x & 0xffff0000u), __builtin_bit_cast(float, w.y << 16), __builtin_bit_cast(float, w.y & 0xffff0000u)};
    b = (f32x4){__builtin_bit_cast(float, w.z << 16), __builtin_bit_cast(float, w.z & 0xffff0000u), __builtin_bit_cast(float, w.w << 16), __builtin_bit_cast(float, w.w & 0xffff0000u)};
}

__device__ __forceinline__ unsigned pk4_fp8(f32x4 v) {
    const float L = 448.f;
    int d = __builtin_amdgcn_cvt_pk_fp8_f32(__builtin_amdgcn_fmed3f(v[0], -L, L), __builtin_amdgcn_fmed3f(v[1], -L, L), 0, false);
    d = __builtin_amdgcn_cvt_pk_fp8_f32(__builtin_amdgcn_fmed3f(v[2], -L, L), __builtin_amdgcn_fmed3f(v[3], -L, L), d, true);
    return (unsigned)d;
}
__device__ __forceinline__ void unpk8_fp8(u32x2 w, f32x4& a, f32x4& b) {
    const auto a0 = __builtin_amdgcn_cvt_pk_f32_fp8((int)w.x, false), a1 = __builtin_amdgcn_cvt_pk_f32_fp8((int)w.x, true), b0 = __builtin_amdgcn_cvt_pk_f32_fp8((int)w.y, false), b1 = __builtin_amdgcn_cvt_pk_f32_fp8((int)w.y, true);
    a = (f32x4){a0[0], a0[1], a1[0], a1[1]}; b = (f32x4){b0[0], b0[1], b1[0], b1[1]};
}
struct EpiMain {
    __device__ __forceinline__ int stores(const pg8::Unit& u) const { const int tile = u.pn + tile0; return (tile >= 4 && tile < 12) ? 8 : 16; }
    EPI_NOPRE
    static constexpr int MIN_STORES = 8;
    static constexpr bool PERM = true;
    int mode; const LAS float* bias; unsigned char* ws; void* dup; float sc; int tile0;
    __device__ __forceinline__ void operator()(EPI_ARGS) const {
        const int tile = u.pn + tile0;
        const int bcol0 = (mode == 0 ? tile : u.pn) * 256 + wc * 64 + 16 * fq;
#pragma unroll
        for (int bj = 0; bj < 2; ++bj)
#pragma unroll
            for (int n = 0; n < 2; ++n) { const f32x4 bv = *(const LAS f32x4*)(bias + bcol0 + bj * 8 + 4 * n);
#pragma unroll
                for (int ai = 0; ai < 2; ++ai)
#pragma unroll
                    for (int m = 0; m < 4; ++m) acc[ai][bj][m][n] = acc[ai][bj][m][n] * sc + bv; }
        const int row0 = u.pm * 256 + wr * 64 + fr;
        if (tile >= 4 && tile < 12) {
            unsigned char* O8 = ws + (tile < 8 ? WS_GA : WS_GB); const int col0 = (tile & 3) * 256 + wc * 64 + 16 * fq;
#pragma unroll
            for (int ai = 0; ai < 2; ++ai)
#pragma unroll
                for (int m = 0; m < 4; ++m) { u32x4 o; o.x = q4_u8(sigmoid4(acc[ai][0][m][0])); o.y = q4_u8(sigmoid4(acc[ai][0][m][1])); o.z = q4_u8(sigmoid4(acc[ai][1][m][0])); o.w = q4_u8(sigmoid4(acc[ai][1][m][1]));
                    *(u32x4*)(O8 + (size_t)(row0 + ai * 128 + m * 16) * 1024 + col0) = o; }
        } else if (tile < 4) {
            const size_t woff = WS_U;
            bf16_t* O = (bf16_t*)(ws + woff); const int col0 = (tile & 3) * 256 + wc * 64 + 16 * fq;
#pragma unroll
            for (int ai = 0; ai < 2; ++ai)
#pragma unroll
                for (int m = 0; m < 4; ++m) { bf16_t* rowp = O + (size_t)(row0 + ai * 128 + m * 16) * 1024 + col0;
#pragma unroll
                    for (int bj = 0; bj < 2; ++bj) { const u32x4 pv = pack8(acc[ai][bj][m][0], acc[ai][bj][m][1]); *(u32x4*)(rowp + bj * 8) = pv;
                        if constexpr ((PROBE_MASK >> 23) & 1) { *(u32x4*)((bf16_t*)dup + (rowp - O) + bj * 8) = pv; } } }
        } else {
            const size_t woff = tile < 14 ? WS_NQ : (mode == 0 ? WS_NK : WS_NKC);
            bf16_t* O = (bf16_t*)(ws + woff); const float sc = tile < 14 ? NA_QS : 1.f; const int col0 = (tile & 1) * 256 + wc * 64 + 16 * fq;
            if (tile >= 14 && mode == 0) {
#pragma unroll
                for (int ai = 0; ai < 2; ++ai)
#pragma unroll
                    for (int m = 0; m < 4; ++m) { const int row = row0 + ai * 128 + m * 16; const int b = row >> 11, s = row & 2047;
#pragma unroll
                        for (int bj = 0; bj < 2; ++bj) { const int col = col0 + bj * 8; *(u32x4*)(O + ((size_t)(b * 16 + (col >> 5)) * 2048 + s) * 32 + (col & 31)) = pack8(acc[ai][bj][m][0], acc[ai][bj][m][1]); } }
            } else {
#pragma unroll
            for (int ai = 0; ai < 2; ++ai)
#pragma unroll
                for (int m = 0; m < 4; ++m) { bf16_t* rowp = O + (size_t)(row0 + ai * 128 + m * 16) * 512 + col0;
#pragma unroll
                    for (int bj = 0; bj < 2; ++bj) *(u32x4*)(rowp + bj * 8) = pack8(acc[ai][bj][m][0] * sc, acc[ai][bj][m][1] * sc); }
            }
        }
    }
};
template <int MODE> struct EpiTT {
    __device__ __forceinline__ int stores(const pg8::Unit&) const { return MIN_STORES; }
    EPI_NOPRE
    static constexpr int MIN_STORES = 0;
    static constexpr bool PERM = true;
    const float* bias; bf16_t *TQ, *TKA, *TVA; const float* rope;
    __device__ __forceinline__ void operator()(EPI_ARGS) const {
        const int row0 = u.pm * 256 + wr * 64 + fr;
        const int axis = fq >> 1, c16 = 16 * fq;
#pragma unroll
        for (int bj = 0; bj < 2; ++bj)
#pragma unroll
            for (int n = 0; n < 2; ++n) { const f32x4 bv = *(const f32x4*)(bias + wc * 64 + c16 + 8 * bj + 4 * n);
#pragma unroll
                for (int ai = 0; ai < 2; ++ai)
#pragma unroll
                    for (int m = 0; m < 4; ++m) acc[ai][bj][m][n] += bv; }
        if (wc == 3) return;
#pragma unroll
        for (int ah = 0; ah < 4; ++ah) { const int ai = ah >> 1, mh = ah & 1;
            f32x4 cs[2][2][2];
            if (MODE == 0 && wc < 2) {
#pragma unroll
                for (int mm = 0; mm < 2; ++mm) { const int s = (row0 + ai * 128 + (2 * mh + mm) * 16) & 2047; const int pos = axis == 0 ? (s >> 6) : (s & 63);
#pragma unroll
                    for (int bj = 0; bj < 2; ++bj) { const float* rb = rope + ((axis * 64 + pos) * 16 + 8 * (fq & 1) + 4 * bj) * 2; cs[mm][bj][0] = *(const f32x4*)rb; cs[mm][bj][1] = *(const f32x4*)(rb + 4); } }
            }
#pragma unroll
            for (int mm = 0; mm < 2; ++mm) { const int m = 2 * mh + mm;
                const int row = row0 + ai * 128 + m * 16;
                int b, s; size_t kvrow;
                if (MODE == 0) { b = row >> 11; s = row & 2047; kvrow = (size_t)b * 2304 + s; } else { b = row >> 8; s = row & 255; kvrow = (size_t)b * 2304 + 2048 + s; }
#pragma unroll
                for (int bj = 0; bj < 2; ++bj) {
                    f32x4 v0 = acc[ai][bj][m][0], v1 = acc[ai][bj][m][1];
                    if (MODE == 0 && wc < 2) {
                        const f32x4 cs0 = cs[mm][bj][0], cs1 = cs[mm][bj][1];
                        v0 = (f32x4){v0[0] * cs0[0] - v0[1] * cs0[1], v0[1] * cs0[0] + v0[0] * cs0[1], v0[2] * cs0[2] - v0[3] * cs0[3], v0[3] * cs0[2] + v0[2] * cs0[3]};
                        v1 = (f32x4){v1[0] * cs1[0] - v1[1] * cs1[1], v1[1] * cs1[0] + v1[0] * cs1[1], v1[2] * cs1[2] - v1[3] * cs1[3], v1[3] * cs1[2] + v1[2] * cs1[3]};
                    }
                    if (wc == 0) { if (MODE == 0) *(u32x4*)(TQ + (size_t)row * 64 + c16 + 8 * bj) = pack8(v0 * TINY_C2, v1 * TINY_C2); }
                    else if (wc == 1) *(u32x4*)(TKA + kvrow * 64 + c16 + 8 * bj) = pack8(v0, v1);
                    else *(u32x4*)(TVA + kvrow * 64 + c16 + 8 * bj) = pack8(v0, v1);
                }
            }
            asm volatile("" ::: "memory");
        }
    }
};

struct EpiT {
    __device__ __forceinline__ int stores(const pg8::Unit&) const { return MIN_STORES; }
    EPI_NOPRE
    static constexpr int MIN_STORES = 16;
    static constexpr bool PERM = true;
    unsigned char* ws; const float* biasT; int ldc, pm_off, ctx; float sc;
    __device__ __forceinline__ void operator()(EPI_ARGS) const {
        const int rt = u.pm + pm_off;
        const int col0 = u.pn * 256 + wc * 64 + 16 * fq;
        const size_t woff = rt < 4 ? WS_VT : (ctx ? WS_NVCT : WS_NVT);
        bf16_t* O = (bf16_t*)(ws + woff);
        float bvv[2][4];
#pragma unroll
        for (int ai = 0; ai < 2; ++ai)
#pragma unroll
            for (int m = 0; m < 4; ++m) bvv[ai][m] = biasT[rt * 256 + ai * 128 + wr * 64 + m * 16 + fr];
#pragma unroll
        for (int ai = 0; ai < 2; ++ai)
#pragma unroll
            for (int m = 0; m < 4; ++m) {
                const int ch = rt * 256 + ai * 128 + wr * 64 + m * 16 + fr; const float bv = bvv[ai][m];
#pragma unroll
                for (int bj = 0; bj < 2; ++bj) { f32x4 v0 = acc[ai][bj][m][0] * sc + bv, v1 = acc[ai][bj][m][1] * sc + bv;
                    if (rt < 4) { v0 = gelu4(v0); v1 = gelu4(v1); }
                    const int t = col0 + bj * 8;
                    size_t idx;
                    if (rt < 4) idx = (size_t)(t >> 7) * (1024 * 128) + (size_t)ch * 128 + (t & 127);
                    else if (!ctx) { const int cn = ch - 1024, b = t >> 11, s = t & 2047; idx = ((size_t)((b * 16 + (cn >> 5)) * 32 + (s >> 6)) * 32 + (cn & 31)) * 64 + (s & 63); }
                    else idx = (size_t)(ch - 1024) * ldc + t;
                    *(u32x4*)(O + idx) = pack8(v0, v1); } }
    }
};

struct EpiGate {
    __device__ __forceinline__ int stores(const pg8::Unit&) const { return MIN_STORES; }
    EPI_NOPRE
    static constexpr int MIN_STORES = 16;
    static constexpr bool PERM = true;
    const unsigned char* gate; const bf16_t* addend; bf16_t* out;
    __device__ __forceinline__ void operator()(EPI_ARGS) const {
        const int row0 = u.pm * 256 + wr * 64 + fr, col0 = u.pn * 256 + wc * 64 + 16 * fq;
#pragma unroll
        for (int ai = 0; ai < 2; ++ai) {
            u32x4 gv[4], av[4][2];
#pragma unroll
            for (int m = 0; m < 4; ++m) { const size_t off = (size_t)(row0 + ai * 128 + m * 16) * 1024 + col0; gv[m] = *(const u32x4*)(gate + off);
#pragma unroll
                for (int bj = 0; bj < 2; ++bj) av[m][bj] = addend ? *(const u32x4*)(addend + off + bj * 8) : (u32x4){0u, 0u, 0u, 0u}; }
#pragma unroll
            for (int m = 0; m < 4; ++m) { const size_t off = (size_t)(row0 + ai * 128 + m * 16) * 1024 + col0;
#pragma unroll
                for (int bj = 0; bj < 2; ++bj) { f32x4 a0, a1; unpack8(av[m][bj], a0, a1);
                    *(u32x4*)(out + off + bj * 8) = pack8(a0 + dq4_u8(gv[m][2 * bj]) * acc[ai][bj][m][0], a1 + dq4_u8(gv[m][2 * bj + 1]) * acc[ai][bj][m][1]); } }
            asm volatile("" ::: "memory");
        }
    }
};

struct EpiMerge {
    EPI_NOPRE
    static constexpr int MIN_STORES = 0;
    static constexpr bool PERM = true;
    const unsigned char* ga; const unsigned char* gb; bf16_t* out;
    __device__ __forceinline__ int stores(const pg8::Unit& u) const { return u.e ? 16 : 0; }
    __device__ __forceinline__ static f32x4 codes(unsigned w) { return (f32x4){(float)(w & 0xffu), (float)((w >> 8) & 0xffu), (float)((w >> 16) & 0xffu), (float)(w >> 24)}; }
    __device__ __forceinline__ static f32x4 max4(f32x4 v, float lo) { return (f32x4){fmaxf(v[0], lo), fmaxf(v[1], lo), fmaxf(v[2], lo), fmaxf(v[3], lo)}; }
    __device__ __forceinline__ static f32x4 rcp4(f32x4 v) { return (f32x4){__builtin_amdgcn_rcpf(v[0]), __builtin_amdgcn_rcpf(v[1]), __builtin_amdgcn_rcpf(v[2]), __builtin_amdgcn_rcpf(v[3])}; }
    __device__ __forceinline__ void operator()(EPI_ARGS) const {
        const int row0 = u.pm * 256 + wr * 64 + fr, col0 = u.pn * 256 + wc * 64 + 16 * fq;
        if (u.e == 0) {
#pragma unroll
            for (int ai = 0; ai < 2; ++ai) { u32x4 va[4], vb[4];
#pragma unroll
                for (int m = 0; m < 4; ++m) { const size_t off = (size_t)(row0 + ai * 128 + m * 16) * 1024 + col0; va[m] = *(const u32x4*)(ga + off); vb[m] = *(const u32x4*)(gb + off); }
#pragma unroll
                for (int m = 0; m < 4; ++m)
#pragma unroll
                    for (int bj = 0; bj < 2; ++bj)
#pragma unroll
                        for (int n = 0; n < 2; ++n) acc[ai][bj][m][n] = acc[ai][bj][m][n] * (codes(vb[m][2 * bj + n]) * rcp4(max4(codes(va[m][2 * bj + n]), 0.5f))); }
        } else {
#pragma unroll
            for (int ai = 0; ai < 2; ++ai) { u32x4 va[4];
#pragma unroll
                for (int m = 0; m < 4; ++m) va[m] = *(const u32x4*)(ga + (size_t)(row0 + ai * 128 + m * 16) * 1024 + col0);
#pragma unroll
                for (int m = 0; m < 4; ++m) { const size_t off = (size_t)(row0 + ai * 128 + m * 16) * 1024 + col0;
#pragma unroll
                    for (int bj = 0; bj < 2; ++bj) *(u32x4*)(out + off + bj * 8) = pack8(max4(codes(va[m][2 * bj]), 0.5f) * (1.f / 255.f) * acc[ai][bj][m][0], max4(codes(va[m][2 * bj + 1]), 0.5f) * (1.f / 255.f) * acc[ai][bj][m][1]); }
                asm volatile("" ::: "memory"); }
        }
    }
};

struct EpiXmid {
    __device__ __forceinline__ int stores(const pg8::Unit&) const { return MIN_STORES; }
    EPI_NOPRE
    static constexpr int MIN_STORES = 16;
    static constexpr bool PERM = true;
    const float* x; const float* mod; bf16_t* xmid; float* ssq;
    __device__ __forceinline__ void operator()(EPI_ARGS) const {
        const int row0 = u.pm * 256 + wr * 64 + fr, col0 = u.pn * 256 + wc * 64 + 16 * fq;
        const float* gm = mod + (size_t)(u.pm >> 3) * 6144 + 2048;
        f32x4 gv[2][2];
#pragma unroll
        for (int bj = 0; bj < 2; ++bj)
#pragma unroll
            for (int n = 0; n < 2; ++n) gv[bj][n] = *(const f32x4*)(gm + col0 + bj * 8 + n * 4);
#pragma unroll
        for (int ai = 0; ai < 2; ++ai)
#pragma unroll
            for (int mh = 0; mh < 2; ++mh) {
                f32x4 xv[2][2][2];
#pragma unroll
                for (int mm = 0; mm < 2; ++mm) { const size_t off = (size_t)(row0 + ai * 128 + (2 * mh + mm) * 16) * 1024 + col0;
#pragma unroll
                    for (int bj = 0; bj < 2; ++bj) { xv[mm][bj][0] = *(const f32x4*)(x + off + bj * 8); xv[mm][bj][1] = *(const f32x4*)(x + off + bj * 8 + 4); } }
#pragma unroll
                for (int mm = 0; mm < 2; ++mm) { const int m = 2 * mh + mm; const size_t off = (size_t)(row0 + ai * 128 + m * 16) * 1024 + col0; float ss = 0.f;
#pragma unroll
                    for (int bj = 0; bj < 2; ++bj) { const f32x4 p0 = xv[mm][bj][0] + gv[bj][0] * acc[ai][bj][m][0], p1 = xv[mm][bj][1] + gv[bj][1] * acc[ai][bj][m][1];
                        ss += ((p0.x * p0.x + p0.y * p0.y) + (p0.z * p0.z + p0.w * p0.w)) + ((p1.x * p1.x + p1.y * p1.y) + (p1.z * p1.z + p1.w * p1.w));
                        *(u32x4*)(xmid + off + bj * 8) = pack8(p0, p1); }
                    ss += __shfl_xor(ss, 16); ss += __shfl_xor(ss, 32);
                    if (fq == 0) ssq[(size_t)(row0 + ai * 128 + m * 16) * 16 + u.pn * 4 + wc] = ss; }
                asm volatile("" ::: "memory");
            }
    }
};

struct EpiMoeGU {
    __device__ __forceinline__ int stores(const pg8::Unit&) const { return MIN_STORES; }
    EPI_NOPRE
    static constexpr int MIN_STORES = 8;
    static constexpr bool PERM = true;
    bf16_t* act;
    __device__ __forceinline__ void operator()(EPI_ARGS) const {
        const int row0 = u.pm * 256 + wr * 64 + fr, col0 = u.pn * 128 + wc * 32 + 8 * fq;
#pragma unroll
        for (int ai = 0; ai < 2; ++ai)
#pragma unroll
            for (int m = 0; m < 4; ++m) { f32x4 o[2];
#pragma unroll
                for (int n = 0; n < 2; ++n) { const f32x4 g = acc[ai][0][m][n] * (1.f / 64.f), up = acc[ai][1][m][n] * (1.f / 64.f); o[n] = g * sigmoid4(g) * up; }
                *(u32x2*)((unsigned char*)act + (size_t)(row0 + ai * 128 + m * 16) * 256 + col0) = (u32x2){pk4_fp8(o[0] * 8.f), pk4_fp8(o[1] * 8.f)}; }
    }
};

struct MoeLists { const int* crow; const float* w; const unsigned* cnt; int gt; };
__device__ __forceinline__ bool moe_lookup(const MoeLists& L, int e, int idx, int& crow, float& w) {
    if (e == 64) { crow = idx * 9 + 8; w = 1.f; return true; }
    if (idx >= (int)L.cnt[e]) { crow = 0; w = 0.f; return false; }
    crow = L.crow[(size_t)e * GCAP + idx]; w = L.w[(size_t)e * GCAP + idx]; return true;
}
struct EpiMoeDown {
    __device__ __forceinline__ int stores(const pg8::Unit&) const { return MIN_STORES; }
    static constexpr int MIN_STORES = 0;
    static constexpr bool PERM = true;
    static constexpr int NPRE = 4;
    struct Pre {};
    unsigned char* C; MoeLists L; LAS unsigned char* lds;
    __device__ __forceinline__ void preload(Pre&, const pg8::Unit& u, int wr, int wc, int fr, int fq) const {
        const int ec = min(u.e, 63), lane = lane_id_();
        LAS unsigned char* wl = lds + EPL_LDS + (wr * 4 + wc) * 1024;
#pragma unroll
        for (int ai = 0; ai < 2; ++ai) { const size_t off = (size_t)ec * GCAP + min(u.r0 + ai * 128 + wr * 64 + lane, GCAP - 1);
            __builtin_amdgcn_global_load_lds((const unsigned*)(L.crow + off), (LAS unsigned*)(wl + ai * 256), 4, 0, 0);
            __builtin_amdgcn_global_load_lds((const unsigned*)(L.w + off), (LAS unsigned*)(wl + 512 + ai * 256), 4, 0, 0); }
    }
    __device__ __forceinline__ void operator()(EPI_ARGS) const {
        const int col0 = u.pn * 256 + wc * 64 + 16 * fq;
        const LAS unsigned char* wl = lds + EPL_LDS + (wr * 4 + wc) * 1024;
#pragma unroll
        for (int ai = 0; ai < 2; ++ai)
#pragma unroll
            for (int m = 0; m < 4; ++m) { const int idx = u.r0 + ai * 128 + wr * 64 + m * 16 + fr;
                if (idx < u.cnt) {
                    if (u.e == 64) { unsigned char* tp = C + (size_t)idx * CROW_BYTES;
                        const float sc_ = 1.f / 512.f;
                        u32x4 o; o.x = pk4_fp8(acc[ai][0][m][0] * sc_); o.y = pk4_fp8(acc[ai][0][m][1] * sc_); o.z = pk4_fp8(acc[ai][1][m][0] * sc_); o.w = pk4_fp8(acc[ai][1][m][1] * sc_); *(u32x4*)(tp + 8 * 1024 + col0) = o;
                    } else { const int crow = *(const LAS int*)(wl + ai * 256 + (m * 16 + fr) * 4); const float w = *(const LAS float*)(wl + 512 + ai * 256 + (m * 16 + fr) * 4) * (1.f / 512.f);
                        const int tl = crow / 9, k = crow - tl * 9; unsigned char* tp = C + (size_t)tl * CROW_BYTES;
                        u32x4 o; o.x = pk4_fp8(acc[ai][0][m][0] * w); o.y = pk4_fp8(acc[ai][0][m][1] * w); o.z = pk4_fp8(acc[ai][1][m][0] * w); o.w = pk4_fp8(acc[ai][1][m][1] * w); *(u32x4*)(tp + k * 1024 + col0) = o; }
                } }
    }
};

struct MoeOrder {
    const volatile LAS unsigned* blk; int nblk, NT, G, c; MoeLists L; int K2, hb;
    __device__ __forceinline__ bool next(int i, pg8::Unit& u) const {
        const int Lq = i * G + c; if (Lq >= nblk * NT) return false;
        const int j = Lq / NT; const unsigned v = (unsigned)__builtin_amdgcn_readfirstlane((int)blk[j]);
        u.pm = j; u.pn = Lq - j * NT; u.e = (int)(v >> 16); u.r0 = (int)(v & 0xffffu) * 256; u.skip = 0;
        u.cnt = u.e == 64 ? L.gt : __builtin_amdgcn_readfirstlane((int)blk[MOE_MAXBLK + 66 + min(u.e, 63)]); return true;
    }
    __device__ __forceinline__ int rowraw(const pg8::Unit& u, int r) const {
        return L.crow[(size_t)min(u.e, 63) * GCAP + min(u.r0 + r, GCAP - 1)];
    }
    __device__ __forceinline__ unsigned rowfin(const pg8::Unit& u, int r, int raw) const {
        const int idx = u.r0 + r;
        const int tokv = u.e == 64 ? hb + idx : hb + raw / 9;
        const int tok = idx < u.cnt ? tokv : MTOK;
        return (unsigned)tok * (unsigned)K2;
    }
    __device__ __forceinline__ unsigned rowoff(const pg8::Unit& u, int r) const { return rowfin(u, r, rowraw(u, r)); }
    static constexpr int NRAW = 4;
    __device__ __forceinline__ int nt(const pg8::Unit&, int ntdef) const { return ntdef; }
    __device__ __forceinline__ bool keep_acc(const pg8::Unit&) const { return false; }
};

struct Frame {
    LAS unsigned char* lds; volatile LAS unsigned* MISC; unsigned* ctl;
    int tid, lane, wave, vcu, G, cid;
};
#define LDS_WAIT() asm volatile("s_waitcnt lgkmcnt(0)" ::: "memory")

__device__ __forceinline__ void p0_adaln(Frame& F, const float* c, const float* c_ctx, const float* w_ada, const float* b_ada, float* mod) {
    LAS float* s = (LAS float*)F.lds;
    for (int cb = F.vcu; cb < 192; cb += F.G) {
        __syncthreads();
        for (int i = F.tid; i < 33 * 1024; i += NTHREADS) { const float v = (i < 32 * 1024) ? c[i] : c_ctx[i - 32 * 1024]; s[i] = v / (1.f + __expf(-v)); }
        __syncthreads();
        const int col = F.lane & 31, kh = F.lane >> 5;
        float acc[33];
#pragma unroll
        for (int b = 0; b < 33; ++b) acc[b] = 0.f;
#pragma unroll 1
        for (int i0 = 0; i0 < 64; i0 += 8) {
            float wv[8];
#pragma unroll
            for (int j = 0; j < 8; ++j) wv[j] = w_ada[(size_t)(128 * F.wave + 2 * (i0 + j) + kh) * 6144 + 32 * cb + col];
#pragma unroll
            for (int j = 0; j < 8; ++j) { const int k = 128 * F.wave + 2 * (i0 + j) + kh;
#pragma unroll
                for (int b = 0; b < 33; ++b) acc[b] += s[b * 1024 + k] * wv[j]; }
        }
#pragma unroll
        for (int b = 0; b < 33; ++b) acc[b] += __shfl_xor(acc[b], 32);
        __syncthreads();
        if (F.lane < 32) {
#pragma unroll
            for (int b = 0; b < 33; ++b) s[(F.wave * 33 + b) * 32 + col] = acc[b];
        }
        __syncthreads();
        for (int o = F.tid; o < 33 * 32; o += NTHREADS) { const int b = o >> 5, cc = o & 31; float t = 0.f;
#pragma unroll
            for (int w = 0; w < 8; ++w) t += s[(w * 33 + b) * 32 + cc];
            mod[b * 6144 + 32 * cb + cc] = t + b_ada[32 * cb + cc]; }
    }
    __syncthreads();
}

struct TrItem { const float* W; bf16_t* WT; int ldw, ldk, k0, n0, drow0, ilv, f8; unsigned char* W8; };
__device__ __forceinline__ void tr_load(const TrItem& t, float (&wv)[32], int lane) {
#pragma unroll
    for (int i = 0; i < 32; ++i) wv[i] = t.W[(size_t)(t.k0 + 2 * i + (lane >> 5)) * t.ldw + t.n0 + (lane & 31)];
}
__device__ __forceinline__ void tr_store(const TrItem& t, const float (&wv)[32], LAS float* scr, int lane) {
#pragma unroll
    for (int i = 0; i < 32; ++i) scr[(2 * i + (lane >> 5)) * 33 + (lane & 31)] = wv[i];
    LDS_WAIT(); asm volatile("" ::: "memory");
    const int c = lane & 7;
#pragma unroll
    for (int j = 0; j < 4; ++j) { const int n = (lane >> 3) + 8 * j; const LAS float* s = scr + (8 * c) * 33 + n;
        if (t.f8) { const int drow = t.drow0 + (t.ilv == 1 ? 16 * (n >> 3) + (n & 7) : t.ilv == 2 ? 2 * (n & 15) + (n >> 4) : n);
            const unsigned lo = pk4_fp8((f32x4){s[0 * 33], s[1 * 33], s[2 * 33], s[3 * 33]} * 64.f), hi = pk4_fp8((f32x4){s[4 * 33], s[5 * 33], s[6 * 33], s[7 * 33]} * 64.f);
            *(u32x2*)((unsigned char*)t.WT + (size_t)drow * t.ldk + t.k0 + 8 * c) = (u32x2){lo, hi}; continue; }
        if (t.W8) { const int drow = t.drow0 + n;
            const unsigned lo = pk4_fp8((f32x4){s[0 * 33], s[1 * 33], s[2 * 33], s[3 * 33]} * 64.f), hi = pk4_fp8((f32x4){s[4 * 33], s[5 * 33], s[6 * 33], s[7 * 33]} * 64.f);
            *(u32x2*)(t.W8 + (size_t)drow * 1024 + t.k0 + 8 * c) = (u32x2){lo, hi}; }
        u32x4 o; o.x = pk2(s[0 * 33], s[1 * 33]); o.y = pk2(s[2 * 33], s[3 * 33]); o.z = pk2(s[4 * 33], s[5 * 33]); o.w = pk2(s[6 * 33], s[7 * 33]);
        *(u32x4*)(t.WT + (size_t)(t.drow0 + (t.ilv == 1 ? 16 * (n >> 3) + (n & 7) : t.ilv == 2 ? 2 * (n & 15) + (n >> 4) : n)) * t.ldk + t.k0 + 8 * c) = o; }
    LDS_WAIT(); asm volatile("" ::: "memory");
}
struct TrJob { const float* W; bf16_t* WT; int ldw, K, ncols, n0, drow0, nrep, mode; size_t wrs, wtrs; int ldk, f8; unsigned char* W8; };
__device__ __forceinline__ int trjob_items(const TrJob& j) { return j.nrep * (j.K / 64) * (j.ncols / 32); }
__device__ __forceinline__ TrItem trjob_item(const TrJob& j, int item) {
    const int per = (j.K / 64) * (j.ncols / 32); const int rep = item / per, r = item - rep * per; const int nblk = j.ncols / 32, kb = r / nblk, nb = r - kb * nblk;
    int drow = j.drow0 + 32 * nb;
    if (j.mode == 1 || j.mode == 2) { const int c0 = 32 * nb; drow = j.drow0 + 256 * (c0 >> 7) + 64 * ((c0 & 127) >> 5) + (j.mode == 2 ? 8 : 0); }
    return TrItem{j.W + (size_t)rep * j.wrs, j.WT + (size_t)rep * j.wtrs, j.ldw, j.ldk ? j.ldk : j.K, 64 * kb, j.n0 + 32 * nb, drow, j.mode == 3 ? 2 : (j.mode != 0 ? 1 : 0), j.f8, j.W8};
}

__device__ __forceinline__ void norm_mod_rows(const float* x0, bf16_t* o0, int nrows, const float* g, const float* shift, const float* scale, int lane, unsigned char* o8f = nullptr) {
    f32x4 gs[4], sh[4];
#pragma unroll
    for (int j = 0; j < 4; ++j) { gs[j] = ((const f32x4*)g)[lane + 64 * j] * (((const f32x4*)scale)[lane + 64 * j] + 1.f); sh[j] = ((const f32x4*)shift)[lane + 64 * j]; }
#pragma unroll 1
    for (int r0 = 0; r0 < nrows; r0 += 4) {
        f32x4 v[4][4]; float s[4];
#pragma unroll
        for (int q = 0; q < 4; ++q)
#pragma unroll
            for (int j = 0; j < 4; ++j) v[q][j] = ((const f32x4*)(x0 + (size_t)(r0 + q) * DM))[lane + 64 * j];
#pragma unroll
        for (int q = 0; q < 4; ++q) { s[q] = 0.f;
#pragma unroll
            for (int j = 0; j < 4; ++j) s[q] += (v[q][j].x * v[q][j].x + v[q][j].y * v[q][j].y) + (v[q][j].z * v[q][j].z + v[q][j].w * v[q][j].w); }
#pragma unroll
        for (int o = 1; o < 64; o <<= 1) {
#pragma unroll
            for (int q = 0; q < 4; ++q) s[q] += __shfl_xor(s[q], o); }
#pragma unroll
        for (int q = 0; q < 4; ++q) { const float r = 1.f / sqrtf(s[q] * (1.f / DM) + NORM_EPS);
            u32x2* o8 = (u32x2*)(o0 + (size_t)(r0 + q) * DM) + lane;
#pragma unroll
            for (int j = 0; j < 4; ++j) { const f32x4 h = v[q][j] * r * gs[j] + sh[j]; u32x2 w; w.x = pk2(h.x, h.y); w.y = pk2(h.z, h.w); o8[64 * j] = w;
                if (o8f) ((unsigned*)(o8f + (size_t)(r0 + q) * DM))[lane + 64 * j] = pk4_fp8(h); } }
    }
}

namespace tattn {
using f32x16 = __attribute__((ext_vector_type(16))) float;
using s16x4 = __attribute__((ext_vector_type(4))) short;
constexpr int TP = 64;
constexpr int NW = 8, QBLK = 32, QB = QBLK * NW, KVBLK = 64;
__device__ __forceinline__ int crow(int r, int hi) { return (r & 3) + 8 * (r >> 2) + 4 * hi; }
#define SBAR() __builtin_amdgcn_sched_barrier(0)
constexpr int NSLOT = 3, SLOTB = 8192;
constexpr int LDS_K = 0, LDS_V = NSLOT * SLOTB, LDS_WS = 2 * NSLOT * SLOTB, LDS_OST = LDS_WS + NW * 64 * 4, LDS_BYTES_T = LDS_OST + NW * 4096;
__device__ __forceinline__ void glds16(const void* gsrc, unsigned lds_dst) { unsigned keep;
    asm volatile("s_mov_b32 %0, m0\n\ts_mov_b32 m0, %2\n\ts_nop 0\n\tglobal_load_lds_dwordx4 %1, off\n\ts_mov_b32 m0, %0" : "=&s"(keep) : "v"(gsrc), "s"(lds_dst) : "memory"); }
__device__ __forceinline__ float max3f(float a, float b, float c) { float r; asm("v_max3_f32 %0, %1, %2, %3" : "=v"(r) : "v"(a), "v"(b), "v"(c)); return r; }
__device__ __forceinline__ float max2f(float a, float b) { float r; asm("v_max_f32_e32 %0, %1, %2" : "=v"(r) : "v"(a), "v"(b)); return r; }
__device__ __forceinline__ float fadd_s(float a, float b) { float r; asm("v_add_f32_e32 %0, %1, %2" : "=v"(r) : "v"(a), "v"(b)); return r; }
__device__ __forceinline__ float fsub_s(float a, float b) { float r; asm("v_sub_f32_e32 %0, %1, %2" : "=v"(r) : "v"(a), "v"(b)); return r; }
typedef float f32x2_t __attribute__((ext_vector_type(2))); typedef __bf16 bf16x2_t __attribute__((ext_vector_type(2)));
__device__ __forceinline__ unsigned cvtpk_s(float lo, float hi) { f32x2_t v = {lo, hi}; bf16x2_t b = __builtin_convertvector(v, bf16x2_t); return __builtin_bit_cast(unsigned, b); }
#define WAIT_BAR(N) asm volatile("s_waitcnt vmcnt(" #N ") lgkmcnt(0)\n\ts_barrier" ::: "memory")
__device__ __forceinline__ void qkt(f32x16& p0, f32x16& p1, const char* Kslot, const bf16x8* qr, const f32x16& negm, int r32, int hi) {
    const char* kb = Kslot + hi * 1024 + r32 * 16;
#pragma unroll
    for (int d0 = 0; d0 < 4; ++d0) {
        const bf16x8 b0 = *reinterpret_cast<const bf16x8*>(kb + d0 * 2048);
        const bf16x8 b1 = *reinterpret_cast<const bf16x8*>(kb + d0 * 2048 + 512);
        if (d0 == 0) { p0 = __builtin_amdgcn_mfma_f32_32x32x16_bf16(b0, qr[0], negm, 0, 0, 0); p1 = __builtin_amdgcn_mfma_f32_32x32x16_bf16(b1, qr[0], negm, 0, 0, 0); }
        else { p0 = __builtin_amdgcn_mfma_f32_32x32x16_bf16(b0, qr[d0], p0, 0, 0, 0); p1 = __builtin_amdgcn_mfma_f32_32x32x16_bf16(b1, qr[d0], p1, 0, 0, 0); } }
}
typedef __attribute__((address_space(3))) const char* lds_cptr;
typedef short v4i16_t __attribute__((ext_vector_type(4)));
__device__ __forceinline__ void kload8(bf16x8* kf, lds_cptr kp) {
    kf[0] = *(const __attribute__((address_space(3))) bf16x8*)(kp);        kf[1] = *(const __attribute__((address_space(3))) bf16x8*)(kp + 512);
    kf[2] = *(const __attribute__((address_space(3))) bf16x8*)(kp + 2048); kf[3] = *(const __attribute__((address_space(3))) bf16x8*)(kp + 2560);
    kf[4] = *(const __attribute__((address_space(3))) bf16x8*)(kp + 4096); kf[5] = *(const __attribute__((address_space(3))) bf16x8*)(kp + 4608);
    kf[6] = *(const __attribute__((address_space(3))) bf16x8*)(kp + 6144); kf[7] = *(const __attribute__((address_space(3))) bf16x8*)(kp + 6656);
}
__device__ __forceinline__ void kload2(bf16x8* kf, lds_cptr kp, int j) { kf[2 * j] = *(const __attribute__((address_space(3))) bf16x8*)(kp + j * 2048); kf[2 * j + 1] = *(const __attribute__((address_space(3))) bf16x8*)(kp + j * 2048 + 512); }
__device__ __forceinline__ s16x4 vtr(lds_cptr p) { return __builtin_bit_cast(s16x4, __builtin_amdgcn_ds_read_tr16_b64_v4i16((__attribute__((address_space(3))) v4i16_t*)p)); }
__device__ __forceinline__ float rowmax(const f32x16& p0, const f32x16& p1) {
    float a = max3f(p0[0], p0[1], p1[0]), b = max3f(p0[2], p0[3], p1[1]); a = max3f(a, p1[2], p1[3]);
#pragma unroll
    for (int r = 4; r < 16; r += 4) { a = max3f(a, p0[r], p0[r + 1]); b = max3f(b, p0[r + 2], p0[r + 3]); a = max3f(a, p1[r], p1[r + 1]); b = max3f(b, p1[r + 2], p1[r + 3]); }
    const float m = max2f(a, b);
    auto rr = __builtin_amdgcn_permlane32_swap(__float_as_uint(m), __float_as_uint(m), false, false);
    return max2f(__uint_as_float(rr[0]), __uint_as_float(rr[1]));
}
__device__ __forceinline__ void pv(f32x16* o, int vb, bf16x8 pa0, bf16x8 pa1, bf16x8 pa2, bf16x8 pa3) {
#pragma unroll
    for (int d0 = 0; d0 < 2; ++d0) { s16x4 lo[4], hi[4];
#pragma unroll
        for (int ks = 0; ks < 4; ++ks) {
            asm volatile("ds_read_b64_tr_b16 %0,%1 offset:%c2" : "=&v"(lo[ks]) : "v"(vb), "i"(d0 * 4096 + ks * 1024) : "memory");
            asm volatile("ds_read_b64_tr_b16 %0,%1 offset:%c2" : "=&v"(hi[ks]) : "v"(vb), "i"(d0 * 4096 + ks * 1024 + 512) : "memory"); }
        asm volatile("s_waitcnt lgkmcnt(0)" ::: "memory"); SBAR();
#define PK(k) (bf16x8){lo[k][0], lo[k][1], lo[k][2], lo[k][3], hi[k][0], hi[k][1], hi[k][2], hi[k][3]}
        o[d0] = __builtin_amdgcn_mfma_f32_32x32x16_bf16(pa0, PK(0), o[d0], 0, 0, 0);
        o[d0] = __builtin_amdgcn_mfma_f32_32x32x16_bf16(pa1, PK(1), o[d0], 0, 0, 0);
        o[d0] = __builtin_amdgcn_mfma_f32_32x32x16_bf16(pa2, PK(2), o[d0], 0, 0, 0);
        o[d0] = __builtin_amdgcn_mfma_f32_32x32x16_bf16(pa3, PK(3), o[d0], 0, 0, 0);
#undef PK
    }
}
template <int THRL, int NKEYS> __device__ __forceinline__ void attn_unit(const bf16_t* Qu, const bf16_t* __restrict__ Kb, const bf16_t* __restrict__ Vb, bf16_t* Ou, char* shm) {
    const int tid = TIDX(), lane = tid & 63, r32 = lane & 31, hi = lane >> 5; const int wid = __builtin_amdgcn_readfirstlane(tid >> 6);
    const bf16_t* Qw = Qu + (long)(wid * QBLK) * TP;
    const bf16_t *Kh = Kb, *Vh = Vb;
    const unsigned lds0 = (unsigned)(uintptr_t)shm;
    float* wsf = (float*)(shm + LDS_WS) + wid * 64;
    const bf16_t* ksrc = Kh + (long)lane * TP + wid * 8;
    const bf16_t* vsrc = Vh + (long)(16 * (wid & 3) + (lane >> 2)) * TP + (wid >> 2) * 32 + (lane & 3) * 8;
    const unsigned kdst = lds0 + LDS_K + wid * 1024, vdst = lds0 + LDS_V + wid * 1024;
#define DMA_K(t, slot) glds16(ksrc + (long)(t) * KVBLK * TP, (unsigned)__builtin_amdgcn_readfirstlane(kdst + (slot)))
#define DMA_V(t, slot) glds16(vsrc + (long)(t) * KVBLK * TP, (unsigned)__builtin_amdgcn_readfirstlane(vdst + (slot)))
    const int vb0 = (int)(lds0 + LDS_V) + ((lane >> 4) & 1) * 32 + (lane & 3) * 8 + (4 * hi + ((lane & 15) >> 2)) * 64;
    const char* Kbase = shm + LDS_K; bf16x8 kf[8];
    const lds_cptr shm3 = (lds_cptr)shm; const lds_cptr kp0 = shm3 + LDS_K + hi * 1024 + r32 * 16; const lds_cptr vp0 = shm3 + LDS_V + ((lane >> 4) & 1) * 32 + (lane & 3) * 8 + (4 * hi + ((lane & 15) >> 2)) * 64;
    constexpr int NT = NKEYS / KVBLK;
    static_assert(NT % 2 == 0 && NT >= 8, "NT even");
    DMA_K(0, 0); DMA_V(0, 0); DMA_K(1, SLOTB);
    bf16x8 qr[4];
#pragma unroll
    for (int d0 = 0; d0 < 4; ++d0) qr[d0] = *reinterpret_cast<const bf16x8*>(&Qw[(long)r32 * TP + d0 * 16 + hi * 8]);
    float mhat = 0.f, l_reg = 0.f; f32x16 o[2]; o[0] = f32x16{}; o[1] = f32x16{}; f32x16 negm = f32x16{}; asm volatile("" : "+v"(negm));
    bool resc = false;
#define START(P0, P1) do { const float rm = rowmax(P0, P1); resc = false; \
    { const float dl = rm; mhat = fadd_s(mhat, dl); \
      _Pragma("unroll") for (int r = 0; r < 16; ++r) { P0[r] = fsub_s(P0[r], dl); P1[r] = fsub_s(P1[r], dl); } \
      _Pragma("unroll") for (int r = 0; r < 16; ++r) negm[r] = -mhat; asm volatile("" : "+v"(negm)); } \
    _Pragma("unroll") for (int r = 0; r < 16; ++r) P0[r] = __builtin_amdgcn_exp2f(P0[r]); } while (0)
#define RESC() do { if (resc) { asm volatile("s_waitcnt lgkmcnt(0)" ::: "memory"); \
      _Pragma("unroll") for (int d_ = 0; d_ < 2; ++d_) _Pragma("unroll") for (int r = 0; r < 16; ++r) o[d_][r] *= wsf[crow(r, hi)]; } } while (0)
    f32x16 pA0, pA1, pB0, pB1;
    int sl_prev = 0, sl_cur = 0, sl_next = SLOTB;
#define ROT() do { sl_prev = sl_cur; sl_cur = sl_next; sl_next = (sl_next == (NSLOT - 1) * SLOTB) ? 0 : sl_next + SLOTB; } while (0)
    DMA_K(2, 2 * SLOTB);
    WAIT_BAR(3);
    qkt(pA0, pA1, Kbase, qr, negm, r32, hi); asm volatile("s_nop 15\n\ts_nop 7" : "+v"(pA0), "+v"(pA1));
    START(pA0, pA1);
    _Pragma("unroll") for (int r = 0; r < 16; ++r) pA1[r] = __builtin_amdgcn_exp2f(pA1[r]);
    WAIT_BAR(0);
    DMA_K(3, 0); DMA_V(1, SLOTB);
    ROT();
    kload8(kf, kp0 + sl_cur);
    WAIT_BAR(2);
    s16x4 vlo[8], vhi[8]; u32x4 pw0, pw1, pw2, pw3;
#define PKW(P, B) cvtpk_s(P[B], P[B + 1])
#define PAF(k) __builtin_bit_cast(bf16x8, pw##k)
#define VFR(i) (bf16x8){vlo[i][0], vlo[i][1], vlo[i][2], vlo[i][3], vhi[i][0], vhi[i][1], vhi[i][2], vhi[i][3]}
#define PIN(x) asm volatile("" : "+v"(x))
#define MX3(a, b, c) __builtin_fmaxf(__builtin_fmaxf((a), (b)), (c))
#define GAPA(MF, A0, A1, A2, A3, W0, W1, PW) do { MF; sacc += A0; sacc += A1; sacc += A2; sacc += A3; PIN(sacc); W0; W1; PIN(PW); SBAR(); } while (0)
#define EX(v) __builtin_amdgcn_exp2f(v)
#define GAPB(MF, X, B) do { MF; X[B] = EX(X[B]); X[B + 1] = EX(X[B + 1]); X[B + 2] = EX(X[B + 2]); X[B + 3] = EX(X[B + 3]); PIN(X); SBAR(); } while (0)
#define VRD(i) do { vlo[i] = vtr(vp_ + (((i) >> 2) * 4096 + ((i) & 3) * 1024)); vhi[i] = vtr(vp_ + (((i) >> 2) * 4096 + ((i) & 3) * 1024 + 512)); } while (0)
#define KRD(G, j) do { if (G) { kload2(kf, kp0 + sl_next, j); SBAR(); } } while (0)
#define STEP(C0, C1, P0, P1, t, GK, GV, GL) do { SBAR(); \
    const lds_cptr vp_ = vp0 + sl_prev; \
    VRD(0); SBAR(); float sacc = (P0[0] + P0[1]); \
    GAPA(C0 = __builtin_amdgcn_mfma_f32_32x32x16_bf16(kf[0], qr[0], negm, 0, 0, 0), P0[2], P0[3], P0[4], P0[5],     pw0[0] = PKW(P0, 0), pw0[1] = PKW(P0, 2), pw0); \
    VRD(4); SBAR(); GAPA(C1 = __builtin_amdgcn_mfma_f32_32x32x16_bf16(kf[1], qr[0], negm, 0, 0, 0), P0[6], P0[7], P0[8], P0[9],     pw0[2] = PKW(P0, 4), pw0[3] = PKW(P0, 6), pw0); \
    VRD(1); SBAR(); GAPA(C0 = __builtin_amdgcn_mfma_f32_32x32x16_bf16(kf[2], qr[1], C0, 0, 0, 0),   P0[10], P0[11], P0[12], P0[13], pw1[0] = PKW(P0, 8), pw1[1] = PKW(P0, 10), pw1); \
    VRD(5); SBAR(); GAPA(C1 = __builtin_amdgcn_mfma_f32_32x32x16_bf16(kf[3], qr[1], C1, 0, 0, 0),   P0[14], P0[15], P1[0], P1[1],   pw1[2] = PKW(P0, 12), pw1[3] = PKW(P0, 14), pw1); \
    VRD(2); SBAR(); GAPA(C0 = __builtin_amdgcn_mfma_f32_32x32x16_bf16(kf[4], qr[2], C0, 0, 0, 0),   P1[2], P1[3], P1[4], P1[5],     pw2[0] = PKW(P1, 0), pw2[1] = PKW(P1, 2), pw2); \
    VRD(6); SBAR(); GAPA(C1 = __builtin_amdgcn_mfma_f32_32x32x16_bf16(kf[5], qr[2], C1, 0, 0, 0),   P1[6], P1[7], P1[8], P1[9],     pw2[2] = PKW(P1, 4), pw2[3] = PKW(P1, 6), pw2); \
    VRD(3); SBAR(); GAPA(C0 = __builtin_amdgcn_mfma_f32_32x32x16_bf16(kf[6], qr[3], C0, 0, 0, 0),   P1[10], P1[11], P1[12], P1[13], pw3[0] = PKW(P1, 8), pw3[1] = PKW(P1, 10), pw3); \
    VRD(7); SBAR(); GAPA(C1 = __builtin_amdgcn_mfma_f32_32x32x16_bf16(kf[7], qr[3], C1, 0, 0, 0),   P1[14], P1[15], 0.f, 0.f,       pw3[2] = PKW(P1, 12), pw3[3] = PKW(P1, 14), pw3); \
    l_reg += sacc; \
    if (GK) { DMA_K((t) + 3, sl_cur); } if (GV) { DMA_V((t) + 1, sl_next); } \
    { float a = MX3(C0[0], C0[1], C1[0]), b = MX3(C0[2], C0[3], C1[1]); a = MX3(a, C1[2], C1[3]); \
      _Pragma("unroll") for (int r = 4; r < 16; r += 4) { a = MX3(a, C0[r], C0[r + 1]); b = MX3(b, C0[r + 2], C0[r + 3]); a = MX3(a, C1[r], C1[r + 1]); b = MX3(b, C1[r + 2], C1[r + 3]); } \
      float rm = __builtin_fmaxf(a, b); { auto rr = __builtin_amdgcn_permlane32_swap(__float_as_uint(rm), __float_as_uint(rm), false, false); rm = __builtin_fmaxf(__uint_as_float(rr[0]), __uint_as_float(rr[1])); } \
      resc = false; \
      if (__builtin_expect(__any(rm > (float)THRL), 0)) { const float dl = __builtin_fmaxf(rm, 0.f); mhat += dl; \
        _Pragma("unroll") for (int r = 0; r < 16; ++r) { C0[r] -= dl; C1[r] -= dl; } \
        _Pragma("unroll") for (int r = 0; r < 16; ++r) negm[r] = -mhat; asm volatile("" : "+v"(negm)); \
        const float f = __builtin_amdgcn_exp2f(-dl); l_reg *= f; if (hi == 0) wsf[r32] = f; resc = true; } } \
    SBAR(); \
    GAPB(o[0] = __builtin_amdgcn_mfma_f32_32x32x16_bf16(PAF(0), VFR(0), o[0], 0, 0, 0), C0, 0); \
    GAPB(o[1] = __builtin_amdgcn_mfma_f32_32x32x16_bf16(PAF(0), VFR(4), o[1], 0, 0, 0), C0, 4); \
    KRD(GL, 0); GAPB(o[0] = __builtin_amdgcn_mfma_f32_32x32x16_bf16(PAF(1), VFR(1), o[0], 0, 0, 0), C0, 8); \
    KRD(GL, 1); GAPB(o[1] = __builtin_amdgcn_mfma_f32_32x32x16_bf16(PAF(1), VFR(5), o[1], 0, 0, 0), C0, 12); \
    KRD(GL, 2); GAPB(o[0] = __builtin_amdgcn_mfma_f32_32x32x16_bf16(PAF(2), VFR(2), o[0], 0, 0, 0), C1, 0); \
    KRD(GL, 3); GAPB(o[1] = __builtin_amdgcn_mfma_f32_32x32x16_bf16(PAF(2), VFR(6), o[1], 0, 0, 0), C1, 4); \
    GAPB(o[0] = __builtin_amdgcn_mfma_f32_32x32x16_bf16(PAF(3), VFR(3), o[0], 0, 0, 0), C1, 8); \
    GAPB(o[1] = __builtin_amdgcn_mfma_f32_32x32x16_bf16(PAF(3), VFR(7), o[1], 0, 0, 0), C1, 12); \
    } while (0)
    int t = 1;
    for (; t + 5 < NT; t += 2) {
        STEP(pB0, pB1, pA0, pA1, t, true, true, true);     WAIT_BAR(2); RESC(); ROT();
        STEP(pA0, pA1, pB0, pB1, t + 1, true, true, true); WAIT_BAR(2); RESC(); ROT();
    }
#define ENDW(tt) do { if ((tt) + 3 < NT) { WAIT_BAR(2); } else if ((tt) + 2 < NT) { WAIT_BAR(1); } else { WAIT_BAR(0); } } while (0)
    for (; t + 1 < NT; t += 2) {
        STEP(pB0, pB1, pA0, pA1, t, (t + 3 < NT), (t + 1 < NT), (t + 1 < NT));         ENDW(t);     RESC(); ROT();
        STEP(pA0, pA1, pB0, pB1, t + 1, (t + 4 < NT), (t + 2 < NT), (t + 2 < NT));     ENDW(t + 1); RESC(); ROT();
    }
    STEP(pB0, pB1, pA0, pA1, NT - 1, false, false, false); RESC();
    { float sacc = pB0[0] + pB0[1]; _Pragma("unroll") for (int r = 2; r < 16; ++r) sacc += pB0[r]; _Pragma("unroll") for (int r = 0; r < 16; ++r) sacc += pB1[r]; l_reg += sacc;
      pw0 = (u32x4){PKW(pB0, 0), PKW(pB0, 2), PKW(pB0, 4), PKW(pB0, 6)}; pw1 = (u32x4){PKW(pB0, 8), PKW(pB0, 10), PKW(pB0, 12), PKW(pB0, 14)}; pw2 = (u32x4){PKW(pB1, 0), PKW(pB1, 2), PKW(pB1, 4), PKW(pB1, 6)}; pw3 = (u32x4){PKW(pB1, 8), PKW(pB1, 10), PKW(pB1, 12), PKW(pB1, 14)};
      SBAR(); pv(o, vb0 + sl_cur, PAF(0), PAF(1), PAF(2), PAF(3)); }
#undef PKW
#undef PAF
#undef VFR
#undef PIN
#undef MX3
#undef GAPA
#undef GAPB
#undef EX
#undef VRD
#undef KRD
#undef STEP
#undef ENDW
    { auto rr = __builtin_amdgcn_permlane32_swap(__float_as_uint(l_reg), __float_as_uint(l_reg), false, false); l_reg = __uint_as_float(rr[0]) + __uint_as_float(rr[1]); }
    if (hi == 0) wsf[32 + r32] = l_reg; asm volatile("s_waitcnt lgkmcnt(0)" ::: "memory");
    float rli[16];
#pragma unroll
    for (int r = 0; r < 16; ++r) rli[r] = __builtin_amdgcn_rcpf(wsf[32 + crow(r, hi)]);
    bf16_t* Ow = Ou + (long)(wid * QBLK) * TP;
    { bf16_t* stg = (bf16_t*)(shm + LDS_OST) + wid * 2048;
#pragma unroll
      for (int r = 0; r < 16; ++r) { const int orow = crow(r, hi);
#pragma unroll
        for (int d0 = 0; d0 < 2; ++d0) stg[orow * 64 + d0 * 32 + r32] = (bf16_t)f2bf(o[d0][r] * rli[r]); }
      asm volatile("s_waitcnt lgkmcnt(0)" ::: "memory");
#pragma unroll
      for (int i = 0; i < 4; ++i) { const int row = i * 8 + (lane >> 3), ch = lane & 7; const u32x4 v = *(const u32x4*)(stg + row * 64 + ch * 8); *(u32x4*)(Ow + (long)row * TP + ch * 8) = v; } }
    asm volatile("s_waitcnt lgkmcnt(0)\n\ts_barrier" ::: "memory");
#undef DMA_K
#undef DMA_V
#undef START
#undef RESC
#undef ROT
}
#undef SBAR
#undef WAIT_BAR
}
constexpr int NA_KL = 0, NA_VL = 45056, NA_KC = 94720, NA_VC = 111104, NA_RPB = 128000;
constexpr int NA_VLP = 1552, NA_VCP = 528;
__device__ __forceinline__ int na_vslot(int dim) { return 16 * ((dim >> 2) & 1) + 4 * (dim >> 3) + (dim & 3); }
__device__ __forceinline__ int na_kaddr(int key, int c) { return key * 64 + ((c ^ ((key >> 2) & 3)) << 4); }
__device__ __forceinline__ void na_task(int b, int r, int ct, int h, int kr0, const bf16x8 qf, bf16_t* OB, const LAS unsigned char* L, int lane) {
    const int qi = lane & 15, g = lane >> 4;
    const int c0 = ct * 16; const int kc0 = min(max(c0 - 8, 0), 32);
    const int r_start = min(max(r - 4, 0), 24);
    const int krl = r_start - kr0;
    const size_t qrow = (size_t)b * 2048 + r * 64 + c0 + qi;
    const f32x4 z4 = {0.f, 0.f, 0.f, 0.f};
    f32x4 o0 = z4, o1 = z4; float m1, l1;
    {
        f32x4 s[16];
#pragma unroll
        for (int kr = 0; kr < 8; ++kr)
#pragma unroll
            for (int cg = 0; cg < 2; ++cg) {
                const int key = (krl + kr) * 64 + kc0 + 16 * cg + qi;
                const bf16x8 kf = *(const LAS bf16x8*)(L + NA_KL + na_kaddr(key, g));
                s[kr * 2 + cg] = __builtin_amdgcn_mfma_f32_16x16x32_bf16(kf, qf, z4, 0, 0, 0);
            }
        const int qc = c0 + qi; const int cs = min(max(qc - 8, 0), 48);
        const LAS float* rp = (const LAS float*)(L + NA_RPB) + 16;
        const int w = cs - kc0;
        bool in0[4]; int dsel[4]; const int d0 = kc0 + 4 * g - qc + 15;
#pragma unroll
        for (int e = 0; e < 4; ++e) { in0[e] = (4 * g + e) >= w; dsel[e] = d0 + e + (in0[e] ? 0 : 16); }
        float v[8][4];
        float mx = -INFINITY;
#pragma unroll
        for (int kr = 0; kr < 8; ++kr) {
            const LAS float* rpr = rp + (r_start + kr - r + 7) * 31;
#pragma unroll
            for (int e = 0; e < 4; ++e) { const float sv = (in0[e] ? s[kr * 2][e] : s[kr * 2 + 1][e]) + rpr[dsel[e]]; v[kr][e] = sv; mx = fmaxf(mx, sv); }
        }
        mx = fmaxf(mx, __shfl_xor(mx, 16)); mx = fmaxf(mx, __shfl_xor(mx, 32));
        float l = 0.f;
        const LAS unsigned char* vl0 = L + NA_VL + qi * NA_VLP + (krl * 64 + kc0 + 4 * g) * 2;
#pragma unroll
        for (int ks = 0; ks < 8; ++ks) {
            f32x4 a, c;
#pragma unroll
            for (int e = 0; e < 4; ++e) { const float pe = __builtin_amdgcn_exp2f(v[ks][e] - mx); l += pe; a[e] = in0[e] ? pe : 0.f; c[e] = in0[e] ? 0.f : pe; }
            const bf16x8 pfr = __builtin_bit_cast(bf16x8, pack8(a, c));
            const u32x2 a0 = *(const LAS u32x2*)(vl0 + ks * 128), a1 = *(const LAS u32x2*)(vl0 + ks * 128 + 32);
            const u32x2 b0 = *(const LAS u32x2*)(vl0 + 16 * NA_VLP + ks * 128), b1 = *(const LAS u32x2*)(vl0 + 16 * NA_VLP + ks * 128 + 32);
            o0 = __builtin_amdgcn_mfma_f32_16x16x32_bf16(__builtin_bit_cast(bf16x8, (u32x4){a0.x, a0.y, a1.x, a1.y}), pfr, o0, 0, 0, 0);
            o1 = __builtin_amdgcn_mfma_f32_16x16x32_bf16(__builtin_bit_cast(bf16x8, (u32x4){b0.x, b0.y, b1.x, b1.y}), pfr, o1, 0, 0, 0);
        }
        m1 = mx; l1 = l;
    }
    float l;
    {
        f32x4 s[16];
#pragma unroll
        for (int tc = 0; tc < 16; ++tc) {
            const bf16x8 kf = *(const LAS bf16x8*)(L + NA_KC + na_kaddr(16 * tc + qi, g));
            s[tc] = __builtin_amdgcn_mfma_f32_16x16x32_bf16(kf, qf, z4, 0, 0, 0);
        }
        float mx = m1;
#pragma unroll
        for (int tc = 0; tc < 16; ++tc)
#pragma unroll
            for (int e = 0; e < 4; ++e) mx = fmaxf(mx, s[tc][e]);
        mx = fmaxf(mx, __shfl_xor(mx, 16)); mx = fmaxf(mx, __shfl_xor(mx, 32));
        const float f1 = __builtin_amdgcn_exp2f(m1 - mx);
        o0 = o0 * f1; o1 = o1 * f1; l = l1 * f1;
        const LAS unsigned char* vc0 = L + NA_VC + qi * NA_VCP + (4 * g) * 2;
#pragma unroll
        for (int ks = 0; ks < 8; ++ks) {
            f32x4 a = s[2 * ks], c = s[2 * ks + 1];
#pragma unroll
            for (int e = 0; e < 4; ++e) { a[e] = __builtin_amdgcn_exp2f(a[e] - mx); c[e] = __builtin_amdgcn_exp2f(c[e] - mx); }
            l += (a[0] + a[1]) + (a[2] + a[3]) + (c[0] + c[1]) + (c[2] + c[3]);
            const bf16x8 pfr = __builtin_bit_cast(bf16x8, pack8(a, c));
            const u32x2 a0 = *(const LAS u32x2*)(vc0 + ks * 64), a1 = *(const LAS u32x2*)(vc0 + ks * 64 + 32);
            const u32x2 b0 = *(const LAS u32x2*)(vc0 + 16 * NA_VCP + ks * 64), b1 = *(const LAS u32x2*)(vc0 + 16 * NA_VCP + ks * 64 + 32);
            o0 = __builtin_amdgcn_mfma_f32_16x16x32_bf16(__builtin_bit_cast(bf16x8, (u32x4){a0.x, a0.y, a1.x, a1.y}), pfr, o0, 0, 0, 0);
            o1 = __builtin_amdgcn_mfma_f32_16x16x32_bf16(__builtin_bit_cast(bf16x8, (u32x4){b0.x, b0.y, b1.x, b1.y}), pfr, o1, 0, 0, 0);
        }
    }
    l += __shfl_xor(l, 16); l += __shfl_xor(l, 32);
    const float rl = 1.f / l;
    *(u32x4*)(OB + qrow * 512 + h * 32 + 8 * g) = pack8(o0 * rl, o1 * rl);
}

__device__ __forceinline__ void na_stage_load(u32x4 (&kv)[6], u32x4 (&vv)[6], const bf16_t* NK, const bf16_t* NVT, int b, int h, int kr0, int tid) {
#pragma unroll
    for (int j = 0; j < 6; ++j) { const int pid = tid + 512 * j; const int key = pid >> 2, c = pid & 3;
        if (j < 5 || pid < 11 * 64 * 4) kv[j] = *(const u32x4*)(NK + ((size_t)(b * 16 + h) * 2048 + kr0 * 64 + key) * 32 + 8 * c); }
#pragma unroll
    for (int j = 0; j < 6; ++j) { const int pid = tid + 512 * j;
        if (j < 5 || pid < 11 * 256) vv[j] = *(const u32x4*)(NVT + ((size_t)((b * 16 + h) * 32 + kr0 + (pid >> 8)) * 32) * 64 + 8 * (pid & 255)); }
}
__device__ __forceinline__ void na_stage_store(const u32x4 (&kv)[6], const u32x4 (&vv)[6], LAS unsigned char* L, int tid) {
#pragma unroll
    for (int j = 0; j < 6; ++j) { const int pid = tid + 512 * j; const int key = pid >> 2, c = pid & 3;
        if (j < 5 || pid < 11 * 64 * 4) *(LAS u32x4*)(L + NA_KL + na_kaddr(key, c)) = kv[j]; }
#pragma unroll
    for (int j = 0; j < 6; ++j) { const int pid = tid + 512 * j; const int kr = pid >> 8, dim = (pid >> 3) & 31, c8 = pid & 7;
        if (j < 5 || pid < 11 * 256) *(LAS u32x4*)(L + NA_VL + na_vslot(dim) * NA_VLP + (kr * 8 + c8) * 16) = vv[j]; }
}

__device__ __forceinline__ void na_phase(Frame& F, const float* na_rpb, const bf16_t* NQ, bf16_t* OB, const bf16_t* NK, const bf16_t* NKC, const bf16_t* NVT, const bf16_t* NVCT) {
    LAS unsigned char* L = F.lds;
    const int npair = BATCH * 16, per = (npair + F.G - 1) / F.G;
    for (int pi = 0; pi < per; ++pi) {
        const int p = F.vcu * per + pi; if (p >= npair) break;
        const int b = p >> 4, h = p & 15;
        const int tid = F.tid;
        __syncthreads();
        for (int i = tid; i < 16 + 15 * 31 + 48; i += NTHREADS) ((LAS float*)(L + NA_RPB))[i] = (i >= 16 && i < 16 + 15 * 31) ? na_rpb[h * (15 * 31) + i - 16] * LOG2E : 0.f;
        { u32x4 kv[6], vv[6], ck[2], cv[2];
          na_stage_load(kv, vv, NK, NVT, b, h, 0, tid);
#pragma unroll
          for (int j = 0; j < 2; ++j) { const int pid = tid + 512 * j, key = pid >> 2, c = pid & 3; ck[j] = *(const u32x4*)(NKC + ((size_t)b * 256 + key) * 512 + h * 32 + 8 * c); }
#pragma unroll
          for (int j = 0; j < 2; ++j) { const int pid = tid + 512 * j, dim = pid >> 5, c16 = pid & 31; cv[j] = *(const u32x4*)(NVCT + (size_t)(h * 32 + dim) * MCTX + (size_t)b * 256 + 8 * c16); }
          na_stage_store(kv, vv, L, tid);
#pragma unroll
          for (int j = 0; j < 2; ++j) { const int pid = tid + 512 * j, key = pid >> 2, c = pid & 3; *(LAS u32x4*)(L + NA_KC + na_kaddr(key, c)) = ck[j]; }
#pragma unroll
          for (int j = 0; j < 2; ++j) { const int pid = tid + 512 * j, dim = pid >> 5, c16 = pid & 31; *(LAS u32x4*)(L + NA_VC + na_vslot(dim) * NA_VCP + c16 * 16) = cv[j]; } }
        __syncthreads();
#pragma unroll 1
        for (int rq = 0; rq < 8; ++rq) {
            const int kr0 = min(max(4 * rq - 4, 0), 21);
            int t2 = F.tid; asm volatile("" : "+v"(t2));
            u32x4 kv[6];
            const int kr0n = min(max(4 * (rq + 1) - 4, 0), 21);
            const bool restage = rq < 7 && kr0n != kr0;
            if (restage) {
#pragma unroll
                for (int j = 0; j < 6; ++j) { const int pid = t2 + 512 * j; const int key = pid >> 2, c = pid & 3;
                    if (j < 5 || pid < 11 * 64 * 4) kv[j] = *(const u32x4*)(NK + ((size_t)(b * 16 + h) * 2048 + kr0n * 64 + key) * 32 + 8 * c); } }
            const int r_a = 4 * rq + (F.wave >> 2), ct_ = F.wave & 3;
            const bf16x8 qfa = *(const bf16x8*)(NQ + ((size_t)b * 2048 + r_a * 64 + ct_ * 16 + (F.lane & 15)) * 512 + h * 32 + 8 * (F.lane >> 4));
            na_task(b, r_a, ct_, h, kr0, qfa, OB, L, F.lane);
            { const bf16x8 qfb = *(const bf16x8*)(NQ + ((size_t)b * 2048 + (r_a + 2) * 64 + ct_ * 16 + (F.lane & 15)) * 512 + h * 32 + 8 * (F.lane >> 4));
              na_task(b, r_a + 2, ct_, h, kr0, qfb, OB, L, F.lane); }
            __syncthreads();
            if (restage) {
                u32x4 vv[6];
#pragma unroll
                for (int j = 0; j < 6; ++j) { const int pid = t2 + 512 * j;
                    if (j < 5 || pid < 11 * 256) vv[j] = *(const u32x4*)(NVT + ((size_t)((b * 16 + h) * 32 + kr0n + (pid >> 8)) * 32) * 64 + 8 * (pid & 255)); }
                na_stage_store(kv, vv, L, t2); }
            __syncthreads();
        }
    }
    __syncthreads();
}

constexpr int SG_P = 200;
__device__ __forceinline__ void sgu_phase(Frame& F, const bf16_t* VT, const bf16_t* U, bf16_t* OA, const bf16_t* TA, const bf16_t* WS, const bf16_t* WO_T,
                                          const float* ln_g, const float* ln_b, const float* b_s) {
    LAS bf16_t* XS = (LAS bf16_t*)F.lds;
    LAS bf16_t* WM = XS + 128 * SG_P;
    LAS float* red = (LAS float*)(F.lds + 2 * 128 * SG_P * 2);
    LAS float* stat = red + 32 * 128 * 2;
    const int tid = F.tid, lane = F.lane, w = F.wave;
    const int nchunk = MTOK / 128;
    for (int ck = F.vcu; ck < nchunk; ck += F.G) {
        const size_t tok0 = (size_t)ck * 128;
        { const int q8 = tid & 15, cg = tid >> 4; float sm[8], sq[8];
#pragma unroll
          for (int i = 0; i < 8; ++i) { sm[i] = 0.f; sq[i] = 0.f; }
#pragma unroll 1
          for (int j0 = 0; j0 < 32; j0 += 8) { u32x4 raw[8];
#pragma unroll
              for (int j = 0; j < 8; ++j) raw[j] = *(const u32x4*)(VT + (size_t)ck * (1024 * 128) + (size_t)(cg + 32 * (j0 + j)) * 128 + 8 * q8);
#pragma unroll
              for (int j = 0; j < 8; ++j) { f32x4 a, c; unpack8(raw[j], a, c);
#pragma unroll
                  for (int i = 0; i < 4; ++i) { sm[i] += a[i]; sq[i] += a[i] * a[i]; sm[4 + i] += c[i]; sq[4 + i] += c[i] * c[i]; } } }
#pragma unroll
          for (int i = 0; i < 8; ++i) { red[(cg * 128 + q8 * 8 + i) * 2] = sm[i]; red[(cg * 128 + q8 * 8 + i) * 2 + 1] = sq[i]; }
          __syncthreads();
          if (tid < 128) { float s = 0.f, q = 0.f; for (int j = 0; j < 32; ++j) { s += red[(j * 128 + tid) * 2]; q += red[(j * 128 + tid) * 2 + 1]; }
              const float mean = s * (1.f / 1024.f), var = fmaxf(q * (1.f / 1024.f) - mean * mean, 0.f); stat[tid * 2] = mean; stat[tid * 2 + 1] = 1.f / sqrtf(var + NORM_EPS); }
#pragma unroll
          for (int j = 0; j < 2; ++j) { const int pid = tid + 512 * j, p = pid >> 3, c8 = pid & 7; *(LAS u32x4*)(XS + p * SG_P + 128 + 8 * c8) = *(const u32x4*)(TA + (tok0 + p) * 64 + 8 * c8); }
          __syncthreads(); }
        u32x4 rw[4], rv[4], ro[2];
#define SGU_LOADS(G_) do { \
            _Pragma("unroll") for (int j = 0; j < 4; ++j) { const int pid = tid + 512 * j, p = pid >> 4, q8 = pid & 15; rw[j] = *(const u32x4*)(WS + ((size_t)(G_) * 128 + p) * 128 + 8 * q8); } \
            _Pragma("unroll") for (int j = 0; j < 4; ++j) { const int pid = tid + 512 * j, c = pid >> 4, q8 = pid & 15; rv[j] = *(const u32x4*)(VT + (size_t)ck * (1024 * 128) + (size_t)((G_) * 128 + c) * 128 + 8 * q8); } \
            _Pragma("unroll") for (int j = 0; j < 2; ++j) { const int pid = tid + 512 * j, c = pid >> 3, c8 = pid & 7; ro[j] = *(const u32x4*)(WO_T + ((size_t)(G_) * 128 + c) * 64 + 8 * c8); } } while (0)
        SGU_LOADS(0);
#pragma unroll 1
        for (int g = 0; g < 8; ++g) {
#pragma unroll
            for (int j = 0; j < 4; ++j) { const int pid = tid + 512 * j, p = pid >> 4, q8 = pid & 15; *(LAS u32x4*)(XS + p * SG_P + 8 * q8) = rw[j]; }
#pragma unroll
            for (int j = 0; j < 4; ++j) { const int pid = tid + 512 * j, c = pid >> 4, q8 = pid & 15; const int ch = g * 128 + c;
                f32x4 a, d; unpack8(rv[j], a, d);
                const float lg = ln_g[ch], lb = ln_b[ch];
#pragma unroll
                for (int i = 0; i < 4; ++i) { a[i] = (a[i] - stat[(8 * q8 + i) * 2]) * stat[(8 * q8 + i) * 2 + 1] * lg + lb; d[i] = (d[i] - stat[(8 * q8 + 4 + i) * 2]) * stat[(8 * q8 + 4 + i) * 2 + 1] * lg + lb; }
                *(LAS u32x4*)(WM + c * SG_P + 8 * q8) = pack8(a, d); }
#pragma unroll
            for (int j = 0; j < 2; ++j) { const int pid = tid + 512 * j, c = pid >> 3, c8 = pid & 7; *(LAS u32x4*)(WM + c * SG_P + 128 + 8 * c8) = ro[j]; }
            __syncthreads();
            const int fr = lane & 15, fq = lane >> 4;
            u32x4 uw[2][2]; float bsv[2];
#pragma unroll
            for (int mi = 0; mi < 2; ++mi) { const int p = 32 * (w >> 1) + 16 * mi + fr; bsv[mi] = b_s[g * 128 + p];
#pragma unroll
                for (int np = 0; np < 2; ++np) uw[mi][np] = *(const u32x4*)(U + (tok0 + p) * 1024 + g * 128 + 64 * (w & 1) + 32 * np + 8 * fq); }
            if (g < 7) SGU_LOADS(g + 1);
            f32x4 acc[2][4];
#pragma unroll
            for (int mi = 0; mi < 2; ++mi)
#pragma unroll
                for (int ni = 0; ni < 4; ++ni) acc[mi][ni] = (f32x4){0.f, 0.f, 0.f, 0.f};
#pragma unroll
            for (int kk = 0; kk < 6; ++kk) {
                bf16x8 xf[2], wf[4];
#pragma unroll
                for (int mi = 0; mi < 2; ++mi) xf[mi] = *(const LAS bf16x8*)(XS + (32 * (w >> 1) + 16 * mi + fr) * SG_P + 32 * kk + 8 * fq);
#pragma unroll
                for (int ni = 0; ni < 4; ++ni) wf[ni] = *(const LAS bf16x8*)(WM + (64 * (w & 1) + 32 * (ni >> 1) + pg8::perm32(16 * (ni & 1) + fr)) * SG_P + 32 * kk + 8 * fq);
#pragma unroll
                for (int mi = 0; mi < 2; ++mi)
#pragma unroll
                    for (int ni = 0; ni < 4; ++ni) acc[mi][ni] = __builtin_amdgcn_mfma_f32_16x16x32_bf16(wf[ni], xf[mi], acc[mi][ni], 0, 0, 0);
            }
#pragma unroll
            for (int mi = 0; mi < 2; ++mi) { const int p = 32 * (w >> 1) + 16 * mi + fr; const float bs = bsv[mi];
#pragma unroll
                for (int np = 0; np < 2; ++np) { const size_t uo = (tok0 + p) * 1024 + g * 128 + 64 * (w & 1) + 32 * np + 8 * fq;
                    f32x4 u0, u1; unpack8(uw[mi][np], u0, u1); u0 = gelu4(u0); u1 = gelu4(u1);
                    *(u32x4*)(OA + uo) = pack8(u0 * (acc[mi][2 * np] + bs), u1 * (acc[mi][2 * np + 1] + bs)); } }
            __syncthreads();
        }
#undef SGU_LOADS
    }
}

constexpr int RT_WP = 264;
__device__ __forceinline__ void router_phase(Frame& F, const bf16_t* xmid, const float* mod, const float* gn, const float* b_router, const bf16_t* WRH, const bf16_t* WRL, const float* w_router,
                                             bf16_t* H2, int* list_crow, float* list_w, unsigned* gcount, bool dry, const float* ssqp) {
    LAS float* t_g = (LAS float*)F.lds;
    LAS float* t_s = t_g + 1024;
    LAS float* br = t_s + 1024;
    LAS float* cvec = br + 64;
    LAS unsigned* lcnt = (LAS unsigned*)(cvec + 64);
    LAS unsigned* lbase = lcnt + 64;
    LAS bf16_t* WH = (LAS bf16_t*)(lbase + 64);
    LAS bf16_t* WL = WH + 64 * RT_WP;
    for (int blk = F.vcu; blk < MTOK / 256; blk += F.G) {
        int tid = F.tid; asm volatile("" : "+v"(tid));
        const int lane = tid & 63, fr = lane & 15, fq = lane >> 4;
        const int b = blk >> 3, grp = blk < GSPLIT / 256 ? 0 : 1;
        const float* mb = mod + (size_t)b * 6144;
        __syncthreads();
        for (int i = tid; i < 1024; i += NTHREADS) { t_g[i] = gn[i] * (1.f + mb[4 * 1024 + i]); t_s[i] = mb[3 * 1024 + i]; }
        if (tid < 64) { br[tid] = b_router[tid]; lcnt[tid] = 0u; }
        __syncthreads();
        { const int e = tid >> 3, part = tid & 7; float a = 0.f;
#pragma unroll 1
          for (int hb = 0; hb < 2; ++hb) { u32x4 wh_[8], wl_[8];
#pragma unroll
              for (int i = 0; i < 8; ++i) { wh_[i] = *(const u32x4*)(WRH + (size_t)e * DM + part * 128 + hb * 64 + 8 * i); wl_[i] = *(const u32x4*)(WRL + (size_t)e * DM + part * 128 + hb * 64 + 8 * i); }
#pragma unroll
              for (int i = 0; i < 8; ++i) { const int k = part * 128 + hb * 64 + 8 * i; f32x4 h0, h1, l0, l1; unpack8(wh_[i], h0, h1); unpack8(wl_[i], l0, l1);
                  const f32x4 s0 = *(const LAS f32x4*)(t_s + k), s1 = *(const LAS f32x4*)(t_s + k + 4); const f32x4 v = s0 * (h0 + l0) + s1 * (h1 + l1); a += (v.x + v.y) + (v.z + v.w); } }
          a += __shfl_xor(a, 1); a += __shfl_xor(a, 2); a += __shfl_xor(a, 4);
          if (part == 0) cvec[e] = a; }
        const int tokw = blk * 256 + F.wave * 32;
        f32x4 acc[2][4]; float rinv[2];
#pragma unroll
        for (int it = 0; it < 2; ++it) {
            const f32x4* sp = (const f32x4*)(ssqp + (size_t)(tokw + 16 * it + fr) * 16); const f32x4 a = (sp[0] + sp[1]) + (sp[2] + sp[3]);
            rinv[it] = 1.f / sqrtf(((a.x + a.y) + (a.z + a.w)) * (1.f / DM) + NORM_EPS);
#pragma unroll
            for (int j = 0; j < 4; ++j) acc[it][j] = (f32x4){0.f, 0.f, 0.f, 0.f}; }
        u32x4 xr[8];
#pragma unroll
        for (int s = 0; s < 8; ++s) xr[s] = *(const u32x4*)(xmid + (size_t)(tokw + fr) * DM + 16 * fq + 64 * (s >> 1) + 8 * (s & 1));
#pragma unroll 1
        for (int kc = 0; kc < 4; ++kc) {
            __syncthreads();
#pragma unroll
            for (int j = 0; j < 4; ++j) { const int pid = tid + 512 * j, e = pid >> 5, c = pid & 31;
                *(LAS u32x4*)(WH + e * RT_WP + 8 * c) = *(const u32x4*)(WRH + (size_t)e * DM + kc * 256 + 8 * c);
                *(LAS u32x4*)(WL + e * RT_WP + 8 * c) = *(const u32x4*)(WRL + (size_t)e * DM + kc * 256 + 8 * c); }
            __syncthreads();
#pragma unroll
            for (int it = 0; it < 2; ++it) {
                unsigned char* hrow = (unsigned char*)H2 + (size_t)(tokw + 16 * it + fr) * DM + kc * 256 + 16 * fq;
                u32x4 xn[8];
                { const int itn = it ^ 1, kcn = kc + it; const bool hasn = kcn < 4;
                  const bf16_t* xrown = xmid + (size_t)(tokw + 16 * itn + fr) * DM + (hasn ? kcn : 3) * 256 + 16 * fq;
#pragma unroll
                  for (int s = 0; s < 8; ++s) xn[s] = *(const u32x4*)(xrown + 64 * (s >> 1) + 8 * (s & 1)); }
#pragma unroll
                for (int s = 0; s < 8; ++s) {
                    const int kl = 64 * (s >> 1) + 16 * fq + 8 * (s & 1);
                    f32x4 x0, x1; unpack8(xr[s], x0, x1);
                    const f32x4 g0 = *(const LAS f32x4*)(t_g + kc * 256 + kl), g1 = *(const LAS f32x4*)(t_g + kc * 256 + kl + 4);
                    const f32x4 h0 = x0 * g0, h1 = x1 * g1;
                    const u32x4 hi = pack8(h0, h1);
                    f32x4 f0, f1; unpack8(hi, f0, f1);
                    const u32x4 lo = pack8(h0 - f0, h1 - f1);
                    const bf16x8 xh = __builtin_bit_cast(bf16x8, hi), xl = __builtin_bit_cast(bf16x8, lo);
#pragma unroll
                    for (int j = 0; j < 4; ++j) {
                        const bf16x8 wh = *(const LAS bf16x8*)(WH + (16 * j + fr) * RT_WP + kl), wl = *(const LAS bf16x8*)(WL + (16 * j + fr) * RT_WP + kl);
                        acc[it][j] = __builtin_amdgcn_mfma_f32_16x16x32_bf16(wh, xh, acc[it][j], 0, 0, 0);
                        acc[it][j] = __builtin_amdgcn_mfma_f32_16x16x32_bf16(wh, xl, acc[it][j], 0, 0, 0);
                        acc[it][j] = __builtin_amdgcn_mfma_f32_16x16x32_bf16(wl, xh, acc[it][j], 0, 0, 0);
                    }
                    const f32x4 s0 = *(const LAS f32x4*)(t_s + kc * 256 + kl), s1 = *(const LAS f32x4*)(t_s + kc * 256 + kl + 4);
                    *(u32x2*)(hrow + 64 * (s >> 1) + 8 * (s & 1)) = (u32x2){pk4_fp8(h0 * rinv[it] + s0), pk4_fp8(h1 * rinv[it] + s1)};
                }
#pragma unroll
                for (int s = 0; s < 8; ++s) xr[s] = xn[s];
            }
        }
        int sel_e[2][8]; float sel_w[2][8]; unsigned sel_p[2][8];
#pragma unroll
        for (int it = 0; it < 2; ++it) {
            float scv[16], selv[16];
#pragma unroll
            for (int j = 0; j < 4; ++j)
#pragma unroll
                for (int e = 0; e < 4; ++e) { const int ex = 16 * j + 4 * fq + e; const float lg = rinv[it] * acc[it][j][e] + cvec[ex]; const float sg = 1.f / (1.f + __expf(-lg)); scv[4 * j + e] = sg; selv[4 * j + e] = sg + br[ex]; }
            float ssum = 0.f;
#pragma unroll
            for (int kk = 0; kk < 8; ++kk) {
                float bv = -INFINITY, bs = 0.f; int be = 0;
#pragma unroll
                for (int p = 0; p < 16; ++p) { const int ex = 16 * (p >> 2) + 4 * fq + (p & 3); const bool t = selv[p] > bv; bv = t ? selv[p] : bv; bs = t ? scv[p] : bs; be = t ? ex : be; }
#pragma unroll
                for (int o = 16; o <= 32; o <<= 1) { const float ov = __shfl_xor(bv, o), os = __shfl_xor(bs, o); const int oe = __shfl_xor(be, o);
                    const bool t = (ov > bv) || (ov == bv && oe < be); bv = t ? ov : bv; bs = t ? os : bs; be = t ? oe : be; }
#pragma unroll
                for (int p = 0; p < 16; ++p) { const int ex = 16 * (p >> 2) + 4 * fq + (p & 3); selv[p] = (ex == be) ? -INFINITY : selv[p]; }
                sel_e[it][kk] = be; sel_w[it][kk] = bs; ssum += bs;
            }
            const float inv = 2.5f / ssum;
#pragma unroll
            for (int kk = 0; kk < 8; ++kk) sel_w[it][kk] *= inv;
            if (lane < 16) {
#pragma unroll
                for (int kk = 0; kk < 8; ++kk) sel_p[it][kk] = atomicAdd((unsigned*)&lcnt[sel_e[it][kk]], 1u);
            }
        }
        __syncthreads();
        if (tid < 64 && !dry) lbase[tid] = atomicAdd(&gcount[grp * 64 + tid], lcnt[tid]);
        __syncthreads();
        if (lane < 16 && !dry) {
#pragma unroll
            for (int it = 0; it < 2; ++it) {
                const int tok = tokw + it * 16 + lane; const int tl = tok - gbase(grp);
#pragma unroll
                for (int kk = 0; kk < 8; ++kk) { const int e = sel_e[it][kk]; const size_t pos = (size_t)(grp * 64 + e) * GCAP + lbase[e] + sel_p[it][kk];
                    list_crow[pos] = tl * 9 + kk; list_w[pos] = sel_w[it][kk]; }
            }
        }
    }
    __syncthreads();
}

constexpr int FIN_EXTRA = 34;
__device__ __forceinline__ void final_phase(Frame& F, int grp, const unsigned char* C, const bf16_t* xmid, const float* mod, const float* fg, float* out, int gemm_units, int Gs = 0, int cs = 0) {
    const int lane = F.lane, n = gsize(grp), G = Gs > 0 ? Gs : F.G, c = Gs > 0 ? cs : F.vcu;
    const int r = gemm_units > 0 ? gemm_units % G : 0, nlight = (gemm_units > 0 && r != 0) ? G - r : 0;
    const int E = (nlight > 0 && FIN_EXTRA * nlight * 2 < n) ? FIN_EXTRA : 0;
    const int rest = n - E * nlight, base = rest / G, rem = rest - base * G;
    const int t0 = c * base + min(c, rem) + ((nlight > 0 && c > r) ? (c - r) * E : 0);
    const int cnt = base + (c < rem ? 1 : 0) + ((nlight > 0 && c >= r) ? E : 0);
    f32x4 fgv[4];
#pragma unroll
    for (int j = 0; j < 4; ++j) fgv[j] = ((const f32x4*)(fg + 16 * lane))[j];
    const int tend = t0 + cnt;
    int tl = t0 + F.wave;
    u32x4 c8[9], xa, xb; f32x4 gv[4];
    if (tl < tend) { const int tok = gbase(grp) + tl; const unsigned char* tp = C + (size_t)tl * CROW_BYTES; const float* gf = mod + (size_t)(tok >> 11) * 6144 + 5 * 1024 + 16 * lane;
#pragma unroll
        for (int k = 0; k < 9; ++k) c8[k] = *(const u32x4*)(tp + k * 1024 + 16 * lane);
        xa = *(const u32x4*)(xmid + (size_t)tok * DM + 16 * lane); xb = *(const u32x4*)(xmid + (size_t)tok * DM + 16 * lane + 8);
#pragma unroll
        for (int j = 0; j < 4; ++j) gv[j] = ((const f32x4*)gf)[j]; }
    while (tl < tend) {
        const int tok = gbase(grp) + tl;
        const int tln = tl + NWAVES, tlc = min(tln, tend - 1);
        u32x4 c8n[9], xan, xbn; f32x4 gvn[4];
        { const int tokn = gbase(grp) + tlc; const unsigned char* tp = C + (size_t)tlc * CROW_BYTES; const float* gf = mod + (size_t)(tokn >> 11) * 6144 + 5 * 1024 + 16 * lane;
#pragma unroll
          for (int k = 0; k < 9; ++k) c8n[k] = *(const u32x4*)(tp + k * 1024 + 16 * lane);
          xan = *(const u32x4*)(xmid + (size_t)tokn * DM + 16 * lane); xbn = *(const u32x4*)(xmid + (size_t)tokn * DM + 16 * lane + 8);
#pragma unroll
          for (int j = 0; j < 4; ++j) gvn[j] = ((const f32x4*)gf)[j]; }
        f32x4 y[4], xv[4];
#pragma unroll
        for (int j = 0; j < 4; ++j) y[j] = (f32x4){0.f, 0.f, 0.f, 0.f};
        unpack8(xa, xv[0], xv[1]); unpack8(xb, xv[2], xv[3]);
#pragma unroll
        for (int k = 0; k < 9; ++k)
#pragma unroll
            for (int j = 0; j < 4; ++j) { const int d = (int)c8[k][j]; const auto lo = __builtin_amdgcn_cvt_pk_f32_fp8(d, false), hi = __builtin_amdgcn_cvt_pk_f32_fp8(d, true);
                y[j] += (f32x4){lo[0], lo[1], hi[0], hi[1]}; }
        f32x4 v[4]; float s = 0.f;
#pragma unroll
        for (int j = 0; j < 4; ++j) { v[j] = xv[j] + gv[j] * y[j]; s += (v[j].x * v[j].x + v[j].y * v[j].y) + (v[j].z * v[j].z + v[j].w * v[j].w); }
        const float r = 1.f / sqrtf(wave_sum_l(s, lane) * (1.f / DM) + NORM_EPS);
        f32x4* orow = (f32x4*)(out + (size_t)tok * DM + 16 * lane);
#pragma unroll
        for (int j = 0; j < 4; ++j) orow[j] = v[j] * r * fgv[j];
#pragma unroll
        for (int k = 0; k < 9; ++k) c8[k] = c8n[k];
        xa = xan; xb = xbn;
#pragma unroll
        for (int j = 0; j < 4; ++j) gv[j] = gvn[j];
        tl = tln;
    }
}
struct Args { const float* in[28]; float* out; unsigned char* ws; int stage, pad1; };

__device__ __forceinline__ int tq_src_col(int j) { const int axis = j >> 5, p = j & 31; return axis * 32 + (p & 1) * 16 + (p >> 1); }
__device__ __forceinline__ int main_src_col(int c) {
    if (c < 1024) return COL_U + c;
    if (c < 2048) return COL_GA + (c - 1024);
    if (c < 3072) return COL_GB + (c - 2048);
    if (c < 3584) return COL_NQ + (c - 3072);
    if (c < 4096) return COL_NK + (c - 3584);
    const int j = c - 4096;
    if (j < 64) return COL_TQ + tq_src_col(j);
    if (j < 128) return COL_TK + tq_src_col(j - 64);
    if (j < 192) return COL_TV + (j - 128);
    return -1;
}
typedef const __attribute__((address_space(4))) Args* KArgs0;
__device__ __forceinline__ void p0_elementwise(Frame& F, KArgs0 ap) {
    unsigned char* ws = ap->ws;
    const size_t gt = (size_t)F.vcu * NTHREADS + F.tid, NT_ = (size_t)F.G * NTHREADS;
    const float* w_in = ap->in[8]; const float* b_in = ap->in[9];
    float* rope = (float*)(ws + WS_ROPE);
    for (size_t i = gt; i < 2 * 64 * 16; i += NT_) { const int f = (int)(i & 15), pos = (int)((i >> 4) & 63); const float inv = powf(10000.f, -(float)f / 16.f); const float ang = (float)pos * inv; rope[2 * i] = cosf(ang); rope[2 * i + 1] = sinf(ang); }
    float* bin = (float*)(ws + WS_BIN); float* bt = (float*)(ws + WS_BT);
    for (size_t i = gt; i < 4352; i += NT_) { const int sc = main_src_col((int)i); bin[i] = sc >= 0 ? b_in[sc] : 0.f; }
    for (size_t i = gt; i < 1536; i += NT_) bt[i] = i < 1024 ? b_in[COL_V + i] : b_in[COL_NV + (i - 1024)];
    bf16_t* win = (bf16_t*)(ws + WS_WIN);
    for (size_t i = gt; i < (size_t)64 * 1024; i += NT_) win[(size_t)(4096 + 192) * 1024 + i] = 0;
    bf16_t* wrh = (bf16_t*)(ws + WS_WRH); bf16_t* wrl = (bf16_t*)(ws + WS_WRL); const float* w_router = ap->in[19];
    for (size_t i = gt; i < (size_t)64 * 1024; i += NT_) { const int e = (int)(i >> 10), k = (int)(i & 1023); const float v = w_router[(size_t)k * 64 + e]; const unsigned h = f2bf(v); wrh[i] = (bf16_t)h; wrl[i] = (bf16_t)f2bf(v - bf2f((unsigned short)h)); }
    bf16_t* wsb = (bf16_t*)(ws + WS_WS); const float* w_s = ap->in[12];
    for (size_t i = gt; i < (size_t)8 * 128 * 128; i += NT_) wsb[i] = (bf16_t)f2bf(w_s[i]);
}

__device__ __forceinline__ void p0_weights(Frame& F, KArgs0 ap) {
    unsigned char* ws = ap->ws;
    LAS float* scr = (LAS float*)(F.lds + F.wave * 16384);
    const int gw = F.vcu * NWAVES + F.wave, NGW = F.G * NWAVES;
    const float* w_in = ap->in[8];
    bf16_t* win = (bf16_t*)(ws + WS_WIN); bf16_t* wt = (bf16_t*)(ws + WS_WT);
    auto get_job = [&](int j) -> TrJob {
        switch (j) {
        case 0: return TrJob{w_in, win, IN_W, 1024, 1024, COL_U, 0, 1, 0, 0, 0, 0, 0, ws + WS_WIN8};
        case 1: return TrJob{w_in, win, IN_W, 1024, 1024, COL_GA, 1024, 1, 0, 0, 0, 0, 0, ws + WS_WIN8};
        case 2: return TrJob{w_in, win, IN_W, 1024, 1024, COL_GB, 2048, 1, 0, 0, 0, 0, 0, ws + WS_WIN8};
        case 3: return TrJob{w_in, win, IN_W, 1024, 512, COL_NQ, 3072, 1, 0, 0, 0, 0, 0, ws + WS_WIN8};
        case 4: return TrJob{w_in, win, IN_W, 1024, 512, COL_NK, 3584, 1, 0, 0, 0, 0, 0, ws + WS_WIN8};
        case 5: return TrJob{w_in, win, IN_W, 1024, 64, COL_TV, 4096 + 128, 1, 0, 0, 0};
        case 6: return TrJob{w_in, wt, IN_W, 1024, 1024, COL_V, 0, 1, 0, 0, 0, 0, 0, ws + WS_WT8};
        case 7: return TrJob{w_in, wt, IN_W, 1024, 512, COL_NV, 1024, 1, 0, 0, 0, 0, 0, ws + WS_WT8};
        case 8: return TrJob{ap->in[16], (bf16_t*)(ws + WS_WUPA) + 512, 1024, 1024, 1024, 0, 0, 1, 0, 0, 0, 1536};
        case 9: return TrJob{ap->in[17], (bf16_t*)(ws + WS_WUPA), 1024, 512, 1024, 0, 0, 1, 0, 0, 0, 1536};
        case 10: return TrJob{ap->in[18], (bf16_t*)(ws + WS_WOUT), 1024, 1024, 1024, 0, 0, 1, 0, 0, 0};
        case 11: return TrJob{ap->in[14], (bf16_t*)(ws + WS_WO), 1024, 64, 1024, 0, 0, 1, 0, 0, 0};
        case 12: return TrJob{ap->in[21], (bf16_t*)(ws + WS_WGU), 256, 1024, 256, 0, 0, 64, 1, (size_t)1024 * 256, (size_t)512 * 512, 1024, 1};
        case 13: return TrJob{ap->in[22], (bf16_t*)(ws + WS_WGU), 256, 1024, 256, 0, 0, 64, 2, (size_t)1024 * 256, (size_t)512 * 512, 1024, 1};
        case 14: return TrJob{ap->in[23], (bf16_t*)(ws + WS_WD), 1024, 256, 1024, 0, 0, 64, 0, (size_t)256 * 1024, (size_t)1024 * 128, 256, 1};
        case 15: return TrJob{ap->in[24], (bf16_t*)(ws + WS_WGU) + (size_t)64 * 512 * 512, 256, 1024, 256, 0, 0, 1, 1, 0, 0, 1024, 1};
        case 16: return TrJob{ap->in[25], (bf16_t*)(ws + WS_WGU) + (size_t)64 * 512 * 512, 256, 1024, 256, 0, 0, 1, 2, 0, 0, 1024, 1};
        case 17: return TrJob{ap->in[26], (bf16_t*)(ws + WS_WD) + (size_t)64 * 1024 * 128, 1024, 256, 1024, 0, 0, 1, 0, 0, 0, 256, 1};
        case 18: return TrJob{w_in, win, IN_W, 1024, 64, COL_TQ, 4096, 1, 3, 0, 0};
        default: return TrJob{w_in, win, IN_W, 1024, 64, COL_TK, 4096 + 64, 1, 3, 0, 0};
        }
    };
    int total = 0;
#pragma unroll 1
    for (int j = 0; j < 20; ++j) total += trjob_items(get_job(j));
    auto locate = [&](int g) -> TrItem { int j = 0, base = 0;
#pragma unroll 1
        for (;; ++j) { const int n = trjob_items(get_job(j)); if (g < base + n) break; base += n; }
        return trjob_item(get_job(j), g - base); };
    int g = gw;
    if (g < total) {
        float wa[32], wb[32];
        TrItem cur = locate(g); tr_load(cur, wa, F.lane);
#pragma unroll 1
        for (;;) {
            g += NGW; const bool has = g < total; TrItem nxt = cur;
            if (has) { nxt = locate(g); tr_load(nxt, wb, F.lane); }
            tr_store(cur, wa, scr, F.lane);
            if (!has) break;
            cur = nxt;
#pragma unroll
            for (int i = 0; i < 32; ++i) wa[i] = wb[i];
        }
    }
}

typedef const __attribute__((address_space(4))) Args* KArgs;
__device__ __forceinline__ KArgs get_args() { KArgs p = (KArgs)__builtin_amdgcn_kernarg_segment_ptr(); asm volatile("" : "+s"(p)); return p; }
#define WSP(T, off) ((T*)(ws + (off)))

__device__ __forceinline__ int moe_table(Frame& F, int g) {
    volatile LAS unsigned* blk = (volatile LAS unsigned*)(F.lds + MOE_BLK_LDS) + (g & 1) * (MOE_MAXBLK + 130);
    volatile LAS unsigned* pre = blk + MOE_MAXBLK;
    __syncthreads();
    { const unsigned* cnt = F.ctl + CW_GCOUNT + g * 64;
      if (F.tid < 64) {
          const unsigned c = __hip_atomic_load(cnt + F.tid, RLX_AGENT); const unsigned nb = (c + 255u) >> 8; unsigned incl = nb;
#pragma unroll
          for (int d = 1; d < 64; d <<= 1) { const int ln = lane_id_(); const unsigned t = (unsigned)__builtin_amdgcn_ds_bpermute((max(ln - d, 0)) << 2, (int)incl); if (ln >= d) incl += t; }
          pre[F.tid] = incl - nb; pre[66 + F.tid] = c;
          if (F.tid == 63) { pre[64] = incl; pre[65] = incl + (((unsigned)gsize(g) + 255u) >> 8); } }
      __syncthreads(); }
    const int nblk = (int)pre[65];
    for (int j = F.tid; j < nblk; j += NTHREADS) { int lo = 0, hi = 65;
        while (hi - lo > 1) { const int mid = (lo + hi) >> 1; if (pre[mid] <= (unsigned)j) lo = mid; else hi = mid; }
        blk[j] = ((unsigned)lo << 16) | ((unsigned)j - pre[lo]); }
    __syncthreads();
    return nblk;
}
__device__ __forceinline__ void moe_gu_phase(Frame& F, int g, int Gs, int cs) {
    volatile LAS unsigned* blk = (volatile LAS unsigned*)(F.lds + MOE_BLK_LDS) + (g & 1) * (MOE_MAXBLK + 130);
    const int nblk = (int)blk[MOE_MAXBLK + 65];
    unsigned char* ws = get_args()->ws;
    MoeLists L{WSP(int, WS_LCROW) + (size_t)g * 64 * GCAP, WSP(float, WS_LW) + (size_t)g * 64 * GCAP, F.ctl + CW_GCOUNT + g * 64, gsize(g)};
    pg8::Gemm gm{WSP(bf16_t, WS_H), WSP(bf16_t, WS_WGU), 512, (size_t)512 * 1024};
    MoeOrder S{blk, nblk, 2, Gs, cs, L, 1024, gbase(g)};
    EpiMoeGU E{WSP(bf16_t, WS_ACT + (size_t)(g & 1) * ACT_BYTES)};
    pg8::gemm_phase<EpiMoeGU, MoeOrder, true, ALIGN_EPI_, true>(F.lds, gm, S, E);
}
__device__ __forceinline__ void moe_down_phase(Frame& F, int g) {
    volatile LAS unsigned* blk = (volatile LAS unsigned*)(F.lds + MOE_BLK_LDS) + (g & 1) * (MOE_MAXBLK + 130);
    const int nblk = (int)blk[MOE_MAXBLK + 65];
    unsigned char* ws = get_args()->ws;
    MoeLists L{WSP(int, WS_LCROW) + (size_t)g * 64 * GCAP, WSP(float, WS_LW) + (size_t)g * 64 * GCAP, F.ctl + CW_GCOUNT + g * 64, gsize(g)};
    pg8::Gemm gm{WSP(bf16_t, WS_ACT + (size_t)(g & 1) * ACT_BYTES), WSP(bf16_t, WS_WD), 128, (size_t)1024 * 256};
    MoeOrder S{blk, nblk, 4, F.G, F.vcu, L, 2048, gbase(g)};
    EpiMoeDown E{WSP(unsigned char, WS_C), L, F.lds};
    if constexpr ((PROBE_MASK >> 31) & 1) { pg8::DupOrder<MoeOrder> S2{S}; pg8::gemm_phase<EpiMoeDown, pg8::DupOrder<MoeOrder>, false, ALIGN_EPI_>(F.lds, gm, S2, E); }
    else if constexpr ((PROBE_MASK >> 26) & 1) { pg8::SkipOrder<MoeOrder> S3{S}; pg8::gemm_phase<EpiMoeDown, pg8::SkipOrder<MoeOrder>, false, ALIGN_EPI_>(F.lds, gm, S3, E); __syncthreads(); pg8::gemm_phase<EpiMoeDown, MoeOrder, false, ALIGN_EPI_, true>(F.lds, gm, S, E); }
    else pg8::gemm_phase<EpiMoeDown, MoeOrder, false, ALIGN_EPI_, true>(F.lds, gm, S, E);
}

__global__ void __launch_bounds__(NTHREADS, 2) mega_fwd(Args args_unused) {
    extern __shared__ __attribute__((aligned(16))) unsigned char lds[];
    Frame F;
    F.lds = (LAS unsigned char*)lds;
    F.MISC = (volatile LAS unsigned*)(F.lds + MISC_OFF);
    F.tid = threadIdx.x; F.lane = F.tid & 63; F.wave = __builtin_amdgcn_readfirstlane(F.tid >> 6);
    { const unsigned slot = __builtin_amdgcn_s_getreg((5 << 11) | 4) & 63u; if (F.lane == 0) *(volatile LAS unsigned*)(size_t)(WTAB_OFF + 4 * slot) = (unsigned)F.wave; }
    __syncthreads();
    F.G = gridDim.x; { const int bx = blockIdx.x; F.vcu = (F.G % 8 == 0) ? (bx % 8) * (F.G / 8) + bx / 8 : bx; F.cid = bx; }
    { KArgs A = get_args(); F.ctl = (unsigned*)(A->ws + WS_CTL); }
    for (int u = F.tid; u < (LDS_BYTES - LDSCTL_OFF) / 4; u += NTHREADS) ((LAS unsigned*)(F.lds + LDSCTL_OFF))[u] = 0u;
    __syncthreads();
    if (TIDX() == 0) { F.MISC[14] = (unsigned)F.vcu; F.MISC[15] = (unsigned)F.cid; }
    __syncthreads();
    XcdBarrier bar = xcd_barrier_post(F.ctl + CW_BAR, F.MISC + 8);
#define GRID_BAR() xcd_barrier(bar)
    const int stage = get_args()->stage;
#define MISC_PTR() ([&]() -> volatile LAS unsigned* { LAS unsigned* p_ = (LAS unsigned*)(F.lds + MISC_OFF); asm volatile("" : "+s"(p_)); return (volatile LAS unsigned*)p_; }())
#define PHASE_BEGIN() do { F.tid = TIDX(); asm volatile("" : "+v"(F.tid));        F.lane = F.tid & 63; { volatile LAS unsigned* m_ = MISC_PTR(); F.vcu = __builtin_amdgcn_readfirstlane((int)m_[14]); F.cid = __builtin_amdgcn_readfirstlane((int)m_[15]); } } while (0)
      { PHASE_BEGIN(); {
        for (int rep_ = 0; rep_ < (((PROBE_MASK >> 11) & 1) ? 2 : 1); ++rep_) {
        { KArgs A = get_args(); p0_adaln(F, A->in[1], A->in[3], A->in[4], A->in[5], (float*)(A->ws + WS_MOD)); }
        { KArgs A = get_args(); p0_elementwise(F, A); }
        { KArgs A = get_args(); p0_weights(F, A); } __syncthreads(); }
      } } GRID_BAR();
      { if (TIDX() == 0) { unsigned ok = (F.G % 8 == 0) ? 1u : 0u;
          for (unsigned j = 0; j < 16; ++j) { const unsigned c = xb_ld(&bar.bar[XB_XCNT(j)]); if (c != (j < 8 ? (unsigned)F.G / 8u : 0u)) ok = 0u; }
          const unsigned x = F.MISC[12], r = F.MISC[13];
          F.MISC[14] = ok ? x * ((unsigned)F.G / 8u) + r : (unsigned)F.vcu; F.MISC[15] = ok ? r * 8u + x : (unsigned)F.cid; }
        __syncthreads(); }
      if constexpr ((PROBE_MASK >> 24) & 1) { for (int i_ = 0; i_ < 10; ++i_) GRID_BAR(); }
      { PHASE_BEGIN(); {
        KArgs A = get_args(); unsigned char* ws = A->ws; const float* x = A->in[0]; const float* mod = WSP(const float, WS_MOD); const float* gmix = A->in[6];
        bf16_t* H = WSP(bf16_t, WS_H); bf16_t* HC = WSP(bf16_t, WS_HC);
        const int gw = F.vcu * NWAVES + F.wave, NGW = F.G * NWAVES;
        for (int rep_ = 0; rep_ < (((PROBE_MASK >> 12) & 1) ? 2 : 1); ++rep_) {
        for (int c0 = gw * 32; c0 < MTOK; c0 += NGW * 32) { const float* mb = mod + (size_t)(c0 >> 11) * 6144; norm_mod_rows(x + (size_t)c0 * DM, H + (size_t)c0 * DM, 32, gmix, mb, mb + 1024, F.lane, WSP(unsigned char, WS_H8) + (size_t)c0 * DM); }
        const float* mc = mod + (size_t)32 * 6144; const float* cx = A->in[2];
        for (int c0 = gw * 4; c0 < MCTX; c0 += NGW * 4) norm_mod_rows(cx + (size_t)c0 * DM, HC + (size_t)c0 * DM, 4, gmix, mc, mc + 1024, F.lane); }
      } } GRID_BAR();
      { PHASE_BEGIN(); {
        { unsigned char* ws = get_args()->ws;
          pg8::Gemm g{WSP(bf16_t, WS_H8), WSP(bf16_t, WS_WIN8) + (size_t)1024 * 512, 512, 0}; pg8::StaticOrder S; S.init(MTOK, 3072, F.G, F.cid);
          LAS float* bl = (LAS float*)(F.lds + MOE_BLK_LDS);
          for (int i = F.tid; i < 1024; i += NTHREADS) ((LAS f32x4*)bl)[i] = WSP(const f32x4, WS_BIN)[i];
          __syncthreads();
          EpiMain E{0, bl, ws, (void*)get_args()->out, 1.f / 64.f, 4};
          if constexpr ((PROBE_MASK >> 22) & 1) { pg8::SkipOrder<pg8::StaticOrder> S3{S}; pg8::gemm_phase<EpiMain, pg8::SkipOrder<pg8::StaticOrder>, false, ALIGN_EPI_>(F.lds, g, S3, E); }
          if constexpr ((PROBE_MASK >> 21) & 1) {
              const unsigned long long t0 = __builtin_amdgcn_s_memrealtime(); const unsigned long long dl = (unsigned long long)((blockIdx.x >> 3) & 3u) * 900ull;
              while (__builtin_amdgcn_s_memrealtime() - t0 < dl) __builtin_amdgcn_s_sleep(8); }
          if constexpr ((PROBE_MASK >> 18) & 1) { pg8::DupOrder<pg8::StaticOrder> S2{S}; pg8::gemm_phase<EpiMain, pg8::DupOrder<pg8::StaticOrder>, false, ALIGN_EPI_>(F.lds, g, S2, E); } else
          for (int rep_ = 0; rep_ < (((PROBE_MASK >> 2) & 1) ? 2 : 1); ++rep_) pg8::gemm_phase<EpiMain, pg8::StaticOrder, false, ALIGN_EPI_, true>(F.lds, g, S, E);
          { pg8::Gemm g2{WSP(bf16_t, WS_H), WSP(bf16_t, WS_WIN), 1024, 0}; pg8::StaticOrder S2; S2.init(MTOK, 1024, F.G, F.cid);
            EpiMain E2{0, bl, ws, (void*)get_args()->out, 1.f, 0};
            pg8::gemm_phase<EpiMain, pg8::StaticOrder, false, ALIGN_EPI_>(F.lds, g2, S2, E2); } }
        { unsigned char* ws = get_args()->ws;
          pg8::Gemm g{WSP(bf16_t, WS_WT8), WSP(bf16_t, WS_H8), 512, 0}; pg8::StaticOrder S; S.init(1536, MTOK, F.G, F.cid);
          EpiT E{ws, WSP(const float, WS_BT), MTOK, 0, 0, 1.f / 64.f};
          for (int rep_ = 0; rep_ < (((PROBE_MASK >> 3) & 1) ? 2 : 1); ++rep_) pg8::gemm_phase<EpiT, pg8::StaticOrder, false, ALIGN_EPI_, true>(F.lds, g, S, E); }
        { unsigned char* ws = get_args()->ws;
          pg8::Gemm g{WSP(bf16_t, WS_H), WSP(bf16_t, WS_WIN) + (size_t)4096 * 1024, 1024, 0}; pg8::StaticOrder S; S.init(MTOK, 256, F.G, F.cid);
          EpiTT<0> E{WSP(const float, WS_BIN) + 4096, WSP(bf16_t, WS_TQ), WSP(bf16_t, WS_TKA), WSP(bf16_t, WS_TVA), WSP(const float, WS_ROPE)};
          for (int rep_ = 0; rep_ < (((PROBE_MASK >> 4) & 1) ? 2 : 1); ++rep_) pg8::gemm_phase<EpiTT<0>, pg8::StaticOrder, false, ALIGN_EPI_>(F.lds, g, S, E); }
        { unsigned char* ws = get_args()->ws;
          pg8::Gemm g{WSP(bf16_t, WS_HC), WSP(bf16_t, WS_WIN) + (size_t)3584 * 1024, 1024, 0}; pg8::StaticOrder S; S.init(MCTX, 512, F.G, F.cid);
          LAS float* bl = (LAS float*)(F.lds + MOE_BLK_LDS);
          __syncthreads();
          { int t_ = TIDX(); asm volatile("" : "+v"(t_));
            for (int i = t_; i < 128; i += NTHREADS) ((LAS f32x4*)bl)[i] = (WSP(const f32x4, WS_BIN) + 3584 / 4)[i]; }
          __syncthreads();
          EpiMain E{1, bl, ws, (void*)get_args()->out, 1.f, 14};
          for (int rep_ = 0; rep_ < (((PROBE_MASK >> 5) & 1) ? 2 : 1); ++rep_) pg8::gemm_phase<EpiMain, pg8::StaticOrder, false, ALIGN_EPI_>(F.lds, g, S, E); }
        { unsigned char* ws = get_args()->ws;
          pg8::Gemm g{WSP(bf16_t, WS_HC), WSP(bf16_t, WS_WIN) + (size_t)4096 * 1024, 1024, 0}; pg8::StaticOrder S; S.init(MCTX, 256, F.G, (F.cid + F.G - 64) % F.G);
          EpiTT<1> E{WSP(const float, WS_BIN) + 4096, WSP(bf16_t, WS_TQ), WSP(bf16_t, WS_TKA), WSP(bf16_t, WS_TVA), WSP(const float, WS_ROPE)};
          for (int rep_ = 0; rep_ < (((PROBE_MASK >> 6) & 1) ? 2 : 1); ++rep_) pg8::gemm_phase<EpiTT<1>, pg8::StaticOrder, false, ALIGN_EPI_>(F.lds, g, S, E); }
        { unsigned char* ws = get_args()->ws;
          pg8::Gemm g{WSP(bf16_t, WS_WT) + (size_t)1024 * 1024, WSP(bf16_t, WS_HC), 1024, 0}; pg8::StaticOrder S; S.init(512, MCTX, F.G, (F.cid + F.G - 96) % F.G);
          EpiT E{ws, WSP(const float, WS_BT), MCTX, 4, 1, 1.f};
          for (int rep_ = 0; rep_ < (((PROBE_MASK >> 7) & 1) ? 2 : 1); ++rep_) pg8::gemm_phase<EpiT, pg8::StaticOrder, false, ALIGN_EPI_>(F.lds, g, S, E); }
      } } GRID_BAR();
      { PHASE_BEGIN(); if (stage >= 2) {
        { unsigned char* ws = get_args()->ws;
          for (int rep_ = (((PROBE_MASK >> 13) & 1) ? 0 : 1); rep_ < 2; ++rep_)
          for (int u = F.vcu; u < BATCH * 8; u += F.G) { const int b = u >> 3, qb = u & 7;
            bf16_t* qp = WSP(bf16_t, WS_TQ) + ((size_t)b * 2048 + qb * 256) * 64;
            bf16_t* op = rep_ == 1 ? qp : WSP(bf16_t, WS_H) + ((size_t)b * 2048 + qb * 256) * 64;
            tattn::attn_unit<8, 2304>(qp, WSP(bf16_t, WS_TKA) + (size_t)b * 2304 * 64, WSP(bf16_t, WS_TVA) + (size_t)b * 2304 * 64, op, (char*)lds); }
          __syncthreads(); }
        { KArgs A = get_args(); unsigned char* ws = A->ws;
          if ((PROBE_MASK >> 14) & 1) na_phase(F, A->in[15], WSP(bf16_t, WS_NQ), WSP(bf16_t, WS_H) + (size_t)8 * MiB, WSP(bf16_t, WS_NK), WSP(bf16_t, WS_NKC), WSP(bf16_t, WS_NVT), WSP(bf16_t, WS_NVCT));
          na_phase(F, A->in[15], WSP(bf16_t, WS_NQ), WSP(bf16_t, WS_NQ), WSP(bf16_t, WS_NK), WSP(bf16_t, WS_NKC), WSP(bf16_t, WS_NVT), WSP(bf16_t, WS_NVCT)); }
      } } GRID_BAR();
      { PHASE_BEGIN(); if (stage >= 2) {
        { KArgs A = get_args(); unsigned char* ws = A->ws;
          if ((PROBE_MASK >> 15) & 1) { sgu_phase(F, WSP(bf16_t, WS_VT), WSP(bf16_t, WS_U), WSP(bf16_t, WS_NK), WSP(bf16_t, WS_TQ), WSP(const bf16_t, WS_WS), WSP(const bf16_t, WS_WO), A->in[10], A->in[11], A->in[13]); __syncthreads(); }
          sgu_phase(F, WSP(bf16_t, WS_VT), WSP(bf16_t, WS_U), WSP(bf16_t, WS_U), WSP(bf16_t, WS_TQ), WSP(const bf16_t, WS_WS), WSP(const bf16_t, WS_WO), A->in[10], A->in[11], A->in[13]);
          __syncthreads(); }
      } } GRID_BAR();
      { PHASE_BEGIN(); if (stage >= 2) {
        unsigned char* ws = get_args()->ws;
        pg8::Gemm g{(const bf16_t*)ws, WSP(bf16_t, WS_WUPA), 1536, 1024};
        pg8::FusedOrder S; S.b.init(MTOK, 1024, F.G, F.cid); S.aoff0 = (unsigned)WS_NQ; S.apitch0 = 1024u; S.aoff1 = (unsigned)WS_U; S.apitch1 = 2048u; S.nt0 = 8; S.nt1 = 16;
        EpiMerge E{WSP(const unsigned char, WS_GA), WSP(const unsigned char, WS_GB), WSP(bf16_t, WS_MERGED)};
        pg8::gemm_phase<EpiMerge, pg8::FusedOrder, true, ALIGN_EPI_>(F.lds, g, S, E);
      } } GRID_BAR();
      { PHASE_BEGIN(); if (stage >= 2) {
        KArgs A = get_args(); unsigned char* ws = A->ws;
        pg8::Gemm g{WSP(bf16_t, WS_MERGED), WSP(bf16_t, WS_WOUT), 1024, 0}; pg8::StaticOrder S; S.init(MTOK, 1024, F.G, F.cid);
        EpiXmid E{A->in[0], WSP(const float, WS_MOD), WSP(bf16_t, WS_XMID), WSP(float, WS_NQ)};
        for (int rep_ = 0; rep_ < (((PROBE_MASK >> 10) & 1) ? 2 : 1); ++rep_) pg8::gemm_phase<EpiXmid, pg8::StaticOrder, false, ALIGN_EPI_>(F.lds, g, S, E);
      } else {
        KArgs A = get_args(); unsigned char* ws = A->ws; const float* x = A->in[0]; bf16_t* xmid = WSP(bf16_t, WS_XMID);
        const size_t gt = (size_t)F.vcu * NTHREADS + F.tid, NT_ = (size_t)F.G * NTHREADS;
        for (size_t i = gt; i < (size_t)MTOK * DM / 8; i += NT_) ((u32x4*)xmid)[i] = pack8(((const f32x4*)x)[2 * i], ((const f32x4*)x)[2 * i + 1]);
      } } GRID_BAR();
      { PHASE_BEGIN(); if (stage >= 3) {
        KArgs A = get_args(); unsigned char* ws = A->ws; bf16_t* H2 = WSP(bf16_t, WS_H);
        if (blockIdx.x == 0) for (int i = F.tid; i < DM / 4; i += NTHREADS) ((unsigned*)((unsigned char*)H2 + (size_t)MTOK * DM))[i] = 0u;
        if ((PROBE_MASK >> 16) & 1) { router_phase(F, WSP(const bf16_t, WS_XMID), WSP(const float, WS_MOD), A->in[7], A->in[20], WSP(const bf16_t, WS_WRH), WSP(const bf16_t, WS_WRL), A->in[19], H2, WSP(int, WS_LCROW), WSP(float, WS_LW), F.ctl + CW_GCOUNT, true, WSP(const float, WS_NQ)); __syncthreads(); }
        router_phase(F, WSP(const bf16_t, WS_XMID), WSP(const float, WS_MOD), A->in[7], A->in[20], WSP(const bf16_t, WS_WRH), WSP(const bf16_t, WS_WRL), A->in[19], H2, WSP(int, WS_LCROW), WSP(float, WS_LW), F.ctl + CW_GCOUNT, false, WSP(const float, WS_NQ));
      } } GRID_BAR();
      if (stage >= 3) {
        volatile LAS unsigned* lv = F.MISC + 16;
        if (TIDX() == 0) lv[0] = 0u;
        __syncthreads();
#pragma unroll 1
        for (;;) {
          PHASE_BEGIN();
          { const int s = __builtin_amdgcn_readfirstlane((int)MISC_PTR()[16]);
            if (s > 2 * NGRP) break;
            if constexpr ((PROBE_MASK >> 29) & 1) { if (s == ((PROBE_MASK >> 30) & 1 ? 0 : 2 * NGRP)) {
                if (TIDX() < 64) { const unsigned long long t0 = __builtin_amdgcn_s_memtime(); while (__builtin_amdgcn_s_memtime() - t0 < 400000ull) __builtin_amdgcn_s_sleep(1); }
                __syncthreads(); } }
            const int g = s >> 1;
            if ((s & 1) == 0) {
              int gu_units = 0;
              if (g < NGRP) gu_units = 2 * moe_table(F, g);
              constexpr int FIN_WGS = 64;
              const bool split = false && g > 0 && g < NGRP && F.G > 2 * FIN_WGS;
              if (g > 0 && (!split || F.vcu >= F.G - FIN_WGS)) { KArgs A = get_args(); unsigned char* ws = A->ws;
                  final_phase(F, g - 1, WSP(const unsigned char, WS_C), WSP(const bf16_t, WS_XMID), WSP(const float, WS_MOD), A->in[27], A->out, split ? 0 : gu_units, split ? FIN_WGS : 0, F.vcu - (F.G - FIN_WGS)); }
              if (g < NGRP && (!split || F.vcu < F.G - FIN_WGS)) { PHASE_BEGIN(); moe_gu_phase(F, g, split ? F.G - FIN_WGS : F.G, F.vcu); }
            } else { moe_down_phase(F, g); if constexpr ((PROBE_MASK >> 28) & 1) { __syncthreads(); moe_down_phase(F, g); } } }
          __syncthreads();
          const int s2 = __builtin_amdgcn_readfirstlane((int)MISC_PTR()[16]);
          __syncthreads();
          if (TIDX() == 0) MISC_PTR()[16] = (unsigned)(s2 + 1);
          if (s2 < 2 * NGRP) GRID_BAR(); else __syncthreads();
        }
      } else {
        PHASE_BEGIN();
        KArgs A = get_args(); unsigned char* ws = A->ws;
        float* out = A->out; const float* fg = A->in[27]; const bf16_t* xmid = WSP(const bf16_t, WS_XMID);
        const int gw = F.vcu * NWAVES + F.wave, NGW = F.G * NWAVES;
        for (int tl = gw; tl < MTOK; tl += NGW) {
            f32x4 v[4]; float s = 0.f;
            unpack8(*(const u32x4*)(xmid + (size_t)tl * DM + 16 * F.lane), v[0], v[1]); unpack8(*(const u32x4*)(xmid + (size_t)tl * DM + 16 * F.lane + 8), v[2], v[3]);
#pragma unroll
            for (int j = 0; j < 4; ++j) s += (v[j].x * v[j].x + v[j].y * v[j].y) + (v[j].z * v[j].z + v[j].w * v[j].w);
            const float r = 1.f / sqrtf(wave_sum(s) * (1.f / DM) + NORM_EPS);
#pragma unroll
            for (int j = 0; j < 4; ++j) ((f32x4*)(out + (size_t)tl * DM + 16 * F.lane))[j] = v[j] * r * ((const f32x4*)(fg + 16 * F.lane))[j];
        }
      }
}

extern "C" void kernel_launch(void* const* d_in, const int* in_sizes, int n_in, void* d_out, int out_size, void* d_ws, size_t ws_size, hipStream_t stream) {
    static int grid = 0;
    if (grid == 0) {
        int dev = 0, cus = 0, per_cu = 0;
        if (n_in != 28 || ws_size < WS_END) { fprintf(stderr, "kernel_launch: n_in %d ws %zu (need %zu)\n", n_in, ws_size, (size_t)WS_END); grid = -1; return; }
        if (hipGetDevice(&dev) != hipSuccess || hipDeviceGetAttribute(&cus, hipDeviceAttributeMultiprocessorCount, dev) != hipSuccess) { fprintf(stderr, "kernel_launch: device query failed\n"); grid = -1; return; }
        if (hipFuncSetAttribute((const void*)mega_fwd, hipFuncAttributeMaxDynamicSharedMemorySize, LDS_BYTES) != hipSuccess) { fprintf(stderr, "kernel_launch: hipFuncSetAttribute failed\n"); grid = -1; return; }
        if (hipOccupancyMaxActiveBlocksPerMultiprocessor(&per_cu, (const void*)mega_fwd, NTHREADS, LDS_BYTES) != hipSuccess || per_cu < 1) { fprintf(stderr, "kernel_launch: occupancy query says %d\n", per_cu); }
        (void)hipGetLastError();
        grid = cus;
    }
    if (grid < 0) return;
    (void)hipMemsetAsync((char*)d_ws + WS_CTL, 0, CTL_ZERO_BYTES, stream);
    Args a{};
    for (int i = 0; i < 28; ++i) a.in[i] = (const float*)d_in[i];
    a.out = (float*)d_out; a.ws = (unsigned char*)d_ws; a.stage = KSTAGE;
    void* kargs[] = {&a};
    hipError_t e = hipLaunchCooperativeKernel((const void*)mega_fwd, dim3(grid), dim3(NTHREADS), kargs, LDS_BYTES, stream);
    if (e != hipSuccess) fprintf(stderr, "kernel_launch: cooperative launch failed: %s\n", hipGetErrorString(e));
}
```
